# Optimizing an MI355X kernel written in HIP

```python
import jax, jax.numpy as jnp
from jax import lax
import numpy as np

D_MODEL = 1024
BATCH = 2
SEQ = 8192
DEPTH = 1
DEC_BATCH = 128
DEC_SEQ = 1
PAST_LEN = 16384
PAGE_SIZE = 128

HEAD_DIM = 64
N_HEADS_A = 8
N_HEADS_B = 8
N_KV_B = 2
GROUP_B = N_HEADS_B // N_KV_B
DILATED = ((128, 1), (512, 4), (2048, 16))
WIN_A = 2048
WIN_B = 128
QBLOCK = 128
D_FF = 2816
D_PLE = 256
ROPE_THETA = 10000.0
EPS = 1e-6
SCALE = HEAD_DIM ** -0.5
QA_W = N_HEADS_A * HEAD_DIM
QB_W = N_HEADS_B * HEAD_DIM
KVB_W = N_KV_B * HEAD_DIM
MIX_W = QA_W + QB_W
IN_W = 3 * QA_W + QB_W + 2 * KVB_W
SPLITS = (QA_W, 2 * QA_W, 3 * QA_W, 3 * QA_W + QB_W, 3 * QA_W + QB_W + KVB_W)

kernel_name = 'hybrid_dilated_swa_sink_decoder_step'


def _rmsnorm(x, g):
    xf = x.astype(jnp.float32)
    y = xf * lax.rsqrt(jnp.mean(xf * xf, axis=-1, keepdims=True) + EPS)
    return (y * g.astype(jnp.float32)).astype(x.dtype)


def _rope(x, pos):
    half = HEAD_DIM // 2
    inv = jnp.power(ROPE_THETA, -jnp.arange(half, dtype=jnp.float32) * 2.0 / HEAD_DIM)
    ang = pos.astype(jnp.float32)[:, None] * inv[None, :]
    c = jnp.cos(ang)[:, None, :]
    s = jnp.sin(ang)[:, None, :]
    x1 = x[..., :half].astype(jnp.float32)
    x2 = x[..., half:].astype(jnp.float32)
    return jnp.concatenate([x1 * c - x2 * s, x2 * c + x1 * s], axis=-1).astype(x.dtype)


def _ffn_half(h, g_pre, g_post, w_gate, w_up, w_down):
    u = _rmsnorm(h, g_pre)
    y = (jax.nn.silu(u @ w_gate) * (u @ w_up)) @ w_down
    return h + 0.5 * _rmsnorm(y, g_post)


def _project(h, g_pre, w_in, pos):
    b, t = h.shape[:2]
    z = _rmsnorm(h, g_pre) @ w_in
    qa, ka, va, qb, kb, vb = jnp.split(z, SPLITS, axis=-1)
    qa = _rope(qa.reshape(b, t, N_HEADS_A, HEAD_DIM), pos)
    ka = _rope(ka.reshape(b, t, N_HEADS_A, HEAD_DIM), pos)
    va = va.reshape(b, t, N_HEADS_A, HEAD_DIM)
    qb = _rope(qb.reshape(b, t, N_HEADS_B, HEAD_DIM), pos)
    kb = _rope(kb.reshape(b, t, N_KV_B, HEAD_DIM), pos)
    vb = vb.reshape(b, t, N_KV_B, HEAD_DIM)
    return qa, ka, va, qb, kb, vb


def _dilated_mix(q, k, v, qidx):
    outs, lses = [], []
    for window, dil in DILATED:
        offs = dil * jnp.arange(window // dil + 1, dtype=jnp.int32)
        idx = qidx[:, None] - offs[None, :]
        valid = idx >= 0
        idx = jnp.maximum(idx, 0)
        kg = k[:, idx]
        vg = v[:, idx]
        s = jnp.einsum('bthd,btmhd->bhtm', q, kg, preferred_element_type=jnp.float32) * SCALE
        s = jnp.where(valid, s, -jnp.inf)
        mx = jnp.max(s, axis=-1, keepdims=True)
        e = jnp.exp(s - mx)
        den = jnp.sum(e, axis=-1, keepdims=True)
        outs.append(jnp.einsum('bhtm,btmhd->bthd', e / den, vg.astype(jnp.float32)))
        lses.append((mx + jnp.log(den))[..., 0])
    wts = jax.nn.softmax(jnp.stack(lses, axis=0), axis=0)
    wts = jnp.transpose(wts, (0, 1, 3, 2))[..., None]
    out = jnp.sum(wts * jnp.stack(outs, axis=0), axis=0)
    return out.astype(q.dtype)


def _dilated_prompt(q, k, v):
    b, s, h, d = q.shape
    nb = s // QBLOCK

    def block(i):
        q_blk = lax.dynamic_slice_in_dim(q, i * QBLOCK, QBLOCK, axis=1)
        qidx = i * QBLOCK + jnp.arange(QBLOCK, dtype=jnp.int32)
        return _dilated_mix(q_blk, k, v, qidx)

    out = lax.map(block, jnp.arange(nb, dtype=jnp.int32))
    return jnp.moveaxis(out, 0, 1).reshape(b, s, h, d)


def _sink_probs(s, sink, valid):
    s = jnp.where(valid, s, -jnp.inf)
    mx = jnp.maximum(jnp.max(s, axis=-1, keepdims=True), sink)
    e = jnp.exp(s - mx)
    den = jnp.sum(e, axis=-1, keepdims=True) + jnp.exp(sink - mx)
    return e / den


def _swa_prompt(q, k, v, sink):
    b, s = q.shape[:2]
    nb = s // QBLOCK
    qg = q.reshape(b, nb, QBLOCK, N_KV_B, GROUP_B, HEAD_DIM)
    kb = k.reshape(b, nb, QBLOCK, N_KV_B, HEAD_DIM)
    vb = v.reshape(b, nb, QBLOCK, N_KV_B, HEAD_DIM)
    padw = ((0, 0), (1, 0), (0, 0), (0, 0), (0, 0))
    kk = jnp.concatenate([jnp.pad(kb, padw)[:, :-1], kb], axis=2)
    vv = jnp.concatenate([jnp.pad(vb, padw)[:, :-1], vb], axis=2)
    qi = jnp.arange(QBLOCK, dtype=jnp.int32)[:, None]
    kj = jnp.arange(2 * QBLOCK, dtype=jnp.int32)[None, :]
    dist = QBLOCK + qi - kj
    kpos = (jnp.arange(nb, dtype=jnp.int32) * QBLOCK)[:, None, None] - QBLOCK + kj[None]
    valid = (dist >= 0) & (dist <= WIN_B) & (kpos >= 0)
    sc = jnp.einsum('bnqkgd,bnmkd->bkgnqm', qg, kk, preferred_element_type=jnp.float32) * SCALE
    p = _sink_probs(sc, sink[None, :, :, None, None, None], valid)
    o = jnp.einsum('bkgnqm,bnmkd->bnqkgd', p, vv.astype(jnp.float32))
    return o.reshape(b, s, QB_W).astype(q.dtype)


def _swa_sample(q, kk, vv, sink, qpos, kpos):
    b, t = q.shape[:2]
    qg = q.reshape(b, t, N_KV_B, GROUP_B, HEAD_DIM)
    sc = jnp.einsum('btkgd,blkd->bkgtl', qg, kk, preferred_element_type=jnp.float32) * SCALE
    dist = qpos[:, None] - kpos[None, :]
    valid = (dist >= 0) & (dist <= WIN_B)
    p = _sink_probs(sc, sink[None, :, :, None, None], valid)
    o = jnp.einsum('bkgtl,blkd->btkgd', p, vv.astype(jnp.float32))
    return o.reshape(b, t, QB_W).astype(q.dtype)


def _mix_out(h, oa, ob, w_out, g_post):
    b, t = h.shape[:2]
    y = jnp.concatenate([oa.reshape(b, t, QA_W), ob], axis=-1) @ w_out
    return h + _rmsnorm(y, g_post)


def _ple(h, p, g_pre, g_post, w_gate, w_proj):
    u = _rmsnorm(h, g_pre)
    y = jax.nn.sigmoid(u @ w_gate) * (p @ w_proj)
    return h + _rmsnorm(y, g_post)


def setup_inputs(seed: int = 0) -> dict:
    key = jax.random.key(seed)
    ks = jax.random.split(key, 32)
    f32 = jnp.float32
    la = min(WIN_A, PAST_LEN)
    lb = min(WIN_B, PAST_LEN)

    def nrm(k, shape, scale):
        return jax.random.normal(k, shape, f32) * scale

    def gain(k):
        return 1.0 + nrm(k, (DEPTH, D_MODEL), 0.02)

    return {
        'x_prompt': nrm(ks[0], (BATCH, SEQ, D_MODEL), 1.0),
        'x_sample': nrm(ks[1], (DEC_BATCH, DEC_SEQ, D_MODEL), 1.0),
        'cache_a_k': nrm(ks[2], (DEPTH, DEC_BATCH, la, N_HEADS_A, HEAD_DIM), 1.0),
        'cache_a_v': nrm(ks[3], (DEPTH, DEC_BATCH, la, N_HEADS_A, HEAD_DIM), 1.0),
        'cache_b_k': nrm(ks[4], (DEPTH, DEC_BATCH, lb, N_KV_B, HEAD_DIM), 1.0),
        'cache_b_v': nrm(ks[5], (DEPTH, DEC_BATCH, lb, N_KV_B, HEAD_DIM), 1.0),
        'p_prompt': nrm(ks[6], (DEPTH, BATCH, SEQ, D_PLE), 1.0),
        'p_sample': nrm(ks[7], (DEPTH, DEC_BATCH, DEC_SEQ, D_PLE), 1.0),
        'norm_f1_pre': gain(ks[8]),
        'norm_f1_post': gain(ks[9]),
        'w_f1_gate': nrm(ks[10], (DEPTH, D_MODEL, D_FF), D_MODEL ** -0.5),
        'w_f1_up': nrm(ks[11], (DEPTH, D_MODEL, D_FF), D_MODEL ** -0.5),
        'w_f1_down': nrm(ks[12], (DEPTH, D_FF, D_MODEL), D_FF ** -0.5),
        'norm_mix_pre': gain(ks[13]),
        'norm_mix_post': gain(ks[14]),
        'w_in': nrm(ks[15], (DEPTH, D_MODEL, IN_W), D_MODEL ** -0.5),
        'sinks_b': nrm(ks[16], (DEPTH, N_HEADS_B), 0.5),
        'w_out': nrm(ks[17], (DEPTH, MIX_W, D_MODEL), MIX_W ** -0.5),
        'norm_f2_pre': gain(ks[18]),
        'norm_f2_post': gain(ks[19]),
        'w_f2_gate': nrm(ks[20], (DEPTH, D_MODEL, D_FF), D_MODEL ** -0.5),
        'w_f2_up': nrm(ks[21], (DEPTH, D_MODEL, D_FF), D_MODEL ** -0.5),
        'w_f2_down': nrm(ks[22], (DEPTH, D_FF, D_MODEL), D_FF ** -0.5),
        'norm_ple_pre': gain(ks[23]),
        'norm_ple_post': gain(ks[24]),
        'w_ple_gate': nrm(ks[25], (DEPTH, D_MODEL, D_MODEL), D_MODEL ** -0.5),
        'w_ple_proj': nrm(ks[26], (DEPTH, D_PLE, D_MODEL), D_PLE ** -0.5),
    }


def reference(x_prompt, x_sample, cache_a_k, cache_a_v, cache_b_k, cache_b_v, p_prompt, p_sample,
              norm_f1_pre, norm_f1_post, w_f1_gate, w_f1_up, w_f1_down,
              norm_mix_pre, norm_mix_post, w_in, sinks_b, w_out,
              norm_f2_pre, norm_f2_post, w_f2_gate, w_f2_up, w_f2_down,
              norm_ple_pre, norm_ple_post, w_ple_gate, w_ple_proj):
    pos_p = jnp.arange(SEQ, dtype=jnp.int32)
    pos_s = PAST_LEN + jnp.arange(DEC_SEQ, dtype=jnp.int32)
    la = cache_a_k.shape[2]
    lb = cache_b_k.shape[2]
    keep_a = min(WIN_A, SEQ)
    keep_b = min(WIN_B, SEQ)
    kpos_b = PAST_LEN - lb + jnp.arange(lb + DEC_SEQ, dtype=jnp.int32)
    qidx_a = la + jnp.arange(DEC_SEQ, dtype=jnp.int32)
    hp, hs = x_prompt, x_sample
    nak_p, nav_p, nbk_p, nbv_p = [], [], [], []
    nak_s, nav_s, nbk_s, nbv_s = [], [], [], []
    for i in range(DEPTH):
        hp = _ffn_half(hp, norm_f1_pre[i], norm_f1_post[i], w_f1_gate[i], w_f1_up[i], w_f1_down[i])
        hs = _ffn_half(hs, norm_f1_pre[i], norm_f1_post[i], w_f1_gate[i], w_f1_up[i], w_f1_down[i])
        sink = sinks_b[i].astype(jnp.float32).reshape(N_KV_B, GROUP_B)
        qa, ka, va, qb, kb, vb = _project(hp, norm_mix_pre[i], w_in[i], pos_p)
        oa = _dilated_prompt(qa, ka, va)
        ob = _swa_prompt(qb, kb, vb, sink)
        hp = _mix_out(hp, oa, ob, w_out[i], norm_mix_post[i])
        nak_p.append(ka[:, SEQ - keep_a:])
        nav_p.append(va[:, SEQ - keep_a:])
        nbk_p.append(kb[:, SEQ - keep_b:])
        nbv_p.append(vb[:, SEQ - keep_b:])
        qa_s, ka_s, va_s, qb_s, kb_s, vb_s = _project(hs, norm_mix_pre[i], w_in[i], pos_s)
        kka = jnp.concatenate([cache_a_k[i].astype(ka_s.dtype), ka_s], axis=1)
        vva = jnp.concatenate([cache_a_v[i].astype(va_s.dtype), va_s], axis=1)
        kkb = jnp.concatenate([cache_b_k[i].astype(kb_s.dtype), kb_s], axis=1)
        vvb = jnp.concatenate([cache_b_v[i].astype(vb_s.dtype), vb_s], axis=1)
        oa_s = _dilated_mix(qa_s, kka, vva, qidx_a)
        ob_s = _swa_sample(qb_s, kkb, vvb, sink, pos_s, kpos_b)
        hs = _mix_out(hs, oa_s, ob_s, w_out[i], norm_mix_post[i])
        nak_s.append(kka[:, DEC_SEQ:])
        nav_s.append(vva[:, DEC_SEQ:])
        nbk_s.append(kkb[:, DEC_SEQ:])
        nbv_s.append(vvb[:, DEC_SEQ:])
        hp = _ffn_half(hp, norm_f2_pre[i], norm_f2_post[i], w_f2_gate[i], w_f2_up[i], w_f2_down[i])
        hs = _ffn_half(hs, norm_f2_pre[i], norm_f2_post[i], w_f2_gate[i], w_f2_up[i], w_f2_down[i])
        hp = _ple(hp, p_prompt[i], norm_ple_pre[i], norm_ple_post[i], w_ple_gate[i], w_ple_proj[i])
        hs = _ple(hs, p_sample[i], norm_ple_pre[i], norm_ple_post[i], w_ple_gate[i], w_ple_proj[i])
    return (hp, hs,
            jnp.stack(nak_p), jnp.stack(nav_p), jnp.stack(nbk_p), jnp.stack(nbv_p),
            jnp.stack(nak_s), jnp.stack(nav_s), jnp.stack(nbk_s), jnp.stack(nbv_s))
```

```cpp
#include <hip/hip_runtime.h>
#include <cstdio>
#include <cstdint>
#include <cmath>

#ifndef PG8_SP2
#define PG8_SP2 true
#endif
#ifndef PG8_ALIGN
#define PG8_ALIGN true
#endif
constexpr int NWAVES = 8;
constexpr int D = 1024, FF = 2816, NIN = 2304, DPLE = 256, SEQ = 8192, NB = 2;
constexpr int MP = NB * SEQ;
constexpr int MS = 128;
constexpr int MR = MP + MS;
constexpr int MT = 65 * 256;
constexpr int LA = 2048, LB = 128, PAST = 16384;
constexpr float EPS = 1e-6f;
constexpr float QSCALE = 0.125f * 1.4426950408889634f;

constexpr size_t O_YP = 0, O_YS = O_YP + (size_t)MP * D, O_AKP = O_YS + (size_t)MS * D, O_AVP = O_AKP + (size_t)NB * 2048 * 512,
    O_BKP = O_AVP + (size_t)NB * 2048 * 512, O_BVP = O_BKP + (size_t)NB * 128 * 128, O_AKS = O_BVP + (size_t)NB * 128 * 128,
    O_AVS = O_AKS + (size_t)MS * LA * 512, O_BKS = O_AVS + (size_t)MS * LA * 512, O_BVS = O_BKS + (size_t)MS * LB * 128, O_END = O_BVS + (size_t)MS * LB * 128;
static_assert(O_END == 293797888ull, "output size");

namespace pg8 {
#define PG8_LAS __attribute__((address_space(3)))
typedef unsigned short bf16_t;
typedef short bf16x8 __attribute__((ext_vector_type(8)));
typedef float f32x4 __attribute__((ext_vector_type(4)));
typedef unsigned u32x4 __attribute__((ext_vector_type(4)));
constexpr int BM = 256, BK = 64, HALF = 128, HTB = HALF * BK * 2  , STAGE_BYTES = 8 * HTB, NXCD = 8, WGM = 8;

__host__ __device__ __forceinline__ int lds_byte(int r, int c) { const int st = (r >> 4) * 2 + (c >> 5), rr = r & 15, cc = c & 31, ob = rr * 64 + cc * 2; return st * 1024 + (ob ^ (((ob >> 9) & 1) << 5)); }
__host__ __device__ __forceinline__ void stage_rc(int b, int& R, int& C) { const int st = b / 1024, sb = b % 1024, swz = sb ^ (((sb >> 9) & 1) << 5); R = (st >> 1) * 16 + swz / 64; C = (st & 1) * 32 + (swz % 64) / 2; }
__host__ __device__ __forceinline__ int perm32(int rho) { const int n = rho >> 4, i = rho & 15; return 8 * (i >> 2) + 4 * n + (i & 3); }

struct Unit { int pm, pn; };
struct Gemm { const bf16_t* A; const bf16_t* Bt; int M, N, K; };

struct StaticOrder {
    int nM, nN, nwg, G, c;
    __host__ __device__ void init(int M, int N, int G_, int c_) { nM = M / BM; nN = N / BM; nwg = nM * nN; G = G_; c = c_; }
    __host__ __device__ bool next(int i, Unit& u) const {
        const long L = (long)i * G + c; if (L >= nwg) return false;
        int wgid = (int)L; { const int q = nwg / NXCD, r = nwg % NXCD, xcd = wgid % NXCD, off = wgid / NXCD; wgid = (xcd < r ? xcd * (q + 1) : r * (q + 1) + (xcd - r) * q) + off; }
        const int nig = WGM * nN, gid = wgid / nig, fm = gid * WGM, gsz = (nM - fm) < WGM ? (nM - fm) : WGM;
        u.pm = fm + ((wgid % nig) % gsz); u.pn = (wgid % nig) / gsz; return true;
    }
    __device__ __forceinline__ void a_ready(const Unit&) const {}
    __device__ __forceinline__ void done(const Unit&) const {}
};

__device__ __forceinline__ unsigned cvt_pk_bf16(float lo, float hi) { unsigned r; asm volatile("v_cvt_pk_bf16_f32 %0, %1, %2" : "=v"(r) : "v"(lo), "v"(hi)); return r; }
typedef float f32x2 __attribute__((ext_vector_type(2)));

typedef unsigned u32x2 __attribute__((ext_vector_type(2)));
__device__ __forceinline__ float fast_sigmoid(float x) { return __builtin_amdgcn_rcpf(1.0f + __builtin_amdgcn_exp2f(-1.4426950408889634f * x)); }

struct EpiPlain {
    static constexpr bool PERM = true, AFTER_DRAIN = false;
    bf16_t* O; int ldc;
    __device__ __forceinline__ void operator()(const f32x4 (&acc)[2][2][4][2], const Unit& u, int wr, int wc, int fr, int fq) const {
        const int row0 = u.pm * BM + wr * 64 + fr, col0 = u.pn * BM + wc * 32 + 8 * fq;
#pragma unroll
        for (int ai = 0; ai < 2; ++ai)
#pragma unroll
            for (int m = 0; m < 4; ++m) { bf16_t* rowp = O + (size_t)(row0 + ai * HALF + m * 16) * ldc + col0;
#pragma unroll
                for (int bj = 0; bj < 2; ++bj) { const f32x4 v0 = acc[ai][bj][m][0], v1 = acc[ai][bj][m][1];
                    u32x4 w; w.x = cvt_pk_bf16(v0[0], v0[1]); w.y = cvt_pk_bf16(v0[2], v0[3]); w.z = cvt_pk_bf16(v1[0], v1[1]); w.w = cvt_pk_bf16(v1[2], v1[3]);
                    *(u32x4*)(rowp + bj * HALF) = w; } }
    }
};

struct EpiSwiGLU {
    static constexpr bool PERM = true, AFTER_DRAIN = false;
    bf16_t* O; int ldc; const float* rs;
    __device__ __forceinline__ void operator()(const f32x4 (&acc)[2][2][4][2], const Unit& u, int wr, int wc, int fr, int fq) const {
        const int row0 = u.pm * BM + wr * 64 + fr, col0 = u.pn * HALF + wc * 32 + 8 * fq;
#pragma unroll
        for (int ai = 0; ai < 2; ++ai)
#pragma unroll
            for (int m = 0; m < 4; ++m) { const int row = row0 + ai * HALF + m * 16; const float r = rs[row];
                unsigned w[4];
#pragma unroll
                for (int bj = 0; bj < 2; ++bj) { const f32x4 g = acc[ai][bj][m][0] * r, up = acc[ai][bj][m][1] * r; float o[4];
#pragma unroll
                    for (int i = 0; i < 4; ++i) o[i] = g[i] * fast_sigmoid(g[i]) * up[i];
                    w[2 * bj] = cvt_pk_bf16(o[0], o[1]); w[2 * bj + 1] = cvt_pk_bf16(o[2], o[3]); }
                u32x4 wv; wv.x = w[0]; wv.y = w[1]; wv.z = w[2]; wv.w = w[3];
                *(u32x4*)(O + (size_t)row * ldc + col0) = wv; }
    }
};

struct EpiRope {
    static constexpr bool PERM = true, AFTER_DRAIN = false;
    bf16_t* O; const float* rs; const float* rope;
    float* out;
    __device__ __forceinline__ void operator()(const f32x4 (&acc)[2][2][4][2], const Unit& u, int wr, int wc, int fr, int fq) const {
        const int pn = u.pn; const int row0 = u.pm * BM + wr * 64 + fr;
        const int d0 = 16 * (wc & 1) + 4 * fq;
        const bool is_s = u.pm >= MP / BM;
#pragma unroll
        for (int ai = 0; ai < 2; ++ai)
#pragma unroll
            for (int m = 0; m < 4; ++m) { const int row = row0 + ai * HALF + m * 16; const float r = rs[row];
                const int t = is_s ? 0 : (row & (SEQ - 1)); const int b = is_s ? (row - MP) : (row / SEQ);
                const float* rp = rope + (unsigned)((is_s ? SEQ : t) * 64 + 2 * d0);
                const f32x4 cs0 = *(const f32x4*)rp, cs1 = *(const f32x4*)(rp + 4);
#pragma unroll
                for (int bj = 0; bj < 2; ++bj) {
                    const int hl = 2 * bj + (wc >> 1);
                    const bool rot = (pn < 4) || (pn == 6) || (pn == 7) || (pn == 8 && bj == 0);
                    const bool isq = (pn < 2) || (pn == 6) || (pn == 7);
                    f32x4 x1 = acc[ai][bj][m][0] * r, x2 = acc[ai][bj][m][1] * r;
                    if (rot) {
                        const f32x4 c = (f32x4){cs0[0], cs0[2], cs1[0], cs1[2]}, s = (f32x4){cs0[1], cs0[3], cs1[1], cs1[3]};
                        const f32x4 a = x1, bb = x2; x1 = a * c - bb * s; x2 = bb * c + a * s; }
                    long doff = -1;
                    if (pn >= 2 && pn <= 5) {
                        const int head = 4 * (pn & 1) + hl; const size_t base = (pn < 4) ? (is_s ? O_AKS : O_AKP) : (is_s ? O_AVS : O_AVP);
                        if (is_s) { if (row < MP + MS) doff = (long)(base + ((size_t)(b * 2048 + 2047) * 8 + head) * 64); }
                        else if (t >= SEQ - 2048) doff = (long)(base + ((size_t)(b * 2048 + (t - (SEQ - 2048))) * 8 + head) * 64);
                    } else if (pn == 8) {
                        const int kvh = wc >> 1; const size_t base = (bj == 0) ? (is_s ? O_BKS : O_BKP) : (is_s ? O_BVS : O_BVP);
                        if (is_s) { if (row < MP + MS) doff = (long)(base + ((size_t)(b * 128 + 127) * 2 + kvh) * 64); }
                        else if (t >= SEQ - 128) doff = (long)(base + ((size_t)(b * 128 + (t - (SEQ - 128))) * 2 + kvh) * 64);
                    }
                    if (doff >= 0) { float* dst = out + doff; *(f32x4*)(dst + d0) = x1; *(f32x4*)(dst + d0 + 32) = x2; }
                    if (isq) { x1 = x1 * QSCALE; x2 = x2 * QSCALE; }
                    bf16_t* op = O + (size_t)row * 2304 + pn * BM + 64 * hl + d0;
                    u32x2 w1, w2; w1.x = cvt_pk_bf16(x1[0], x1[1]); w1.y = cvt_pk_bf16(x1[2], x1[3]); w2.x = cvt_pk_bf16(x2[0], x2[1]); w2.y = cvt_pk_bf16(x2[2], x2[3]);
                    *(u32x2*)op = w1; *(u32x2*)(op + 32) = w2; } }
    }
};

struct EpiPle {
    static constexpr bool PERM = true, AFTER_DRAIN = false;
    bf16_t* O; int ldc; const float* rs; const bf16_t* PP;
    __device__ __forceinline__ void operator()(const f32x4 (&acc)[2][2][4][2], const Unit& u, int wr, int wc, int fr, int fq) const {
        const int row0 = u.pm * BM + wr * 64 + fr, col0 = u.pn * BM + wc * 32 + 8 * fq;
#pragma unroll
        for (int ai = 0; ai < 2; ++ai)
#pragma unroll
            for (int m = 0; m < 4; ++m) { const int row = row0 + ai * HALF + m * 16; const float r = rs[row]; const size_t off = (size_t)row * ldc + col0;
#pragma unroll
                for (int bj = 0; bj < 2; ++bj) { const u32x4 pp = *(const u32x4*)(PP + off + bj * HALF);
                    const f32x4 v0 = acc[ai][bj][m][0] * r, v1 = acc[ai][bj][m][1] * r; float o[8];
#pragma unroll
                    for (int i = 0; i < 4; ++i) { const unsigned pw0 = pp[i >> 1], pw1 = pp[2 + (i >> 1)];
                        const float p0 = __uint_as_float((i & 1) ? (pw0 & 0xffff0000u) : (pw0 << 16)), p1 = __uint_as_float((i & 1) ? (pw1 & 0xffff0000u) : (pw1 << 16));
                        o[i] = fast_sigmoid(v0[i]) * p0; o[4 + i] = fast_sigmoid(v1[i]) * p1; }
                    u32x4 w; w.x = cvt_pk_bf16(o[0], o[1]); w.y = cvt_pk_bf16(o[2], o[3]); w.z = cvt_pk_bf16(o[4], o[5]); w.w = cvt_pk_bf16(o[6], o[7]);
                    *(u32x4*)(O + off + bj * HALF) = w; } }
    }
};

template <class Epi, class Sched, bool ALIGN_EPI = false, bool SP2 = false>
__device__ __forceinline__ void gemm_phase(PG8_LAS unsigned char* lds, const Gemm g, const Sched& S, const Epi& E) {
    const int tid = threadIdx.x, wid = __builtin_amdgcn_readfirstlane(tid >> 6), lane = tid & 63, wr = wid >> 2, wc = wid & 3, fr = lane & 15, fq = lane >> 4;
    const int K = g.K, nt = K / BK;
    unsigned voffA[2], voffB[2];
#pragma unroll
    for (int i = 0; i < 2; ++i) { int R, C; stage_rc(tid * 16 + i * 8192, R, C); const int Rb = Epi::PERM ? ((R & ~31) + perm32(R & 31)) : R;
        voffA[i] = (unsigned)(R * K + C) * 2u; voffB[i] = (unsigned)(Rb * K + C) * 2u; }
    const size_t kstep = (size_t)(BK * 2);
    const size_t hstep = (size_t)HALF * K * 2;
    const size_t tstep = 2 * hstep;
    const unsigned ldsw = (unsigned)wid * 1024u;
    const int aoff = lds_byte(wr * 64 + fr, fq * 8), boff = lds_byte(wc * 32 + fr, fq * 8);
#define PG8_SA(b, h) (((b) * 2 + (h)) * HTB)
#define PG8_SB(b, h) ((4 + (b) * 2 + (h)) * HTB)
#define PG8_STAGE(bufoff, gbase, voff) do { _Pragma("unroll") for (int _i = 0; _i < 2; ++_i) \
        __builtin_amdgcn_global_load_lds((const unsigned*)((const char*)(gbase) + (voff)[_i]), (PG8_LAS unsigned*)(lds + (bufoff) + ldsw + _i * 8192), 16, 0, 0); } while (0)
#define PG8_LDA(dst, b, h) do { _Pragma("unroll") for (int m = 0; m < 4; ++m) _Pragma("unroll") for (int k = 0; k < 2; ++k) dst[m][k] = *(const PG8_LAS bf16x8*)(lds + PG8_SA(b, h) + aoff + m * 2048 + k * 1024); } while (0)
#define PG8_LDB(dst, b, h) do { _Pragma("unroll") for (int n = 0; n < 2; ++n) _Pragma("unroll") for (int k = 0; k < 2; ++k) dst[n][k] = *(const PG8_LAS bf16x8*)(lds + PG8_SB(b, h) + boff + n * 2048 + k * 1024); } while (0)
#define PG8_MMA(ai, bj, At, Bt) do { __builtin_amdgcn_s_setprio(1); _Pragma("unroll") for (int m = 0; m < 4; ++m) _Pragma("unroll") for (int n = 0; n < 2; ++n) _Pragma("unroll") for (int k = 0; k < 2; ++k) \
        acc[ai][bj][m][n] = __builtin_amdgcn_mfma_f32_16x16x32_bf16(Bt[n][k], At[m][k], acc[ai][bj][m][n], 0, 0, 0); __builtin_amdgcn_s_setprio(0); } while (0)
#define PG8_WAIT_V(n) asm volatile("s_waitcnt vmcnt(" #n ")" ::: "memory")
#define PG8_WAIT_L(n) asm volatile("s_waitcnt lgkmcnt(" #n ")" ::: "memory")
#define PG8_BAR __builtin_amdgcn_s_barrier()
#define PG8_SCHED __builtin_amdgcn_sched_barrier(0)
    Unit cur, nxt; int ui = 0;
    if (!S.next(0, cur)) return;
    f32x4 acc[2][2][4][2];
#pragma unroll
    for (int a = 0; a < 2; ++a)
#pragma unroll
        for (int b = 0; b < 2; ++b)
#pragma unroll
            for (int m = 0; m < 4; ++m)
#pragma unroll
                for (int n = 0; n < 2; ++n) acc[a][b][m][n] = (f32x4){0.f, 0.f, 0.f, 0.f};
    bf16x8 At[4][2], B0[2][2], B1[2][2];
    const char* cA = (const char*)g.A + (size_t)cur.pm * tstep; const char* cB = (const char*)g.Bt + (size_t)cur.pn * tstep;
    S.a_ready(cur);
    if constexpr (SP2) {
        PG8_STAGE(PG8_SB(0, 0), cB, voffB); PG8_STAGE(PG8_SB(0, 1), cB + hstep, voffB); PG8_STAGE(PG8_SA(0, 0), cA, voffA); PG8_STAGE(PG8_SA(0, 1), cA + hstep, voffA);
        if (wr == 1) PG8_BAR;
        PG8_WAIT_V(2); PG8_BAR;
        PG8_STAGE(PG8_SB(1, 0), cB + kstep, voffB); PG8_STAGE(PG8_SA(1, 0), cA + kstep, voffA); PG8_STAGE(PG8_SB(1, 1), cB + hstep + kstep, voffB);
        PG8_WAIT_V(6); PG8_BAR;
    } else {
        PG8_STAGE(PG8_SB(0, 0), cB, voffB); PG8_STAGE(PG8_SA(0, 0), cA, voffA); PG8_STAGE(PG8_SB(0, 1), cB + hstep, voffB); PG8_STAGE(PG8_SA(0, 1), cA + hstep, voffA);
        if (wr == 1) PG8_BAR;
        PG8_WAIT_V(4); PG8_BAR;
        PG8_STAGE(PG8_SB(1, 0), cB + kstep, voffB); PG8_STAGE(PG8_SA(1, 0), cA + kstep, voffA); PG8_STAGE(PG8_SB(1, 1), cB + hstep + kstep, voffB);
        PG8_WAIT_V(6); PG8_BAR;
    }
    for (;;) {
        const bool has_next = S.next(ui + 1, nxt);
        const char* nA = has_next ? (const char*)g.A + (size_t)nxt.pm * tstep : cA; const char* nB = has_next ? (const char*)g.Bt + (size_t)nxt.pn * tstep : cB;
        for (int t = 0; t < nt; t += 2) {
            const bool last = (t == nt - 2);
            const char* a1 = cA + (size_t)(t + 1) * kstep;
            const char* a2 = last ? nA : cA + (size_t)(t + 2) * kstep; const char* b2 = last ? nB : cB + (size_t)(t + 2) * kstep;
            const char* a3 = a2 + kstep; const char* b3 = b2 + kstep;
            if (last && has_next) S.a_ready(nxt);
            if constexpr (SP2) {
            PG8_LDB(B0, 0, 0); PG8_LDB(B1, 0, 1); PG8_SCHED; PG8_LDA(At, 0, 0); PG8_STAGE(PG8_SA(1, 1), a1 + hstep, voffA);
            PG8_WAIT_V(8); PG8_WAIT_L(0); PG8_BAR; PG8_MMA(0, 0, At, B0); PG8_MMA(0, 1, At, B1); PG8_BAR; PG8_SCHED;
            PG8_LDA(At, 0, 1); PG8_STAGE(PG8_SB(0, 0), b2, voffB); PG8_STAGE(PG8_SB(0, 1), b2 + hstep, voffB); PG8_STAGE(PG8_SA(0, 0), a2, voffA);
            PG8_WAIT_V(8); PG8_WAIT_L(0); PG8_BAR; PG8_MMA(1, 0, At, B0); PG8_MMA(1, 1, At, B1); PG8_BAR; PG8_SCHED;
            PG8_LDB(B0, 1, 0); PG8_LDB(B1, 1, 1); PG8_SCHED; PG8_LDA(At, 1, 0); PG8_STAGE(PG8_SA(0, 1), a2 + hstep, voffA);
            PG8_WAIT_V(8); PG8_WAIT_L(0); PG8_BAR; PG8_MMA(0, 0, At, B0); PG8_MMA(0, 1, At, B1); PG8_BAR; PG8_SCHED;
            PG8_LDA(At, 1, 1); PG8_STAGE(PG8_SB(1, 0), b3, voffB); PG8_STAGE(PG8_SB(1, 1), b3 + hstep, voffB); PG8_STAGE(PG8_SA(1, 0), a3, voffA);
            PG8_WAIT_V(8); PG8_WAIT_L(0); PG8_BAR; PG8_MMA(1, 0, At, B0); PG8_MMA(1, 1, At, B1); PG8_BAR; PG8_SCHED;
            } else {
            PG8_LDB(B0, 0, 0); PG8_SCHED; PG8_LDA(At, 0, 0); PG8_STAGE(PG8_SA(1, 1), a1 + hstep, voffA);
            PG8_WAIT_L(8); PG8_BAR; PG8_WAIT_L(0); PG8_MMA(0, 0, At, B0); PG8_BAR; PG8_SCHED;
            PG8_LDB(B1, 0, 1); PG8_STAGE(PG8_SB(0, 0), b2, voffB);
            PG8_BAR; PG8_WAIT_L(0); PG8_MMA(0, 1, At, B1); PG8_BAR;
            PG8_LDA(At, 0, 1); PG8_STAGE(PG8_SA(0, 0), a2, voffA);
            PG8_BAR; PG8_WAIT_L(0); PG8_MMA(1, 0, At, B0); PG8_BAR; PG8_SCHED;
            PG8_STAGE(PG8_SB(0, 1), b2 + hstep, voffB);
            PG8_WAIT_V(6); PG8_BAR; PG8_MMA(1, 1, At, B1); PG8_BAR;
            PG8_LDB(B0, 1, 0); PG8_SCHED; PG8_LDA(At, 1, 0); PG8_STAGE(PG8_SA(0, 1), a2 + hstep, voffA);
            PG8_WAIT_L(8); PG8_BAR; PG8_WAIT_L(0); PG8_MMA(0, 0, At, B0); PG8_BAR; PG8_SCHED;
            PG8_LDB(B1, 1, 1); PG8_STAGE(PG8_SB(1, 0), b3, voffB);
            PG8_BAR; PG8_WAIT_L(0); PG8_MMA(0, 1, At, B1); PG8_BAR;
            PG8_LDA(At, 1, 1); PG8_STAGE(PG8_SA(1, 0), a3, voffA);
            PG8_BAR; PG8_WAIT_L(0); PG8_MMA(1, 0, At, B0); PG8_BAR; PG8_SCHED;
            PG8_STAGE(PG8_SB(1, 1), b3 + hstep, voffB);
            PG8_WAIT_V(6); PG8_BAR; PG8_MMA(1, 1, At, B1); PG8_BAR;
            }
        }
        if constexpr (ALIGN_EPI) { if (wr == 0) PG8_BAR; }
        if constexpr (!Epi::AFTER_DRAIN) { E(acc, cur, wr, wc, fr, fq); S.done(cur); }
        if (!has_next) break;
#pragma unroll
        for (int a = 0; a < 2; ++a)
#pragma unroll
            for (int b = 0; b < 2; ++b)
#pragma unroll
                for (int m = 0; m < 4; ++m)
#pragma unroll
                    for (int n = 0; n < 2; ++n) acc[a][b][m][n] = (f32x4){0.f, 0.f, 0.f, 0.f};
        cur = nxt; cA = nA; cB = nB; ++ui;
        if constexpr (ALIGN_EPI) { if (wr == 1) PG8_BAR; }
    }
    PG8_WAIT_V(0);
    if constexpr (!ALIGN_EPI) { if (wr == 0) PG8_BAR; }
    PG8_BAR;
    if constexpr (Epi::AFTER_DRAIN) { E.fused(acc, cur, wr, wc, fr, fq, lds, wid, lane); S.done(cur); }
#undef PG8_SA
#undef PG8_SB
#undef PG8_STAGE
#undef PG8_LDA
#undef PG8_LDB
#undef PG8_MMA
#undef PG8_WAIT_V
#undef PG8_WAIT_L
#undef PG8_BAR
#undef PG8_SCHED
}
}
constexpr size_t MiB = 1u << 20;
constexpr size_t WS_CTL = 0, CTL_ZERO_BYTES = 1 * MiB;
constexpr size_t WS_WGU1 = 2 * MiB, WS_WD1 = 14 * MiB, WS_WIN = 20 * MiB, WS_WOUT = 25 * MiB, WS_WGU2 = 28 * MiB, WS_WD2 = 40 * MiB, WS_WPG = 46 * MiB, WS_WPP = 49 * MiB, WS_ROPE = 50 * MiB;
constexpr size_t WS_RS = 54 * MiB;
constexpr size_t WS_XB = 56 * MiB;
constexpr size_t WS_H = 92 * MiB;
constexpr size_t WS_ACT = 160 * MiB;
constexpr size_t WS_Y = 252 * MiB;
constexpr size_t WS_QKV = 288 * MiB;
constexpr size_t WS_ATT = 364 * MiB;
constexpr size_t WS_OP2 = 400 * MiB, WS_OP3 = 418 * MiB;
constexpr size_t WS_LS2 = 436 * MiB, WS_LS3 = 437 * MiB;
constexpr size_t WS_PB = 438 * MiB;
constexpr size_t WS_PP = 448 * MiB;
constexpr size_t WS_END = 484 * MiB;
static_assert(WS_WGU1 + (size_t)2 * FF * D * 2 <= WS_WD1 && WS_WD1 + (size_t)D * FF * 2 <= WS_WIN && WS_WIN + (size_t)NIN * D * 2 <= WS_WOUT && WS_WOUT + (size_t)D * D * 2 <= WS_WGU2 &&
              WS_WGU2 + (size_t)2 * FF * D * 2 <= WS_WD2 && WS_WD2 + (size_t)D * FF * 2 <= WS_WPG && WS_WPG + (size_t)D * D * 2 <= WS_WPP && WS_WPP + (size_t)D * DPLE * 2 <= WS_ROPE &&
              WS_ROPE + (size_t)8193 * 64 * 4 <= WS_RS && WS_RS + (size_t)MT * 4 <= WS_XB && WS_XB + (size_t)MT * D * 2 <= WS_H && WS_H + (size_t)MT * D * 4 <= WS_ACT &&
              WS_ACT + (size_t)MT * FF * 2 <= WS_Y && WS_Y + (size_t)MT * D * 2 <= WS_QKV && WS_QKV + (size_t)MT * NIN * 2 <= WS_ATT && WS_ATT + (size_t)MT * D * 2 <= WS_OP2 &&
              WS_OP2 + (size_t)MP * 512 * 2 <= WS_OP3 && WS_OP3 + (size_t)MP * 512 * 2 <= WS_LS2 && WS_LS2 + (size_t)MP * 8 * 4 <= WS_LS3 && WS_LS3 + (size_t)MP * 8 * 4 <= WS_PB &&
              WS_PB + (size_t)MT * DPLE * 2 <= WS_PP && WS_PP + (size_t)MT * D * 2 <= WS_END, "d_ws map");
constexpr int CW_BAR = 4096;
constexpr int RING_OFF = 0, RING_BYTES = 131072;
constexpr int LDSCTL_OFF = RING_BYTES, MISC_OFF = LDSCTL_OFF + 320;
constexpr int LDS_BYTES = 147456;
static_assert(MISC_OFF + 128 <= LDS_BYTES, "LDS map");

#define GAS __attribute__((address_space(1)))
#define LAS __attribute__((address_space(3)))
typedef unsigned short bf16;
typedef unsigned v4u __attribute__((ext_vector_type(4)));
typedef float f32x4 __attribute__((ext_vector_type(4)));
typedef short bf16x8 __attribute__((ext_vector_type(8)));
typedef GAS unsigned gu32;
typedef GAS unsigned long long gu64;
#define RLX_AGENT __ATOMIC_RELAXED, __HIP_MEMORY_SCOPE_AGENT
#define LDS_WAIT() asm volatile("s_waitcnt lgkmcnt(0)" ::: "memory")
#define VM_WAIT() asm volatile("s_waitcnt vmcnt(0)" ::: "memory")
__device__ __forceinline__ unsigned long long rt() { return __builtin_amdgcn_s_memrealtime(); }
__device__ __forceinline__ unsigned f2bf(float f) { unsigned u = __builtin_bit_cast(unsigned, f); return (u + 0x7fffu + ((u >> 16) & 1u)) >> 16; }
__device__ __forceinline__ unsigned pk2(float lo, float hi) { return f2bf(lo) | (f2bf(hi) << 16); }

#define XB_TMO      128
#define XB_XCNT(j)  (256  + 64 * (j))
#define XB_XSUB(j)  (1280 + 64 * (j))
#define XB_XGEN(j)  (2304 + 64 * (j))
#define XB_TOP      3328
#define XB_TOPGEN   3392
#define XCD_BAR_WORDS 3456
#define XB_SPIN_CAP (1u << 18)

__device__ __forceinline__ unsigned xb_ld(unsigned* p)              { return __hip_atomic_load(p, __ATOMIC_RELAXED, __HIP_MEMORY_SCOPE_AGENT); }
__device__ __forceinline__ unsigned xb_add(unsigned* p, unsigned v) { return __hip_atomic_fetch_add(p, v, __ATOMIC_RELAXED, __HIP_MEMORY_SCOPE_AGENT); }
__device__ __forceinline__ unsigned xb_xcc_id() { return (unsigned)__builtin_amdgcn_s_getreg((3 << 11) | 20) & 0xFu; }
#define XB_SPIN(cond, bar) do { unsigned _sp = 0; while (cond) { __builtin_amdgcn_s_sleep(1); \
    if ((++_sp & 255u) == 0u) { if (xb_ld(&(bar)[XB_TMO])) break; if (_sp > XB_SPIN_CAP) { atomicAdd(&(bar)[XB_TMO], 1u); break; } } } } while (0)

struct XcdBarrier {
    unsigned* bar; unsigned x;
    volatile LAS unsigned* st;
};

__device__ __forceinline__ XcdBarrier xcd_barrier_post(unsigned* bar, volatile LAS unsigned* st) {
    XcdBarrier b; b.bar = bar; b.x = xb_xcc_id(); b.st = st;
    if (threadIdx.x == 0) (void)xb_add(&bar[XB_XCNT(b.x)], 1u);
    return b;
}
__device__ __forceinline__ void xcd_barrier_complete(unsigned* bar, unsigned x, unsigned& nloc, unsigned& nx) {
    const unsigned G = gridDim.x * gridDim.y * gridDim.z;
    unsigned sum, cnt, mine, sp = 0u;
    for (;;) {
        sum = 0u; cnt = 0u; mine = 0u;
#pragma unroll
        for (unsigned j = 0; j < 16; ++j) { const unsigned c = xb_ld(&bar[XB_XCNT(j)]); sum += c; cnt += (c > 0u) ? 1u : 0u; mine = (j == x) ? c : mine; }
        if (sum == G) break;
        __builtin_amdgcn_s_sleep(1);
        if ((++sp & 255u) == 0u) { if (xb_ld(&bar[XB_TMO])) break; if (sp > XB_SPIN_CAP) { atomicAdd(&bar[XB_TMO], 1u); break; } }
    }
    nloc = mine > 0u ? mine : 1u; nx = cnt > 0u ? cnt : 1u;
}

__device__ __forceinline__ void xcd_barrier(const XcdBarrier& b) {
    asm volatile("s_waitcnt vmcnt(0)" ::: "memory");
    __syncthreads();
    if (threadIdx.x == 0) {
        unsigned* bar = b.bar;
        __builtin_amdgcn_s_waitcnt(0);
        unsigned nloc = b.st[0], nx = b.st[1];
        if (nloc == 0u) { xcd_barrier_complete(bar, b.x, nloc, nx); b.st[0] = nloc; b.st[1] = nx; }
        const unsigned old = xb_add(&bar[XB_XSUB(b.x)], 1u);
        const unsigned gen = old / nloc;
        if (old + 1u == (gen + 1u) * nloc) {
            __builtin_amdgcn_fence(__ATOMIC_RELEASE, "agent");
            asm volatile("s_waitcnt vmcnt(0)" ::: "memory");
            const unsigned og = xb_add(&bar[XB_TOP], 1u);
            const unsigned tg = og / nx;
            if (og + 1u == (tg + 1u) * nx) xb_add(&bar[XB_TOPGEN], 1u);
            else XB_SPIN(xb_ld(&bar[XB_TOPGEN]) == tg, bar);
            __builtin_amdgcn_fence(__ATOMIC_ACQUIRE, "agent");
            xb_add(&bar[XB_XGEN(b.x)], 1u);
            asm volatile("s_waitcnt vmcnt(0)" ::: "memory");
        } else {
            XB_SPIN(xb_ld(&bar[XB_XGEN(b.x)]) == gen, bar);
            __builtin_amdgcn_fence(__ATOMIC_ACQUIRE, "agent");
            asm volatile("s_waitcnt vmcnt(0)" ::: "memory");
        }
    }
    __syncthreads();
}

typedef unsigned u32x2g __attribute__((ext_vector_type(2)));
typedef float f32x16 __attribute__((ext_vector_type(16)));
typedef short s16x4 __attribute__((ext_vector_type(4)));
struct Args { const float* in[27]; float* out; unsigned char* ws; };
struct Frame {
    LAS unsigned char* lds;
    volatile LAS unsigned* MISC;
    gu32* ctl;
    int tid, lane, wave;
    int vcu, G;
};
__device__ __forceinline__ float wave_sum(float v) {
#pragma unroll
    for (int o = 1; o < 64; o <<= 1) v += __shfl_xor(v, o);
    return v;
}
__device__ __forceinline__ float bf_lo(unsigned w) { return __uint_as_float(w << 16); }
__device__ __forceinline__ float bf_hi(unsigned w) { return __uint_as_float(w & 0xffff0000u); }

enum { MAP_ID = 0, MAP_GATE = 1, MAP_UP = 2, MAP_ROPE = 3 };
__host__ __device__ __forceinline__ int map_row(int kind, int n) {
    if (kind == MAP_ID) return n;
    if (kind == MAP_ROPE) {
        const int pn = n >> 8, c = n & 255, hl = c >> 6, d = c & 63;
        const int bj = hl >> 1, wch = hl & 1, nn = d >> 5, dd = d & 31, wcl = dd >> 4, fq = (dd >> 2) & 3, i = dd & 3;
        const int wc = wch * 2 + wcl;
        return pn * 256 + 128 * bj + 32 * wc + 8 * fq + 4 * nn + i;
    }
    const int pn = n >> 7, o = n & 127, wc = o >> 5, fq = (o >> 3) & 3, bj = (o >> 2) & 1, i = o & 3;
    return pn * 256 + 128 * bj + 32 * wc + 8 * fq + 4 * (kind == MAP_UP ? 1 : 0) + i;
}
__device__ __forceinline__ void p0_transpose_item(const float* W, int K, int N, bf16* WT, int kind, const float* gain, LAS float* scr, int item, int lane) {
    const int nblk = N / 32, kb = item / nblk, nb = item % nblk, k0 = 64 * kb, n0 = 32 * nb;
#pragma unroll 8
    for (int i = 0; i < 32; ++i) { const int kk = 2 * i + (lane >> 5); const float g = gain ? gain[k0 + kk] : 1.0f; scr[kk * 33 + (lane & 31)] = W[(size_t)(k0 + kk) * N + n0 + (lane & 31)] * g; }
    LDS_WAIT(); asm volatile("" ::: "memory");
    const int c = lane & 7;
#pragma unroll
    for (int j = 0; j < 4; ++j) { const int n = (lane >> 3) + 8 * j; const LAS float* s = scr + (8 * c) * 33 + n;
        v4u o; o.x = pk2(s[0 * 33], s[1 * 33]); o.y = pk2(s[2 * 33], s[3 * 33]); o.z = pk2(s[4 * 33], s[5 * 33]); o.w = pk2(s[6 * 33], s[7 * 33]);
        *(GAS v4u*)(WT + (size_t)map_row(kind, n0 + n) * K + k0 + 8 * c) = o; }
    LDS_WAIT(); asm volatile("" ::: "memory");
}
__device__ __forceinline__ void row_to_bf16_rs(int lane, const float* xrow, bf16* orow, float* rs) {
    const GAS f32x4* xr = (const GAS f32x4*)xrow + lane;
    f32x4 v[4]; float s = 0.f;
#pragma unroll
    for (int j = 0; j < 4; ++j) { v[j] = xr[64 * j]; s += (v[j].x * v[j].x + v[j].y * v[j].y) + (v[j].z * v[j].z + v[j].w * v[j].w); }
    s = wave_sum(s);
    GAS unsigned long long* o8 = (GAS unsigned long long*)orow + lane;
#pragma unroll
    for (int j = 0; j < 4; ++j) o8[64 * j] = (unsigned long long)pk2(v[j].x, v[j].y) | ((unsigned long long)pk2(v[j].z, v[j].w) << 32);
    if (lane == 0) *rs = 1.0f / sqrtf(s * (1.0f / D) + EPS);
}

__device__ __forceinline__ void copy_shift(const float* src, float* dst, int nbatch, int L, int RW, int gtid, int gthreads) {
    const unsigned per_b4 = (unsigned)(L - 1) * RW / 4, blk4 = (unsigned)L * RW / 4, shift4 = (unsigned)RW / 4;
    for (int b = 0; b < nbatch; ++b) { const f32x4* s4 = (const f32x4*)src + (size_t)b * blk4 + shift4; f32x4* d4 = (f32x4*)dst + (size_t)b * blk4;
        for (unsigned e = gtid; e < per_b4; e += gthreads) { const f32x4 v = __builtin_nontemporal_load(s4 + e); __builtin_nontemporal_store(v, d4 + e); } }
}

__device__ __forceinline__ void p0_prologue(Frame& F, const Args& A) {
    unsigned char* ws = A.ws;
    LAS float* scr = (LAS float*)(F.lds + RING_OFF + F.wave * 16384);
    const int gw = F.vcu * NWAVES + F.wave, NGW = F.G * NWAVES;
    constexpr int I_GU = (D / 64) * (FF / 32), I_DN = (FF / 64) * (D / 32), I_IN = (D / 64) * (NIN / 32), I_SQ = (D / 64) * (D / 32), I_PP = (DPLE / 64) * (D / 32);
    constexpr int NITEMS = 4 * I_GU + 2 * I_DN + I_IN + 2 * I_SQ + I_PP;
    for (int it = gw; it < NITEMS; it += NGW) {
        int r = it;
        if (r < I_GU) { p0_transpose_item(A.in[10], D, FF, (bf16*)(ws + WS_WGU1), MAP_GATE, A.in[8], scr, r, F.lane); continue; } r -= I_GU;
        if (r < I_GU) { p0_transpose_item(A.in[11], D, FF, (bf16*)(ws + WS_WGU1), MAP_UP, A.in[8], scr, r, F.lane); continue; } r -= I_GU;
        if (r < I_DN) { p0_transpose_item(A.in[12], FF, D, (bf16*)(ws + WS_WD1), MAP_ID, nullptr, scr, r, F.lane); continue; } r -= I_DN;
        if (r < I_IN) { p0_transpose_item(A.in[15], D, NIN, (bf16*)(ws + WS_WIN), MAP_ROPE, A.in[13], scr, r, F.lane); continue; } r -= I_IN;
        if (r < I_SQ) { p0_transpose_item(A.in[17], D, D, (bf16*)(ws + WS_WOUT), MAP_ID, nullptr, scr, r, F.lane); continue; } r -= I_SQ;
        if (r < I_GU) { p0_transpose_item(A.in[20], D, FF, (bf16*)(ws + WS_WGU2), MAP_GATE, A.in[18], scr, r, F.lane); continue; } r -= I_GU;
        if (r < I_GU) { p0_transpose_item(A.in[21], D, FF, (bf16*)(ws + WS_WGU2), MAP_UP, A.in[18], scr, r, F.lane); continue; } r -= I_GU;
        if (r < I_DN) { p0_transpose_item(A.in[22], FF, D, (bf16*)(ws + WS_WD2), MAP_ID, nullptr, scr, r, F.lane); continue; } r -= I_DN;
        if (r < I_SQ) { p0_transpose_item(A.in[25], D, D, (bf16*)(ws + WS_WPG), MAP_ID, A.in[23], scr, r, F.lane); continue; } r -= I_SQ;
        p0_transpose_item(A.in[26], DPLE, D, (bf16*)(ws + WS_WPP), MAP_ID, nullptr, scr, r, F.lane);
    }
    bf16* XB = (bf16*)(ws + WS_XB); float* RS = (float*)(ws + WS_RS);
    for (int m = gw; m < MR; m += NGW) { const float* xr = (m < MP) ? A.in[0] + (size_t)m * D : A.in[1] + (size_t)(m - MP) * D; row_to_bf16_rs(F.lane, xr, XB + (size_t)m * D, RS + m); }
    bf16* PB = (bf16*)(ws + WS_PB);
    for (int m = gw; m < MR; m += NGW) { const float* pr = (m < MP) ? A.in[6] + (size_t)m * DPLE : A.in[7] + (size_t)(m - MP) * DPLE;
        const f32x4 v = *((const GAS f32x4*)pr + F.lane);
        *((GAS unsigned long long*)(PB + (size_t)m * DPLE) + F.lane) = (unsigned long long)pk2(v.x, v.y) | ((unsigned long long)pk2(v.z, v.w) << 32); }
    { float* rope = (float*)(ws + WS_ROPE); const int gt = gw * 64 + F.lane, NGT = NGW * 64;
      for (int i = gt; i < 8193 * 32; i += NGT) { const int idx = i >> 5, d = i & 31; const float pos = (float)(idx < SEQ ? idx : PAST);
          const float inv = powf(10000.0f, -(float)d * (1.0f / 32.0f)); const float ang = pos * inv;
          rope[2 * i] = cosf(ang); rope[2 * i + 1] = sinf(ang); } }
    { const int gt = gw * 64 + F.lane, NGT = NGW * 64;
      copy_shift(A.in[2], A.out + O_AKS, MS, LA, 512, gt, NGT);
      copy_shift(A.in[3], A.out + O_AVS, MS, LA, 512, gt, NGT);
      copy_shift(A.in[4], A.out + O_BKS, MS, LB, 128, gt, NGT);
      copy_shift(A.in[5], A.out + O_BVS, MS, LB, 128, gt, NGT); }
}

template <int MODE> __device__ __forceinline__ void norm_phase(Frame& F, const Args& A, const float* gpost, float coef) {
    unsigned char* ws = A.ws;
    const bf16* Y = (const bf16*)(ws + WS_Y); float* H = (float*)(ws + WS_H); bf16* XB = (bf16*)(ws + WS_XB); float* RS = (float*)(ws + WS_RS);
    const int gw = F.vcu * NWAVES + F.wave, NGW = F.G * NWAVES, lane = F.lane;
    f32x4 g[4];
#pragma unroll
    for (int j = 0; j < 4; ++j) g[j] = *((const GAS f32x4*)gpost + lane + 64 * j) * coef;
    for (int m = gw; m < MR; m += NGW) {
        const float* hsrc = (MODE == 0) ? ((m < MP) ? A.in[0] + (size_t)m * D : A.in[1] + (size_t)(m - MP) * D) : H + (size_t)m * D;
        float* hdst = (MODE == 2) ? ((m < MP) ? A.out + O_YP + (size_t)m * D : A.out + O_YS + (size_t)(m - MP) * D) : H + (size_t)m * D;
        const GAS unsigned long long* y8 = (const GAS unsigned long long*)(Y + (size_t)m * D) + lane;
        f32x4 y[4], h[4]; float s = 0.f;
#pragma unroll
        for (int j = 0; j < 4; ++j) { const unsigned long long w = y8[64 * j]; const unsigned lo = (unsigned)w, hi = (unsigned)(w >> 32);
            y[j] = (f32x4){bf_lo(lo), bf_hi(lo), bf_lo(hi), bf_hi(hi)}; s += (y[j].x * y[j].x + y[j].y * y[j].y) + (y[j].z * y[j].z + y[j].w * y[j].w);
            h[j] = *((const GAS f32x4*)hsrc + lane + 64 * j); }
        const float rstd = 1.0f / sqrtf(wave_sum(s) * (1.0f / D) + EPS);
        float s2 = 0.f;
#pragma unroll
        for (int j = 0; j < 4; ++j) { h[j] = h[j] + g[j] * (y[j] * rstd); s2 += (h[j].x * h[j].x + h[j].y * h[j].y) + (h[j].z * h[j].z + h[j].w * h[j].w);
            *((GAS f32x4*)hdst + lane + 64 * j) = h[j]; }
        if (MODE != 2) {
            s2 = wave_sum(s2);
            GAS unsigned long long* o8 = (GAS unsigned long long*)(XB + (size_t)m * D) + lane;
#pragma unroll
            for (int j = 0; j < 4; ++j) o8[64 * j] = (unsigned long long)pk2(h[j].x, h[j].y) | ((unsigned long long)pk2(h[j].z, h[j].w) << 32);
            if (lane == 0) RS[m] = 1.0f / sqrtf(s2 * (1.0f / D) + EPS);
        }
    }
}

__device__ __forceinline__ int crow(int r, int hi) { return (r & 3) + 8 * (r >> 2) + 4 * hi; }
__device__ __forceinline__ unsigned cvtpk(float lo, float hi) { unsigned r; asm volatile("v_cvt_pk_bf16_f32 %0, %1, %2" : "=v"(r) : "v"(lo), "v"(hi)); return r; }
__device__ __forceinline__ float xhalf_max(float v) { return fmaxf(v, __shfl_xor(v, 32)); }
__device__ __forceinline__ float xhalf_sum(float v) { return v + __shfl_xor(v, 32); }
__device__ __forceinline__ s16x4 vtr(const LAS unsigned char* p) { typedef short v4i16_t __attribute__((ext_vector_type(4))); return __builtin_bit_cast(s16x4, __builtin_amdgcn_ds_read_tr16_b64_v4i16((LAS v4i16_t*)p)); }

template <int MODE> __device__ __forceinline__ void attn_task(const bf16* QKV, int b, int qcol, int kcol, int vcol, int tq0_, int dil, LAS unsigned char* vt, int lane,
                                                              bf16* OP, float* LS, int head, float sinkl, const bf16* OP2, const bf16* OP3, const float* LS2, const float* LS3, bf16* ATT, int acol) {
    int tq0 = tq0_; asm volatile("" : "+s"(tq0));
    const int r32 = lane & 31, hi = lane >> 5;
    const GAS unsigned char* qb = (const GAS unsigned char*)QKV;
    const unsigned rowb = (unsigned)b * SEQ;
    bf16x8 qf[4];
    { const unsigned qo = ((rowb + tq0 + dil * r32) * NIN + qcol + hi * 32) * 2u;
#pragma unroll
      for (int d0 = 0; d0 < 4; ++d0) qf[d0] = *(const GAS bf16x8*)(qb + qo + d0 * 16); }
    float m_run = (MODE == 2) ? sinkl : -INFINITY, l_run = (MODE == 2) ? 1.0f : 0.0f;
    f32x16 o0 = {}, o1 = {};
    const int sq0 = tq0 / dil; int j0 = (128 - sq0) / 32; j0 = j0 < 0 ? 0 : j0;
    const int tk_base = tq0 - 128 * dil;
    const int g = lane >> 4, tq = (lane & 15) >> 2, tp = lane & 3;
    const int trow = 4 * (g >> 1) + tq, tsw = ((trow >> 1) & 1) << 6, tcol = 32 * (g & 1) + 8 * tp;
    const LAS unsigned char* ta0 = vt + trow * 128 + ((0 ^ tsw) + tcol);
    const LAS unsigned char* ta1 = vt + trow * 128 + ((64 ^ tsw) + tcol);
    const int vkey = lane >> 3, vch = lane & 7;
    const unsigned kstep = (unsigned)(32 * dil * NIN * 2), vustep = (unsigned)(8 * dil * NIN * 2);
    unsigned ko = ((rowb + tk_base + 32 * dil * j0 + dil * r32) * NIN + kcol + hi * 32) * 2u;
    unsigned vo = ((rowb + tk_base + 32 * dil * j0 + dil * vkey) * NIN + vcol + vch * 8) * 2u;
    bf16x8 kf[4], vf[4];
#pragma unroll
    for (int d0 = 0; d0 < 4; ++d0) kf[d0] = *(const GAS bf16x8*)(qb + ko + d0 * 16);
#pragma unroll
    for (int u = 0; u < 4; ++u) vf[u] = *(const GAS bf16x8*)(qb + vo + u * vustep);
#pragma unroll 1
    for (int j = j0; j < 5; ++j) {
        f32x16 s = {};
#pragma unroll
        for (int d0 = 0; d0 < 4; ++d0) s = __builtin_amdgcn_mfma_f32_32x32x16_bf16(kf[d0], qf[d0], s, 0, 0, 0);
#pragma unroll
        for (int u = 0; u < 4; ++u) { const int key = 8 * u + vkey; *(LAS bf16x8*)(vt + key * 128 + ((vch * 16) ^ (((key >> 1) & 1) << 6))) = vf[u]; }
        if (j < 4) { ko += kstep; vo += kstep; }
#pragma unroll
        for (int d0 = 0; d0 < 4; ++d0) kf[d0] = *(const GAS bf16x8*)(qb + ko + d0 * 16);
#pragma unroll
        for (int u = 0; u < 4; ++u) vf[u] = *(const GAS bf16x8*)(qb + vo + u * vustep);
        if (j == 0) {
#pragma unroll
            for (int r = 0; r < 16; ++r) if (crow(r, hi) < r32) s[r] = -INFINITY;
        }
        if (j == 4) {
#pragma unroll
            for (int r = 0; r < 16; ++r) if (crow(r, hi) > r32) s[r] = -INFINITY;
        }
        float mx = s[0];
#pragma unroll
        for (int r = 1; r < 16; ++r) mx = fmaxf(mx, s[r]);
        mx = xhalf_max(mx);
        const float m_new = fmaxf(m_run, mx);
        const float alpha = __builtin_amdgcn_exp2f(m_run - m_new);
        float rs = 0.f;
#pragma unroll
        for (int r = 0; r < 16; ++r) { s[r] = __builtin_amdgcn_exp2f(s[r] - m_new); rs += s[r]; }
        rs = xhalf_sum(rs);
        l_run = l_run * alpha + rs; m_run = m_new;
#pragma unroll
        for (int r = 0; r < 16; ++r) { o0[r] *= alpha; o1[r] *= alpha; }
        bf16x8 pk[2];
#pragma unroll
        for (int sl = 0; sl < 2; ++sl) { v4u w; w.x = cvtpk(s[8 * sl + 0], s[8 * sl + 1]); w.y = cvtpk(s[8 * sl + 2], s[8 * sl + 3]); w.z = cvtpk(s[8 * sl + 4], s[8 * sl + 5]); w.w = cvtpk(s[8 * sl + 6], s[8 * sl + 7]);
            pk[sl] = __builtin_bit_cast(bf16x8, w); }
#pragma unroll
        for (int sl = 0; sl < 2; ++sl) {
            const s16x4 a_lo = vtr(ta0 + 2048 * sl), a_hi = vtr(ta0 + 2048 * sl + 1024);
            const s16x4 b_lo = vtr(ta1 + 2048 * sl), b_hi = vtr(ta1 + 2048 * sl + 1024);
            const bf16x8 va = (bf16x8){a_lo[0], a_lo[1], a_lo[2], a_lo[3], a_hi[0], a_hi[1], a_hi[2], a_hi[3]};
            const bf16x8 vb = (bf16x8){b_lo[0], b_lo[1], b_lo[2], b_lo[3], b_hi[0], b_hi[1], b_hi[2], b_hi[3]};
            o0 = __builtin_amdgcn_mfma_f32_32x32x16_bf16(va, pk[sl], o0, 0, 0, 0);
            o1 = __builtin_amdgcn_mfma_f32_32x32x16_bf16(vb, pk[sl], o1, 0, 0, 0);
        }
    }
    const size_t qrow = (size_t)(rowb + tq0 + dil * r32);
    if (MODE == 0) {
        const float inv = 1.0f / l_run;
        bf16* op = OP + qrow * 512 + head * 64 + 4 * hi;
#pragma unroll
        for (int a = 0; a < 4; ++a) {
            u32x2g w0, w1; w0.x = cvtpk(o0[4 * a] * inv, o0[4 * a + 1] * inv); w0.y = cvtpk(o0[4 * a + 2] * inv, o0[4 * a + 3] * inv);
            w1.x = cvtpk(o1[4 * a] * inv, o1[4 * a + 1] * inv); w1.y = cvtpk(o1[4 * a + 2] * inv, o1[4 * a + 3] * inv);
            *(GAS u32x2g*)(op + 8 * a) = w0; *(GAS u32x2g*)(op + 32 + 8 * a) = w1; }
        if (hi == 0) LS[qrow * 8 + head] = m_run + __builtin_amdgcn_logf(l_run);
    } else if (MODE == 1) {
        const float l2 = LS2[qrow * 8 + head], l3 = LS3[qrow * 8 + head];
        const float M = fmaxf(m_run, fmaxf(l2, l3));
        const float w1 = __builtin_amdgcn_exp2f(m_run - M), w2 = __builtin_amdgcn_exp2f(l2 - M), w3 = __builtin_amdgcn_exp2f(l3 - M);
        const float inv = 1.0f / (l_run * w1 + w2 + w3);
        const float c1 = w1 * inv, c2 = w2 * inv, c3 = w3 * inv;
        const bf16* p2 = OP2 + qrow * 512 + head * 64 + 4 * hi; const bf16* p3 = OP3 + qrow * 512 + head * 64 + 4 * hi;
        bf16* op = ATT + qrow * D + acol + 4 * hi;
#pragma unroll
        for (int a = 0; a < 4; ++a) {
            const u32x2g a2 = *(const GAS u32x2g*)(p2 + 8 * a), b2 = *(const GAS u32x2g*)(p2 + 32 + 8 * a), a3 = *(const GAS u32x2g*)(p3 + 8 * a), b3 = *(const GAS u32x2g*)(p3 + 32 + 8 * a);
            float x0[4], x1[4];
            x0[0] = o0[4 * a] * c1 + bf_lo(a2.x) * c2 + bf_lo(a3.x) * c3; x0[1] = o0[4 * a + 1] * c1 + bf_hi(a2.x) * c2 + bf_hi(a3.x) * c3;
            x0[2] = o0[4 * a + 2] * c1 + bf_lo(a2.y) * c2 + bf_lo(a3.y) * c3; x0[3] = o0[4 * a + 3] * c1 + bf_hi(a2.y) * c2 + bf_hi(a3.y) * c3;
            x1[0] = o1[4 * a] * c1 + bf_lo(b2.x) * c2 + bf_lo(b3.x) * c3; x1[1] = o1[4 * a + 1] * c1 + bf_hi(b2.x) * c2 + bf_hi(b3.x) * c3;
            x1[2] = o1[4 * a + 2] * c1 + bf_lo(b2.y) * c2 + bf_lo(b3.y) * c3; x1[3] = o1[4 * a + 3] * c1 + bf_hi(b2.y) * c2 + bf_hi(b3.y) * c3;
            u32x2g w0, w1v; w0.x = cvtpk(x0[0], x0[1]); w0.y = cvtpk(x0[2], x0[3]); w1v.x = cvtpk(x1[0], x1[1]); w1v.y = cvtpk(x1[2], x1[3]);
            *(GAS u32x2g*)(op + 8 * a) = w0; *(GAS u32x2g*)(op + 32 + 8 * a) = w1v; }
    } else {
        const float inv = 1.0f / l_run;
        bf16* op = ATT + qrow * D + acol + 4 * hi;
#pragma unroll
        for (int a = 0; a < 4; ++a) {
            u32x2g w0, w1; w0.x = cvtpk(o0[4 * a] * inv, o0[4 * a + 1] * inv); w0.y = cvtpk(o0[4 * a + 2] * inv, o0[4 * a + 3] * inv);
            w1.x = cvtpk(o1[4 * a] * inv, o1[4 * a + 1] * inv); w1.y = cvtpk(o1[4 * a + 2] * inv, o1[4 * a + 3] * inv);
            *(GAS u32x2g*)(op + 8 * a) = w0; *(GAS u32x2g*)(op + 32 + 8 * a) = w1; }
    }
}

struct SPart { float m, l; f32x4 o; };
__device__ __forceinline__ void sample_scan(const float* kbase, const float* vbase, const float* knew, const float* vnew, int L, int rstride, int dil, const f32x4 q4, int lane, float& m_run, float& l_run, f32x4& o4) {
    const int sub = lane & 15, ks = lane >> 4;
#pragma unroll 4
    for (int st = 0; st < 33; ++st) {
        const int k = 4 * st + ks; const bool valid = k <= 128; const int idx = L - dil * (valid ? k : 128);
        const float* kp = (idx == L) ? knew : kbase + (size_t)idx * rstride; const float* vp = (idx == L) ? vnew : vbase + (size_t)idx * rstride;
        const f32x4 k4 = *((const GAS f32x4*)kp + sub), v4 = *((const GAS f32x4*)vp + sub);
        float s = (k4.x * q4.x + k4.y * q4.y) + (k4.z * q4.z + k4.w * q4.w);
        s += __shfl_xor(s, 1); s += __shfl_xor(s, 2); s += __shfl_xor(s, 4); s += __shfl_xor(s, 8);
        if (!valid) s = -INFINITY;
        const float m_new = fmaxf(m_run, s); const float alpha = __builtin_amdgcn_exp2f(m_run - m_new), p = __builtin_amdgcn_exp2f(s - m_new);
        l_run = l_run * alpha + p; o4 = o4 * alpha + v4 * p; m_run = m_new;
    }
}
__device__ __forceinline__ void sample_merge4(float& m_run, float& l_run, f32x4& o4) {
#pragma unroll
    for (int x = 16; x <= 32; x <<= 1) {
        const float mo = __shfl_xor(m_run, x), lo = __shfl_xor(l_run, x);
        f32x4 oo; oo.x = __shfl_xor(o4.x, x); oo.y = __shfl_xor(o4.y, x); oo.z = __shfl_xor(o4.z, x); oo.w = __shfl_xor(o4.w, x);
        const float M = fmaxf(m_run, mo), a = __builtin_amdgcn_exp2f(m_run - M), c = __builtin_amdgcn_exp2f(mo - M);
        l_run = l_run * a + lo * c; o4 = o4 * a + oo * c; m_run = M;
    }
}

__device__ __forceinline__ void attention_phase(Frame& F, const Args& A) {
    unsigned char* ws = A.ws;
    const bf16* QKV = (const bf16*)(ws + WS_QKV); bf16* ATT = (bf16*)(ws + WS_ATT);
    bf16* OP2 = (bf16*)(ws + WS_OP2); bf16* OP3 = (bf16*)(ws + WS_OP3); float* LS2 = (float*)(ws + WS_LS2); float* LS3 = (float*)(ws + WS_LS3);
    const int lane = F.lane, w = F.wave;
    LAS unsigned char* vt = F.lds + RING_OFF + w * 4096;
    LAS float* spart = (LAS float*)(F.lds + RING_OFF + 32768);
    const float* sinks = A.in[16];
    for (int u = F.vcu; u < 256; u += F.G) {
        const int b = u >> 7, h = (u >> 4) & 7, T0 = (u & 15) * 512;
#pragma unroll 1
        for (int k = 0; k < 2; ++k) attn_task<0>(QKV, b, 64 * h, 512 + 64 * h, 1024 + 64 * h, T0 + 2 * w + k, 16, vt, lane, OP3, LS3, h, 0.f, nullptr, nullptr, nullptr, nullptr, nullptr, 0);
#pragma unroll 1
        for (int k = 0; k < 2; ++k) { const int task = 2 * w + k; attn_task<0>(QKV, b, 64 * h, 512 + 64 * h, 1024 + 64 * h, T0 + 128 * (task >> 2) + (task & 3), 4, vt, lane, OP2, LS2, h, 0.f, nullptr, nullptr, nullptr, nullptr, nullptr, 0); }
#pragma unroll 1
        for (int k = 0; k < 2; ++k) attn_task<2>(QKV, b, 1536 + 64 * h, 2048 + 64 * (h >> 2), 2176 + 64 * (h >> 2), T0 + 32 * (2 * w + k), 1, vt, lane, nullptr, nullptr, h, sinks[h] * 1.4426950408889634f, nullptr, nullptr, nullptr, nullptr, ATT, 512 + 64 * h);
        if (u < 256) {
#pragma unroll 1
            for (int k = 0; k < 2; ++k) { const int task = w + 8 * k;
                const int sub = lane & 15;
                if (task < 12) {
                    const int pair = 4 * u + task / 3, pat = task % 3, sb = pair >> 3, sh = pair & 7, dil = pat == 0 ? 1 : (pat == 1 ? 4 : 16);
                    const bf16* qp = QKV + (size_t)(MP + sb) * NIN + 64 * sh + 4 * sub; const unsigned long long qw = *(const GAS unsigned long long*)qp;
                    const f32x4 q4 = (f32x4){bf_lo((unsigned)qw), bf_hi((unsigned)qw), bf_lo((unsigned)(qw >> 32)), bf_hi((unsigned)(qw >> 32))};
                    float m_run = -INFINITY, l_run = 0.f; f32x4 o4 = {0.f, 0.f, 0.f, 0.f};
                    sample_scan(A.in[2] + ((size_t)sb * LA * 8 + sh) * 64, A.in[3] + ((size_t)sb * LA * 8 + sh) * 64,
                                A.out + O_AKS + ((size_t)(sb * LA + LA - 1) * 8 + sh) * 64, A.out + O_AVS + ((size_t)(sb * LA + LA - 1) * 8 + sh) * 64, LA, 512, dil, q4, lane, m_run, l_run, o4);
                    sample_merge4(m_run, l_run, o4);
                    if (lane < 16) { LAS float* sp = spart + (task * 16 + sub) * 6; sp[0] = m_run; sp[1] = l_run; sp[2] = o4.x; sp[3] = o4.y; sp[4] = o4.z; sp[5] = o4.w; }
                } else {
                    const int pair = 4 * u + (task - 12), sb = pair >> 3, sh = pair & 7, kv = sh >> 2;
                    const bf16* qp = QKV + (size_t)(MP + sb) * NIN + 1536 + 64 * sh + 4 * sub; const unsigned long long qw = *(const GAS unsigned long long*)qp;
                    const f32x4 q4 = (f32x4){bf_lo((unsigned)qw), bf_hi((unsigned)qw), bf_lo((unsigned)(qw >> 32)), bf_hi((unsigned)(qw >> 32))};
                    float m_run = (lane < 16) ? sinks[sh] * 1.4426950408889634f : -INFINITY, l_run = (lane < 16) ? 1.0f : 0.f; f32x4 o4 = {0.f, 0.f, 0.f, 0.f};
                    sample_scan(A.in[4] + ((size_t)sb * LB * 2 + kv) * 64, A.in[5] + ((size_t)sb * LB * 2 + kv) * 64,
                                A.out + O_BKS + ((size_t)(sb * LB + LB - 1) * 2 + kv) * 64, A.out + O_BVS + ((size_t)(sb * LB + LB - 1) * 2 + kv) * 64, LB, 128, 1, q4, lane, m_run, l_run, o4);
                    sample_merge4(m_run, l_run, o4);
                    if (lane < 16) { const float inv = 1.0f / l_run; bf16* op = ATT + (size_t)(MP + sb) * D + 512 + 64 * sh + 4 * sub;
                        *(GAS unsigned long long*)op = (unsigned long long)cvtpk(o4.x * inv, o4.y * inv) | ((unsigned long long)cvtpk(o4.z * inv, o4.w * inv) << 32); }
                }
            }
        }
        __builtin_amdgcn_fence(__ATOMIC_RELEASE, "workgroup"); __syncthreads(); __builtin_amdgcn_fence(__ATOMIC_ACQUIRE, "workgroup");
#pragma unroll 1
        for (int k = 0; k < 2; ++k) attn_task<1>(QKV, b, 64 * h, 512 + 64 * h, 1024 + 64 * h, T0 + 32 * (2 * w + k), 1, vt, lane, nullptr, nullptr, h, 0.f, OP2, OP3, LS2, LS3, ATT, 64 * h);
        if (w < 4 && lane < 16) {
            const int pair = 4 * u + w, sb = pair >> 3, sh = pair & 7, sub = lane;
            float m_run = -INFINITY, l_run = 0.f; f32x4 o4 = {0.f, 0.f, 0.f, 0.f};
#pragma unroll
            for (int p = 0; p < 3; ++p) { const LAS float* sp = spart + ((3 * w + p) * 16 + sub) * 6; const float mo = sp[0], lo = sp[1]; const f32x4 oo = (f32x4){sp[2], sp[3], sp[4], sp[5]};
                const float M = fmaxf(m_run, mo), a = __builtin_amdgcn_exp2f(m_run - M), c = __builtin_amdgcn_exp2f(mo - M);
                l_run = l_run * a + lo * c; o4 = o4 * a + oo * c; m_run = M; }
            const float inv = 1.0f / l_run; bf16* op = ATT + (size_t)(MP + sb) * D + 64 * sh + 4 * sub;
            *(GAS unsigned long long*)op = (unsigned long long)cvtpk(o4.x * inv, o4.y * inv) | ((unsigned long long)cvtpk(o4.z * inv, o4.w * inv) << 32);
        }
        __syncthreads();
    }
}

__global__ void __launch_bounds__(NWAVES * 64, 2) fwd_kernel(Args args) {
    extern __shared__ __attribute__((aligned(16))) unsigned char lds[];
    Frame F;
    F.lds = (LAS unsigned char*)lds;
    F.MISC = (volatile LAS unsigned*)(F.lds + MISC_OFF);
    F.tid = threadIdx.x; F.lane = F.tid & 63; F.wave = __builtin_amdgcn_readfirstlane(F.tid >> 6);
    F.G = gridDim.x; { const int bx = blockIdx.x; F.vcu = (F.G % 8 == 0) ? (bx % 8) * (F.G / 8) + bx / 8 : bx; }
    unsigned char* ws = args.ws;
    F.ctl = (gu32*)(ws + WS_CTL);
    for (int u = F.tid; u < (LDS_BYTES - LDSCTL_OFF) / 4; u += NWAVES * 64) ((LAS unsigned*)(F.lds + LDSCTL_OFF))[u] = 0u;
    __syncthreads();
    XcdBarrier bar = xcd_barrier_post((unsigned*)(F.ctl + CW_BAR), F.MISC + 8);
#define GRID_BAR() xcd_barrier(bar)

    bf16* XB = (bf16*)(ws + WS_XB); float* RS = (float*)(ws + WS_RS); bf16* ACT = (bf16*)(ws + WS_ACT); bf16* Y = (bf16*)(ws + WS_Y);
    bf16* QKV = (bf16*)(ws + WS_QKV); bf16* ATT = (bf16*)(ws + WS_ATT); bf16* PB = (bf16*)(ws + WS_PB); bf16* PP = (bf16*)(ws + WS_PP);

#ifndef SKIP_P0
    p0_prologue(F, args);
#endif
    GRID_BAR();
#ifndef SKIP_P1
    { pg8::Gemm g{XB, (const bf16*)(ws + WS_WGU1), MT, 2 * FF, D}; pg8::StaticOrder S; S.init(MT, 2 * FF, F.G, (int)blockIdx.x);
      pg8::EpiSwiGLU E{ACT, FF, RS};
      pg8::gemm_phase<pg8::EpiSwiGLU, pg8::StaticOrder, PG8_ALIGN, PG8_SP2>(F.lds + RING_OFF, g, S, E); }
#endif
    GRID_BAR();
#ifndef SKIP_P2
    { pg8::Gemm g{ACT, (const bf16*)(ws + WS_WD1), MT, D, FF}; pg8::StaticOrder S; S.init(MT, D, F.G, (int)blockIdx.x);
      pg8::EpiPlain E{Y, D};
      pg8::gemm_phase<pg8::EpiPlain, pg8::StaticOrder, PG8_ALIGN, PG8_SP2>(F.lds + RING_OFF, g, S, E); }
#endif
    GRID_BAR();
#ifndef SKIP_NORM
    norm_phase<0>(F, args, args.in[9], 0.5f);
#endif
    GRID_BAR();
#ifndef SKIP_P3
    { pg8::Gemm g{XB, (const bf16*)(ws + WS_WIN), MT, NIN, D}; pg8::StaticOrder S; S.init(MT, NIN, F.G, (int)blockIdx.x);
      pg8::EpiRope E{QKV, RS, (const float*)(ws + WS_ROPE), args.out};
      pg8::gemm_phase<pg8::EpiRope, pg8::StaticOrder, PG8_ALIGN, PG8_SP2>(F.lds + RING_OFF, g, S, E); }
#endif
#ifndef SKIP_P3B
    { pg8::Gemm g{PB, (const bf16*)(ws + WS_WPP), MT, D, DPLE}; pg8::StaticOrder S; S.init(MT, D, F.G, (int)blockIdx.x);
      pg8::EpiPlain E{PP, D};
      pg8::gemm_phase<pg8::EpiPlain, pg8::StaticOrder, PG8_ALIGN, PG8_SP2>(F.lds + RING_OFF, g, S, E); }
#endif
    GRID_BAR();
#ifndef SKIP_P4
    attention_phase(F, args);
#endif
    GRID_BAR();
#ifndef SKIP_P5
    { pg8::Gemm g{ATT, (const bf16*)(ws + WS_WOUT), MT, D, D}; pg8::StaticOrder S; S.init(MT, D, F.G, (int)blockIdx.x);
      pg8::EpiPlain E{Y, D};
      pg8::gemm_phase<pg8::EpiPlain, pg8::StaticOrder, PG8_ALIGN, PG8_SP2>(F.lds + RING_OFF, g, S, E); }
#endif
    GRID_BAR();
#ifndef SKIP_NORM
    norm_phase<1>(F, args, args.in[14], 1.0f);
#endif
    GRID_BAR();
#ifndef SKIP_P6
    { pg8::Gemm g{XB, (const bf16*)(ws + WS_WGU2), MT, 2 * FF, D}; pg8::StaticOrder S; S.init(MT, 2 * FF, F.G, (int)blockIdx.x);
      pg8::EpiSwiGLU E{ACT, FF, RS};
      pg8::gemm_phase<pg8::EpiSwiGLU, pg8::StaticOrder, PG8_ALIGN, PG8_SP2>(F.lds + RING_OFF, g, S, E); }
#endif
    GRID_BAR();
#ifndef SKIP_P7
    { pg8::Gemm g{ACT, (const bf16*)(ws + WS_WD2), MT, D, FF}; pg8::StaticOrder S; S.init(MT, D, F.G, (int)blockIdx.x);
      pg8::EpiPlain E{Y, D};
      pg8::gemm_phase<pg8::EpiPlain, pg8::StaticOrder, PG8_ALIGN, PG8_SP2>(F.lds + RING_OFF, g, S, E); }
#endif
    GRID_BAR();
#ifndef SKIP_NORM
    norm_phase<1>(F, args, args.in[19], 0.5f);
#endif
    GRID_BAR();
#ifndef SKIP_P8
    { pg8::Gemm g{XB, (const bf16*)(ws + WS_WPG), MT, D, D}; pg8::StaticOrder S; S.init(MT, D, F.G, (int)blockIdx.x);
      pg8::EpiPle E{Y, D, RS, PP};
      pg8::gemm_phase<pg8::EpiPle, pg8::StaticOrder, PG8_ALIGN, PG8_SP2>(F.lds + RING_OFF, g, S, E); }
#endif
    GRID_BAR();
#ifndef SKIP_NORM
    norm_phase<2>(F, args, args.in[24], 1.0f);
#endif
#undef GRID_BAR
}

extern "C" void kernel_launch(void* const* d_in, const int* in_sizes, int n_in, void* d_out, int out_size, void* d_ws, size_t ws_size, hipStream_t stream) {
    static int grid = 0;
    if (grid == 0) {
        if (n_in != 27 || (size_t)out_size != O_END || ws_size < WS_END) { fprintf(stderr, "kernel_launch: unexpected shapes (n_in %d, out %d, ws %zu); nothing launched\n", n_in, out_size, ws_size); grid = -1; return; }
        int dev = 0, cus = 0, per_cu = 0;
        if (hipGetDevice(&dev) != hipSuccess || hipDeviceGetAttribute(&cus, hipDeviceAttributeMultiprocessorCount, dev) != hipSuccess) { grid = -1; return; }
        if (hipFuncSetAttribute((const void*)fwd_kernel, hipFuncAttributeMaxDynamicSharedMemorySize, LDS_BYTES) != hipSuccess) { fprintf(stderr, "kernel_launch: hipFuncSetAttribute failed\n"); grid = -1; return; }
        if (hipOccupancyMaxActiveBlocksPerMultiprocessor(&per_cu, (const void*)fwd_kernel, NWAVES * 64, LDS_BYTES) != hipSuccess || per_cu < 1) { fprintf(stderr, "kernel_launch: occupancy query says %d blocks per CU\n", per_cu); per_cu = 1; }
        (void)hipGetLastError();
        grid = cus;
    }
    if (grid < 0) return;
    if (hipMemsetAsync((char*)d_ws + WS_CTL, 0, CTL_ZERO_BYTES, stream) != hipSuccess) return;
    Args a{};
    for (int i = 0; i < 27; ++i) a.in[i] = (const float*)d_in[i];
    a.out = (float*)d_out; a.ws = (unsigned char*)d_ws;
    hipLaunchKernelGGL(fwd_kernel, dim3(grid), dim3(NWAVES * 64), LDS_BYTES, stream, a);
}
```

```cpp
#include <hip/hip_runtime.h>
#include <cstdio>
#include <cstdint>
#include <cmath>

#ifndef PG8_SP2
#define PG8_SP2 true
#endif
#ifndef PG8_ALIGN
#define PG8_ALIGN true
#endif
constexpr int NWAVES = 8;
constexpr int D = 1024, FF = 2816, NIN = 2304, DPLE = 256, SEQ = 8192, NB = 2;
constexpr int MP = NB * SEQ;
constexpr int MS = 128;
constexpr int MR = MP + MS;
constexpr int MT = 65 * 256;
constexpr int LA = 2048, LB = 128, PAST = 16384;
constexpr float EPS = 1e-6f;
constexpr float QSCALE = 0.125f * 1.4426950408889634f;

constexpr size_t O_YP = 0, O_YS = O_YP + (size_t)MP * D, O_AKP = O_YS + (size_t)MS * D, O_AVP = O_AKP + (size_t)NB * 2048 * 512,
    O_BKP = O_AVP + (size_t)NB * 2048 * 512, O_BVP = O_BKP + (size_t)NB * 128 * 128, O_AKS = O_BVP + (size_t)NB * 128 * 128,
    O_AVS = O_AKS + (size_t)MS * LA * 512, O_BKS = O_AVS + (size_t)MS * LA * 512, O_BVS = O_BKS + (size_t)MS * LB * 128, O_END = O_BVS + (size_t)MS * LB * 128;
static_assert(O_END == 293797888ull, "output size");

namespace pg8 {
#define PG8_LAS __attribute__((address_space(3)))
typedef unsigned short bf16_t;
typedef short bf16x8 __attribute__((ext_vector_type(8)));
typedef float f32x4 __attribute__((ext_vector_type(4)));
typedef unsigned u32x4 __attribute__((ext_vector_type(4)));
constexpr int BM = 256, BK = 64, HALF = 128, HTB = HALF * BK * 2  , STAGE_BYTES = 8 * HTB, NXCD = 8, WGM = 8;

__host__ __device__ __forceinline__ int lds_byte(int r, int c) { const int st = (r >> 4) * 2 + (c >> 5), rr = r & 15, cc = c & 31, ob = rr * 64 + cc * 2; return st * 1024 + (ob ^ (((ob >> 9) & 1) << 5)); }
__host__ __device__ __forceinline__ void stage_rc(int b, int& R, int& C) { const int st = b / 1024, sb = b % 1024, swz = sb ^ (((sb >> 9) & 1) << 5); R = (st >> 1) * 16 + swz / 64; C = (st & 1) * 32 + (swz % 64) / 2; }
__host__ __device__ __forceinline__ int perm32(int rho) { const int n = rho >> 4, i = rho & 15; return 8 * (i >> 2) + 4 * n + (i & 3); }

struct Unit { int pm, pn, kt0, nkt; };
struct Gemm { const bf16_t* A; const bf16_t* Bt; int M, N, K; };

struct StaticOrder {
    int nM, nN, nwg, G, c;
    __host__ __device__ void init(int M, int N, int G_, int c_) { nM = M / BM; nN = N / BM; nwg = nM * nN; G = G_; c = c_; }
    __host__ __device__ bool next(int i, Unit& u) const {
        const long L = (long)i * G + c; if (L >= nwg) return false;
        int wgid = (int)L; { const int q = nwg / NXCD, r = nwg % NXCD, xcd = wgid % NXCD, off = wgid / NXCD; wgid = (xcd < r ? xcd * (q + 1) : r * (q + 1) + (xcd - r) * q) + off; }
        const int nig = WGM * nN, gid = wgid / nig, fm = gid * WGM, gsz = (nM - fm) < WGM ? (nM - fm) : WGM;
        u.pm = fm + ((wgid % nig) % gsz); u.pn = (wgid % nig) / gsz; return true;
    }
    __device__ __forceinline__ void a_ready(const Unit&) const {}
    __device__ __forceinline__ void done(const Unit&) const {}
};

struct SampleOrder {
    StaticOrder P; int nkt_full, nsplit, ns;
    __host__ __device__ void init(int Mp, int N, int K, int nsplit_, int G_, int c_) { P.init(Mp, N, G_, c_); nkt_full = K / BK; nsplit = nsplit_; ns = (N / BM) * nsplit_; }
    __host__ __device__ bool next(int i, Unit& u) const {
        Unit t; t.pm = 0; t.pn = 0; t.kt0 = 0; t.nkt = 0; int pm, pn, kt0 = 0, nkt = nkt_full;
        if (P.next(i, t)) { pm = t.pm; pn = t.pn; }
        else { const long L = (long)i * P.G + P.c - P.nwg; if (L < 0 || L >= ns) return false;
            const int s = (int)L, ks = s / P.nN; pm = P.nM; pn = s - ks * P.nN; nkt = nkt_full / nsplit; kt0 = ks * nkt; }
        u.pm = pm; u.pn = pn; u.kt0 = kt0; u.nkt = nkt; return true;
    }
    __device__ __forceinline__ void a_ready(const Unit&) const {}
    __device__ __forceinline__ void done(const Unit&) const {}
};
struct NoCopy { static constexpr bool ACTIVE = false; __device__ __forceinline__ void prime() {} template <int P> __device__ __forceinline__ void step() {} __device__ __forceinline__ void flush() {} };
struct StreamCopy {
    static constexpr bool ACTIVE = true;
    const unsigned char* src; unsigned char* dst; int cur, last; unsigned lane_off; f32x4 buf0, buf1; unsigned off0, off1;
    __device__ __forceinline__ unsigned chunk_off() { const int c = cur < last ? cur : last; cur += 8; return (unsigned)c * 1024u + lane_off; }
    static __device__ __forceinline__ void ld(f32x4& v, unsigned off, const unsigned char* base) { asm volatile("global_load_dwordx4 %0, %1, %2 nt" : "=v"(v) : "v"(off), "s"(base) : "memory"); }
    static __device__ __forceinline__ void st_w10(const f32x4& v, unsigned off, unsigned char* base) { asm volatile("s_waitcnt vmcnt(10)\n\tglobal_store_dwordx4 %0, %1, %2 nt" : : "v"(off), "v"(v), "s"(base) : "memory"); }
    static __device__ __forceinline__ void st(const f32x4& v, unsigned off, unsigned char* base) { asm volatile("global_store_dwordx4 %0, %1, %2 nt" : : "v"(off), "v"(v), "s"(base) : "memory"); }
    __device__ __forceinline__ void prime() { off0 = chunk_off(); ld(buf0, off0, src); off1 = chunk_off(); ld(buf1, off1, src); }
    template <int P> __device__ __forceinline__ void step() {
        if (P == 0) { st_w10(buf0, off0, dst); off0 = chunk_off(); ld(buf0, off0, src); }
        else        { st_w10(buf1, off1, dst); off1 = chunk_off(); ld(buf1, off1, src); }
    }
    __device__ __forceinline__ void flush() { st(buf0, off0, dst); st(buf1, off1, dst); }
};

__device__ __forceinline__ unsigned cvt_pk_bf16(float lo, float hi) { unsigned r; asm volatile("v_cvt_pk_bf16_f32 %0, %1, %2" : "=v"(r) : "v"(lo), "v"(hi)); return r; }
typedef float f32x2 __attribute__((ext_vector_type(2)));

typedef unsigned u32x2 __attribute__((ext_vector_type(2)));
__device__ __forceinline__ float fast_sigmoid(float x) { return __builtin_amdgcn_rcpf(1.0f + __builtin_amdgcn_exp2f(-1.4426950408889634f * x)); }

__device__ __forceinline__ void store_slab(float* slab, const f32x4 (&acc)[2][2][4][2], const Unit& u, int wr, int wc, int fr, int fq) {
    const int ks = u.kt0 / u.nkt; float* base = slab + ((size_t)ks * 128 + wr * 64 + fr) * 1024 + u.pn * BM + wc * 32 + 8 * fq;
#pragma unroll
    for (int m = 0; m < 4; ++m)
#pragma unroll
        for (int bj = 0; bj < 2; ++bj) { float* p = base + (size_t)m * 16 * 1024 + bj * HALF; *(f32x4*)p = acc[0][bj][m][0]; *(f32x4*)(p + 4) = acc[0][bj][m][1]; }
}
struct EpiPlain {
    static constexpr bool PERM = true, AFTER_DRAIN = false;
    bf16_t* O; int ldc; float* slab;
    __device__ __forceinline__ void operator()(const f32x4 (&acc)[2][2][4][2], const Unit& u, int wr, int wc, int fr, int fq) const {
        if (slab != nullptr && u.pm == MP / BM) { store_slab(slab, acc, u, wr, wc, fr, fq); return; }
        const int row0 = u.pm * BM + wr * 64 + fr, col0 = u.pn * BM + wc * 32 + 8 * fq;
#pragma unroll
        for (int ai = 0; ai < 2; ++ai)
#pragma unroll
            for (int m = 0; m < 4; ++m) { bf16_t* rowp = O + (size_t)(row0 + ai * HALF + m * 16) * ldc + col0;
#pragma unroll
                for (int bj = 0; bj < 2; ++bj) { const f32x4 v0 = acc[ai][bj][m][0], v1 = acc[ai][bj][m][1];
                    u32x4 w; w.x = cvt_pk_bf16(v0[0], v0[1]); w.y = cvt_pk_bf16(v0[2], v0[3]); w.z = cvt_pk_bf16(v1[0], v1[1]); w.w = cvt_pk_bf16(v1[2], v1[3]);
                    *(u32x4*)(rowp + bj * HALF) = w; } }
    }
};

struct EpiSwiGLU {
    static constexpr bool PERM = true, AFTER_DRAIN = false;
    bf16_t* O; int ldc; const float* rs;
    __device__ __forceinline__ void operator()(const f32x4 (&acc)[2][2][4][2], const Unit& u, int wr, int wc, int fr, int fq) const {
        const int row0 = u.pm * BM + wr * 64 + fr, col0 = u.pn * HALF + wc * 32 + 8 * fq;
#pragma unroll
        for (int ai = 0; ai < 2; ++ai)
#pragma unroll
            for (int m = 0; m < 4; ++m) { const int row = row0 + ai * HALF + m * 16; const float r = rs[row];
                unsigned w[4];
#pragma unroll
                for (int bj = 0; bj < 2; ++bj) { const f32x4 g = acc[ai][bj][m][0] * r, up = acc[ai][bj][m][1] * r; float o[4];
#pragma unroll
                    for (int i = 0; i < 4; ++i) o[i] = g[i] * fast_sigmoid(g[i]) * up[i];
                    w[2 * bj] = cvt_pk_bf16(o[0], o[1]); w[2 * bj + 1] = cvt_pk_bf16(o[2], o[3]); }
                u32x4 wv; wv.x = w[0]; wv.y = w[1]; wv.z = w[2]; wv.w = w[3];
                *(u32x4*)(O + (size_t)row * ldc + col0) = wv; }
    }
};

struct EpiRope {
    static constexpr bool PERM = true, AFTER_DRAIN = false;
    bf16_t* O; const float* rs; const float* rope;
    float* out;
    __device__ __forceinline__ void operator()(const f32x4 (&acc)[2][2][4][2], const Unit& u, int wr, int wc, int fr, int fq) const {
        const int pn = u.pn; const int row0 = u.pm * BM + wr * 64 + fr;
        const int d0 = 16 * (wc & 1) + 4 * fq;
        const bool is_s = u.pm >= MP / BM;
#pragma unroll
        for (int ai = 0; ai < 2; ++ai)
#pragma unroll
            for (int m = 0; m < 4; ++m) { const int row = row0 + ai * HALF + m * 16; const float r = rs[row];
                const int t = is_s ? 0 : (row & (SEQ - 1)); const int b = is_s ? (row - MP) : (row / SEQ);
                const float* rp = rope + (unsigned)((is_s ? SEQ : t) * 64 + 2 * d0);
                const f32x4 cs0 = *(const f32x4*)rp, cs1 = *(const f32x4*)(rp + 4);
#pragma unroll
                for (int bj = 0; bj < 2; ++bj) {
                    const int hl = 2 * bj + (wc >> 1);
                    const bool rot = (pn < 4) || (pn == 6) || (pn == 7) || (pn == 8 && bj == 0);
                    const bool isq = (pn < 2) || (pn == 6) || (pn == 7);
                    f32x4 x1 = acc[ai][bj][m][0] * r, x2 = acc[ai][bj][m][1] * r;
                    if (rot) {
                        const f32x4 c = (f32x4){cs0[0], cs0[2], cs1[0], cs1[2]}, s = (f32x4){cs0[1], cs0[3], cs1[1], cs1[3]};
                        const f32x4 a = x1, bb = x2; x1 = a * c - bb * s; x2 = bb * c + a * s; }
                    long doff = -1;
                    if (pn >= 2 && pn <= 5) {
                        const int head = 4 * (pn & 1) + hl; const size_t base = (pn < 4) ? (is_s ? O_AKS : O_AKP) : (is_s ? O_AVS : O_AVP);
                        if (is_s) { if (row < MP + MS) doff = (long)(base + ((size_t)(b * 2048 + 2047) * 8 + head) * 64); }
                        else if (t >= SEQ - 2048) doff = (long)(base + ((size_t)(b * 2048 + (t - (SEQ - 2048))) * 8 + head) * 64);
                    } else if (pn == 8) {
                        const int kvh = wc >> 1; const size_t base = (bj == 0) ? (is_s ? O_BKS : O_BKP) : (is_s ? O_BVS : O_BVP);
                        if (is_s) { if (row < MP + MS) doff = (long)(base + ((size_t)(b * 128 + 127) * 2 + kvh) * 64); }
                        else if (t >= SEQ - 128) doff = (long)(base + ((size_t)(b * 128 + (t - (SEQ - 128))) * 2 + kvh) * 64);
                    }
                    if (doff >= 0) { float* dst = out + doff; *(f32x4*)(dst + d0) = x1; *(f32x4*)(dst + d0 + 32) = x2; }
                    if (isq) { x1 = x1 * QSCALE; x2 = x2 * QSCALE; }
                    bf16_t* op = O + (size_t)row * 2304 + pn * BM + 64 * hl + d0;
                    u32x2 w1, w2; w1.x = cvt_pk_bf16(x1[0], x1[1]); w1.y = cvt_pk_bf16(x1[2], x1[3]); w2.x = cvt_pk_bf16(x2[0], x2[1]); w2.y = cvt_pk_bf16(x2[2], x2[3]);
                    *(u32x2*)op = w1; *(u32x2*)(op + 32) = w2; } }
    }
};

struct EpiPle {
    static constexpr bool PERM = true, AFTER_DRAIN = false;
    bf16_t* O; int ldc; const float* rs; const bf16_t* PP; float* slab;
    __device__ __forceinline__ void operator()(const f32x4 (&acc)[2][2][4][2], const Unit& u, int wr, int wc, int fr, int fq) const {
        if (u.pm == MP / BM) { store_slab(slab, acc, u, wr, wc, fr, fq); return; }
        const int row0 = u.pm * BM + wr * 64 + fr, col0 = u.pn * BM + wc * 32 + 8 * fq;
#pragma unroll
        for (int ai = 0; ai < 2; ++ai)
#pragma unroll
            for (int m = 0; m < 4; ++m) { const int row = row0 + ai * HALF + m * 16; const float r = rs[row]; const size_t off = (size_t)row * ldc + col0;
#pragma unroll
                for (int bj = 0; bj < 2; ++bj) { const u32x4 pp = *(const u32x4*)(PP + off + bj * HALF);
                    const f32x4 v0 = acc[ai][bj][m][0] * r, v1 = acc[ai][bj][m][1] * r; float o[8];
#pragma unroll
                    for (int i = 0; i < 4; ++i) { const unsigned pw0 = pp[i >> 1], pw1 = pp[2 + (i >> 1)];
                        const float p0 = __uint_as_float((i & 1) ? (pw0 & 0xffff0000u) : (pw0 << 16)), p1 = __uint_as_float((i & 1) ? (pw1 & 0xffff0000u) : (pw1 << 16));
                        o[i] = fast_sigmoid(v0[i]) * p0; o[4 + i] = fast_sigmoid(v1[i]) * p1; }
                    u32x4 w; w.x = cvt_pk_bf16(o[0], o[1]); w.y = cvt_pk_bf16(o[2], o[3]); w.z = cvt_pk_bf16(o[4], o[5]); w.w = cvt_pk_bf16(o[6], o[7]);
                    *(u32x4*)(O + off + bj * HALF) = w; } }
    }
};

template <class Epi, class Sched, class Copy, bool ALIGN_EPI = false, bool SP2 = false>
__device__ __forceinline__ void gemm_phase(PG8_LAS unsigned char* lds, const Gemm g, const Sched& S, const Epi& E, Copy& C) {
    int tid_ = threadIdx.x; asm volatile("" : "+v"(tid_));
    const int tid = tid_, wid = __builtin_amdgcn_readfirstlane(tid >> 6), lane = tid & 63, wr = wid >> 2, wc = wid & 3, fr = lane & 15, fq = lane >> 4;
    const int K = g.K;
    unsigned voffA[2], voffB[2];
#pragma unroll
    for (int i = 0; i < 2; ++i) { int R, C; stage_rc(tid * 16 + i * 8192, R, C); const int Rb = Epi::PERM ? ((R & ~31) + perm32(R & 31)) : R;
        voffA[i] = (unsigned)(R * K + C) * 2u; voffB[i] = (unsigned)(Rb * K + C) * 2u; }
    const size_t kstep = (size_t)(BK * 2);
    const size_t hstep = (size_t)HALF * K * 2;
    const size_t tstep = 2 * hstep;
    const unsigned ldsw = (unsigned)wid * 1024u;
    const int aoff = lds_byte(wr * 64 + fr, fq * 8), boff = lds_byte(wc * 32 + fr, fq * 8);
#define PG8_SA(b, h) (((b) * 2 + (h)) * HTB)
#define PG8_SB(b, h) ((4 + (b) * 2 + (h)) * HTB)
#define PG8_STAGE(bufoff, gbase, voff) do { _Pragma("unroll") for (int _i = 0; _i < 2; ++_i) \
        __builtin_amdgcn_global_load_lds((const unsigned*)((const char*)(gbase) + (voff)[_i]), (PG8_LAS unsigned*)(lds + (bufoff) + ldsw + _i * 8192), 16, 0, 0); } while (0)
#define PG8_LDA(dst, b, h) do { _Pragma("unroll") for (int m = 0; m < 4; ++m) _Pragma("unroll") for (int k = 0; k < 2; ++k) dst[m][k] = *(const PG8_LAS bf16x8*)(lds + PG8_SA(b, h) + aoff + m * 2048 + k * 1024); } while (0)
#define PG8_LDB(dst, b, h) do { _Pragma("unroll") for (int n = 0; n < 2; ++n) _Pragma("unroll") for (int k = 0; k < 2; ++k) dst[n][k] = *(const PG8_LAS bf16x8*)(lds + PG8_SB(b, h) + boff + n * 2048 + k * 1024); } while (0)
#define PG8_MMA(ai, bj, At, Bt) do { __builtin_amdgcn_s_setprio(1); _Pragma("unroll") for (int m = 0; m < 4; ++m) _Pragma("unroll") for (int n = 0; n < 2; ++n) _Pragma("unroll") for (int k = 0; k < 2; ++k) \
        acc[ai][bj][m][n] = __builtin_amdgcn_mfma_f32_16x16x32_bf16(Bt[n][k], At[m][k], acc[ai][bj][m][n], 0, 0, 0); __builtin_amdgcn_s_setprio(0); } while (0)
#define PG8_WAIT_V(n) asm volatile("s_waitcnt vmcnt(" #n ")" ::: "memory")
#define PG8_WAIT_L(n) asm volatile("s_waitcnt lgkmcnt(" #n ")" ::: "memory")
#define PG8_WAIT_VC do { if constexpr (Copy::ACTIVE) { PG8_WAIT_V(12); } else { PG8_WAIT_V(8); } } while (0)
#define PG8_BAR __builtin_amdgcn_s_barrier()
#define PG8_SCHED __builtin_amdgcn_sched_barrier(0)
    Unit cur, nxt; int ui = 0;
    if (!S.next(0, cur)) return;
    f32x4 acc[2][2][4][2];
#pragma unroll
    for (int a = 0; a < 2; ++a)
#pragma unroll
        for (int b = 0; b < 2; ++b)
#pragma unroll
            for (int m = 0; m < 4; ++m)
#pragma unroll
                for (int n = 0; n < 2; ++n) acc[a][b][m][n] = (f32x4){0.f, 0.f, 0.f, 0.f};
    bf16x8 At[4][2], B0[2][2], B1[2][2];
    const char* cA = (const char*)g.A + (size_t)cur.pm * tstep + (size_t)cur.kt0 * kstep; const char* cB = (const char*)g.Bt + (size_t)cur.pn * tstep + (size_t)cur.kt0 * kstep;
    S.a_ready(cur);
    C.prime();
    if constexpr (SP2) {
        PG8_STAGE(PG8_SB(0, 0), cB, voffB); PG8_STAGE(PG8_SB(0, 1), cB + hstep, voffB); PG8_STAGE(PG8_SA(0, 0), cA, voffA); PG8_STAGE(PG8_SA(0, 1), cA + hstep, voffA);
        if (wr == 1) PG8_BAR;
        PG8_WAIT_V(2); PG8_BAR;
        PG8_STAGE(PG8_SB(1, 0), cB + kstep, voffB); PG8_STAGE(PG8_SA(1, 0), cA + kstep, voffA); PG8_STAGE(PG8_SB(1, 1), cB + hstep + kstep, voffB);
        PG8_WAIT_V(6); PG8_BAR;
    } else {
        PG8_STAGE(PG8_SB(0, 0), cB, voffB); PG8_STAGE(PG8_SA(0, 0), cA, voffA); PG8_STAGE(PG8_SB(0, 1), cB + hstep, voffB); PG8_STAGE(PG8_SA(0, 1), cA + hstep, voffA);
        if (wr == 1) PG8_BAR;
        PG8_WAIT_V(4); PG8_BAR;
        PG8_STAGE(PG8_SB(1, 0), cB + kstep, voffB); PG8_STAGE(PG8_SA(1, 0), cA + kstep, voffA); PG8_STAGE(PG8_SB(1, 1), cB + hstep + kstep, voffB);
        PG8_WAIT_V(6); PG8_BAR;
    }
    for (;;) {
        const bool has_next = S.next(ui + 1, nxt);
        const char* nA = has_next ? (const char*)g.A + (size_t)nxt.pm * tstep + (size_t)nxt.kt0 * kstep : cA; const char* nB = has_next ? (const char*)g.Bt + (size_t)nxt.pn * tstep + (size_t)nxt.kt0 * kstep : cB;
        const int nt = cur.nkt;
#pragma nounroll
        for (int t = 0; t < nt; t += 2) {
            const bool last = (t == nt - 2);
            const char* a1 = cA + (size_t)(t + 1) * kstep;
            const char* a2 = last ? nA : cA + (size_t)(t + 2) * kstep; const char* b2 = last ? nB : cB + (size_t)(t + 2) * kstep;
            const char* a3 = a2 + kstep; const char* b3 = b2 + kstep;
            if (last && has_next) S.a_ready(nxt);
            if constexpr (SP2) {
            PG8_LDB(B0, 0, 0); PG8_LDB(B1, 0, 1); PG8_SCHED; PG8_LDA(At, 0, 0); PG8_STAGE(PG8_SA(1, 1), a1 + hstep, voffA);
            C.template step<0>(); PG8_WAIT_VC; PG8_WAIT_L(0); PG8_BAR; PG8_MMA(0, 0, At, B0); PG8_MMA(0, 1, At, B1); PG8_BAR; PG8_SCHED;
            PG8_LDA(At, 0, 1); PG8_STAGE(PG8_SB(0, 0), b2, voffB); PG8_STAGE(PG8_SB(0, 1), b2 + hstep, voffB); PG8_STAGE(PG8_SA(0, 0), a2, voffA);
            C.template step<1>(); PG8_WAIT_VC; PG8_WAIT_L(0); PG8_BAR; PG8_MMA(1, 0, At, B0); PG8_MMA(1, 1, At, B1); PG8_BAR; PG8_SCHED;
            PG8_LDB(B0, 1, 0); PG8_LDB(B1, 1, 1); PG8_SCHED; PG8_LDA(At, 1, 0); PG8_STAGE(PG8_SA(0, 1), a2 + hstep, voffA);
            C.template step<0>(); PG8_WAIT_VC; PG8_WAIT_L(0); PG8_BAR; PG8_MMA(0, 0, At, B0); PG8_MMA(0, 1, At, B1); PG8_BAR; PG8_SCHED;
            PG8_LDA(At, 1, 1); PG8_STAGE(PG8_SB(1, 0), b3, voffB); PG8_STAGE(PG8_SB(1, 1), b3 + hstep, voffB); PG8_STAGE(PG8_SA(1, 0), a3, voffA);
            C.template step<1>(); PG8_WAIT_VC; PG8_WAIT_L(0); PG8_BAR; PG8_MMA(1, 0, At, B0); PG8_MMA(1, 1, At, B1); PG8_BAR; PG8_SCHED;
            } else {
            PG8_LDB(B0, 0, 0); PG8_SCHED; PG8_LDA(At, 0, 0); PG8_STAGE(PG8_SA(1, 1), a1 + hstep, voffA);
            PG8_WAIT_L(8); PG8_BAR; PG8_WAIT_L(0); PG8_MMA(0, 0, At, B0); PG8_BAR; PG8_SCHED;
            PG8_LDB(B1, 0, 1); PG8_STAGE(PG8_SB(0, 0), b2, voffB);
            PG8_BAR; PG8_WAIT_L(0); PG8_MMA(0, 1, At, B1); PG8_BAR;
            PG8_LDA(At, 0, 1); PG8_STAGE(PG8_SA(0, 0), a2, voffA);
            PG8_BAR; PG8_WAIT_L(0); PG8_MMA(1, 0, At, B0); PG8_BAR; PG8_SCHED;
            PG8_STAGE(PG8_SB(0, 1), b2 + hstep, voffB);
            PG8_WAIT_V(6); PG8_BAR; PG8_MMA(1, 1, At, B1); PG8_BAR;
            PG8_LDB(B0, 1, 0); PG8_SCHED; PG8_LDA(At, 1, 0); PG8_STAGE(PG8_SA(0, 1), a2 + hstep, voffA);
            PG8_WAIT_L(8); PG8_BAR; PG8_WAIT_L(0); PG8_MMA(0, 0, At, B0); PG8_BAR; PG8_SCHED;
            PG8_LDB(B1, 1, 1); PG8_STAGE(PG8_SB(1, 0), b3, voffB);
            PG8_BAR; PG8_WAIT_L(0); PG8_MMA(0, 1, At, B1); PG8_BAR;
            PG8_LDA(At, 1, 1); PG8_STAGE(PG8_SA(1, 0), a3, voffA);
            PG8_BAR; PG8_WAIT_L(0); PG8_MMA(1, 0, At, B0); PG8_BAR; PG8_SCHED;
            PG8_STAGE(PG8_SB(1, 1), b3 + hstep, voffB);
            PG8_WAIT_V(6); PG8_BAR; PG8_MMA(1, 1, At, B1); PG8_BAR;
            }
        }
        if constexpr (ALIGN_EPI) { if (wr == 0) PG8_BAR; }
        if constexpr (!Epi::AFTER_DRAIN) { E(acc, cur, wr, wc, fr, fq); S.done(cur); }
        if (!has_next) break;
#pragma unroll
        for (int a = 0; a < 2; ++a)
#pragma unroll
            for (int b = 0; b < 2; ++b)
#pragma unroll
                for (int m = 0; m < 4; ++m)
#pragma unroll
                    for (int n = 0; n < 2; ++n) acc[a][b][m][n] = (f32x4){0.f, 0.f, 0.f, 0.f};
        cur = nxt; cA = nA; cB = nB; ++ui;
        if constexpr (ALIGN_EPI) { if (wr == 1) PG8_BAR; }
    }
    PG8_WAIT_V(0);
    C.flush();
    if constexpr (!ALIGN_EPI) { if (wr == 0) PG8_BAR; }
    PG8_BAR;
    if constexpr (Epi::AFTER_DRAIN) { E.fused(acc, cur, wr, wc, fr, fq, lds, wid, lane); S.done(cur); }
#undef PG8_SA
#undef PG8_SB
#undef PG8_STAGE
#undef PG8_LDA
#undef PG8_LDB
#undef PG8_MMA
#undef PG8_WAIT_V
#undef PG8_WAIT_L
#undef PG8_WAIT_VC
#undef PG8_BAR
#undef PG8_SCHED
}
}
constexpr size_t MiB = 1u << 20;
constexpr size_t WS_CTL = 0, CTL_ZERO_BYTES = 1 * MiB;
constexpr size_t WS_WGU1 = 2 * MiB, WS_WD1 = 14 * MiB, WS_WIN = 20 * MiB, WS_WOUT = 25 * MiB, WS_WGU2 = 28 * MiB, WS_WD2 = 40 * MiB, WS_WPG = 46 * MiB, WS_WPP = 49 * MiB, WS_ROPE = 50 * MiB;
constexpr size_t WS_RS = 54 * MiB;
constexpr size_t WS_XB = 56 * MiB;
constexpr size_t WS_H = 92 * MiB;
constexpr size_t WS_ACT = 160 * MiB;
constexpr size_t WS_Y = 252 * MiB;
constexpr size_t WS_QKV = 288 * MiB;
constexpr size_t WS_ATT = 364 * MiB;
constexpr size_t WS_OP2 = 400 * MiB, WS_OP3 = 418 * MiB;
constexpr size_t WS_LS2 = 436 * MiB, WS_LS3 = 437 * MiB;
constexpr size_t WS_PB = 438 * MiB;
constexpr size_t WS_PP = 448 * MiB;
constexpr size_t WS_SLAB = 484 * MiB;
constexpr size_t WS_END = 492 * MiB;
static_assert(WS_WGU1 + (size_t)2 * FF * D * 2 <= WS_WD1 && WS_WD1 + (size_t)D * FF * 2 <= WS_WIN && WS_WIN + (size_t)NIN * D * 2 <= WS_WOUT && WS_WOUT + (size_t)D * D * 2 <= WS_WGU2 &&
              WS_WGU2 + (size_t)2 * FF * D * 2 <= WS_WD2 && WS_WD2 + (size_t)D * FF * 2 <= WS_WPG && WS_WPG + (size_t)D * D * 2 <= WS_WPP && WS_WPP + (size_t)D * DPLE * 2 <= WS_ROPE &&
              WS_ROPE + (size_t)8193 * 64 * 4 <= WS_RS && WS_RS + (size_t)MT * 4 <= WS_XB && WS_XB + (size_t)MT * D * 2 <= WS_H && WS_H + (size_t)MT * D * 4 <= WS_ACT &&
              WS_ACT + (size_t)MT * FF * 2 <= WS_Y && WS_Y + (size_t)MT * D * 2 <= WS_QKV && WS_QKV + (size_t)MT * NIN * 2 <= WS_ATT && WS_ATT + (size_t)MT * D * 2 <= WS_OP2 &&
              WS_OP2 + (size_t)MP * 512 * 2 <= WS_OP3 && WS_OP3 + (size_t)MP * 512 * 2 <= WS_LS2 && WS_LS2 + (size_t)MP * 8 * 4 <= WS_LS3 && WS_LS3 + (size_t)MP * 8 * 4 <= WS_PB &&
              WS_PB + (size_t)MT * DPLE * 2 <= WS_PP && WS_PP + (size_t)MT * D * 2 <= WS_SLAB && WS_SLAB + (size_t)11 * 128 * D * 4 <= WS_END, "d_ws map");
constexpr int CW_BAR = 4096;
constexpr int RING_OFF = 0, RING_BYTES = 131072;
constexpr int LDSCTL_OFF = RING_BYTES, MISC_OFF = LDSCTL_OFF + 320;
constexpr int LDS_BYTES = 147456;
static_assert(MISC_OFF + 128 <= LDS_BYTES, "LDS map");

#define GAS __attribute__((address_space(1)))
#define LAS __attribute__((address_space(3)))
typedef unsigned short bf16;
typedef unsigned v4u __attribute__((ext_vector_type(4)));
typedef float f32x4 __attribute__((ext_vector_type(4)));
typedef short bf16x8 __attribute__((ext_vector_type(8)));
typedef GAS unsigned gu32;
typedef GAS unsigned long long gu64;
#define RLX_AGENT __ATOMIC_RELAXED, __HIP_MEMORY_SCOPE_AGENT
#define LDS_WAIT() asm volatile("s_waitcnt lgkmcnt(0)" ::: "memory")
#define VM_WAIT() asm volatile("s_waitcnt vmcnt(0)" ::: "memory")
__device__ __forceinline__ unsigned long long rt() { return __builtin_amdgcn_s_memrealtime(); }
__device__ __forceinline__ unsigned f2bf(float f) { unsigned u = __builtin_bit_cast(unsigned, f); return (u + 0x7fffu + ((u >> 16) & 1u)) >> 16; }
__device__ __forceinline__ unsigned pk2(float lo, float hi) { return f2bf(lo) | (f2bf(hi) << 16); }

#define XB_TMO      128
#define XB_XCNT(j)  (256  + 64 * (j))
#define XB_XSUB(j)  (1280 + 64 * (j))
#define XB_XGEN(j)  (2304 + 64 * (j))
#define XB_TOP      3328
#define XB_TOPGEN   3392
#define XCD_BAR_WORDS 3456
#define XB_SPIN_CAP (1u << 18)

__device__ __forceinline__ unsigned xb_ld(unsigned* p)              { return __hip_atomic_load(p, __ATOMIC_RELAXED, __HIP_MEMORY_SCOPE_AGENT); }
__device__ __forceinline__ unsigned xb_add(unsigned* p, unsigned v) { return __hip_atomic_fetch_add(p, v, __ATOMIC_RELAXED, __HIP_MEMORY_SCOPE_AGENT); }
__device__ __forceinline__ unsigned xb_xcc_id() { return (unsigned)__builtin_amdgcn_s_getreg((3 << 11) | 20) & 0xFu; }
#define XB_SPIN(cond, bar) do { unsigned _sp = 0; while (cond) { __builtin_amdgcn_s_sleep(1); \
    if ((++_sp & 255u) == 0u) { if (xb_ld(&(bar)[XB_TMO])) break; if (_sp > XB_SPIN_CAP) { atomicAdd(&(bar)[XB_TMO], 1u); break; } } } } while (0)

struct XcdBarrier {
    unsigned* bar; unsigned x;
    volatile LAS unsigned* st;
};

__device__ __forceinline__ XcdBarrier xcd_barrier_post(unsigned* bar, volatile LAS unsigned* st) {
    XcdBarrier b; b.bar = bar; b.x = xb_xcc_id(); b.st = st;
    if (threadIdx.x == 0) (void)xb_add(&bar[XB_XCNT(b.x)], 1u);
    return b;
}
__device__ __forceinline__ void xcd_barrier_complete(unsigned* bar, unsigned x, unsigned& nloc, unsigned& nx) {
    const unsigned G = gridDim.x * gridDim.y * gridDim.z;
    unsigned sum, cnt, mine, sp = 0u;
    for (;;) {
        sum = 0u; cnt = 0u; mine = 0u;
#pragma unroll
        for (unsigned j = 0; j < 16; ++j) { const unsigned c = xb_ld(&bar[XB_XCNT(j)]); sum += c; cnt += (c > 0u) ? 1u : 0u; mine = (j == x) ? c : mine; }
        if (sum == G) break;
        __builtin_amdgcn_s_sleep(1);
        if ((++sp & 255u) == 0u) { if (xb_ld(&bar[XB_TMO])) break; if (sp > XB_SPIN_CAP) { atomicAdd(&bar[XB_TMO], 1u); break; } }
    }
    nloc = mine > 0u ? mine : 1u; nx = cnt > 0u ? cnt : 1u;
}

__device__ __forceinline__ void xcd_barrier(const XcdBarrier& b) {
    asm volatile("s_waitcnt vmcnt(0)" ::: "memory");
    __syncthreads();
    if (threadIdx.x == 0) {
        unsigned* bar = b.bar;
        __builtin_amdgcn_s_waitcnt(0);
        unsigned nloc = b.st[0], nx = b.st[1];
        if (nloc == 0u) { xcd_barrier_complete(bar, b.x, nloc, nx); b.st[0] = nloc; b.st[1] = nx; }
        const unsigned old = xb_add(&bar[XB_XSUB(b.x)], 1u);
        const unsigned gen = old / nloc;
        if (old + 1u == (gen + 1u) * nloc) {
            __builtin_amdgcn_fence(__ATOMIC_RELEASE, "agent");
            asm volatile("s_waitcnt vmcnt(0)" ::: "memory");
            const unsigned og = xb_add(&bar[XB_TOP], 1u);
            const unsigned tg = og / nx;
            if (og + 1u == (tg + 1u) * nx) xb_add(&bar[XB_TOPGEN], 1u);
            else XB_SPIN(xb_ld(&bar[XB_TOPGEN]) == tg, bar);
            __builtin_amdgcn_fence(__ATOMIC_ACQUIRE, "agent");
            xb_add(&bar[XB_XGEN(b.x)], 1u);
            asm volatile("s_waitcnt vmcnt(0)" ::: "memory");
        } else {
            XB_SPIN(xb_ld(&bar[XB_XGEN(b.x)]) == gen, bar);
            __builtin_amdgcn_fence(__ATOMIC_ACQUIRE, "agent");
            asm volatile("s_waitcnt vmcnt(0)" ::: "memory");
        }
    }
    __syncthreads();
}

typedef unsigned u32x2g __attribute__((ext_vector_type(2)));
typedef float f32x16 __attribute__((ext_vector_type(16)));
typedef short s16x4 __attribute__((ext_vector_type(4)));
struct Args { const float* in[27]; float* out; unsigned char* ws; };
struct Frame {
    LAS unsigned char* lds;
    volatile LAS unsigned* MISC;
    gu32* ctl;
    int tid, lane, wave;
    int vcu, G;
    int copy_cur;
};
__device__ __forceinline__ float wave_sum(float v) {
#pragma unroll
    for (int o = 1; o < 64; o <<= 1) v += __shfl_xor(v, o);
    return v;
}
__device__ __forceinline__ float bf_lo(unsigned w) { return __uint_as_float(w << 16); }
__device__ __forceinline__ float bf_hi(unsigned w) { return __uint_as_float(w & 0xffff0000u); }

enum { MAP_ID = 0, MAP_GATE = 1, MAP_UP = 2, MAP_ROPE = 3 };
__host__ __device__ __forceinline__ int map_row(int kind, int n) {
    if (kind == MAP_ID) return n;
    if (kind == MAP_ROPE) {
        const int pn = n >> 8, c = n & 255, hl = c >> 6, d = c & 63;
        const int bj = hl >> 1, wch = hl & 1, nn = d >> 5, dd = d & 31, wcl = dd >> 4, fq = (dd >> 2) & 3, i = dd & 3;
        const int wc = wch * 2 + wcl;
        return pn * 256 + 128 * bj + 32 * wc + 8 * fq + 4 * nn + i;
    }
    const int pn = n >> 7, o = n & 127, wc = o >> 5, fq = (o >> 3) & 3, bj = (o >> 2) & 1, i = o & 3;
    return pn * 256 + 128 * bj + 32 * wc + 8 * fq + 4 * (kind == MAP_UP ? 1 : 0) + i;
}
__device__ __forceinline__ void p0_transpose_item(const float* W, int K, int N, bf16* WT, int kind, const float* gain, LAS float* scr, int item, int lane) {
    const int nblk = N / 32, kb = item / nblk, nb = item % nblk, k0 = 64 * kb, n0 = 32 * nb;
#pragma unroll 8
    for (int i = 0; i < 32; ++i) { const int kk = 2 * i + (lane >> 5); const float g = gain ? gain[k0 + kk] : 1.0f; scr[kk * 33 + (lane & 31)] = W[(size_t)(k0 + kk) * N + n0 + (lane & 31)] * g; }
    LDS_WAIT(); asm volatile("" ::: "memory");
    const int c = lane & 7;
#pragma unroll
    for (int j = 0; j < 4; ++j) { const int n = (lane >> 3) + 8 * j; const LAS float* s = scr + (8 * c) * 33 + n;
        v4u o; o.x = pk2(s[0 * 33], s[1 * 33]); o.y = pk2(s[2 * 33], s[3 * 33]); o.z = pk2(s[4 * 33], s[5 * 33]); o.w = pk2(s[6 * 33], s[7 * 33]);
        *(GAS v4u*)(WT + (size_t)map_row(kind, n0 + n) * K + k0 + 8 * c) = o; }
    LDS_WAIT(); asm volatile("" ::: "memory");
}
__device__ __forceinline__ void row_to_bf16_rs(int lane, const float* xrow, bf16* orow, float* rs) {
    const GAS f32x4* xr = (const GAS f32x4*)xrow + lane;
    f32x4 v[4]; float s = 0.f;
#pragma unroll
    for (int j = 0; j < 4; ++j) { v[j] = xr[64 * j]; s += (v[j].x * v[j].x + v[j].y * v[j].y) + (v[j].z * v[j].z + v[j].w * v[j].w); }
    s = wave_sum(s);
    GAS unsigned long long* o8 = (GAS unsigned long long*)orow + lane;
#pragma unroll
    for (int j = 0; j < 4; ++j) o8[64 * j] = (unsigned long long)pk2(v[j].x, v[j].y) | ((unsigned long long)pk2(v[j].z, v[j].w) << 32);
    if (lane == 0) *rs = 1.0f / sqrtf(s * (1.0f / D) + EPS);
}

__device__ __forceinline__ void copy_shift(const float* src, float* dst, int nbatch, int L, int RW, int gtid, int gthreads) {
    const unsigned per_b4 = (unsigned)(L - 1) * RW / 4, blk4 = (unsigned)L * RW / 4, shift4 = (unsigned)RW / 4;
    for (int b = 0; b < nbatch; ++b) { const f32x4* s4 = (const f32x4*)src + (size_t)b * blk4 + shift4; f32x4* d4 = (f32x4*)dst + (size_t)b * blk4;
        for (unsigned e = gtid; e < per_b4; e += gthreads) { const f32x4 v = __builtin_nontemporal_load(s4 + e); __builtin_nontemporal_store(v, d4 + e); } }
}

__device__ __forceinline__ void p0_prologue(Frame& F, const Args& A) {
    unsigned char* ws = A.ws;
    LAS float* scr = (LAS float*)(F.lds + RING_OFF + F.wave * 16384);
    const int gw = F.vcu * NWAVES + F.wave, NGW = F.G * NWAVES;
    constexpr int I_GU = (D / 64) * (FF / 32), I_DN = (FF / 64) * (D / 32), I_IN = (D / 64) * (NIN / 32), I_SQ = (D / 64) * (D / 32), I_PP = (DPLE / 64) * (D / 32);
    constexpr int NITEMS = 4 * I_GU + 2 * I_DN + I_IN + 2 * I_SQ + I_PP;
    for (int it = gw; it < NITEMS; it += NGW) {
        int r = it;
        if (r < I_GU) { p0_transpose_item(A.in[10], D, FF, (bf16*)(ws + WS_WGU1), MAP_GATE, A.in[8], scr, r, F.lane); continue; } r -= I_GU;
        if (r < I_GU) { p0_transpose_item(A.in[11], D, FF, (bf16*)(ws + WS_WGU1), MAP_UP, A.in[8], scr, r, F.lane); continue; } r -= I_GU;
        if (r < I_DN) { p0_transpose_item(A.in[12], FF, D, (bf16*)(ws + WS_WD1), MAP_ID, nullptr, scr, r, F.lane); continue; } r -= I_DN;
        if (r < I_IN) { p0_transpose_item(A.in[15], D, NIN, (bf16*)(ws + WS_WIN), MAP_ROPE, A.in[13], scr, r, F.lane); continue; } r -= I_IN;
        if (r < I_SQ) { p0_transpose_item(A.in[17], D, D, (bf16*)(ws + WS_WOUT), MAP_ID, nullptr, scr, r, F.lane); continue; } r -= I_SQ;
        if (r < I_GU) { p0_transpose_item(A.in[20], D, FF, (bf16*)(ws + WS_WGU2), MAP_GATE, A.in[18], scr, r, F.lane); continue; } r -= I_GU;
        if (r < I_GU) { p0_transpose_item(A.in[21], D, FF, (bf16*)(ws + WS_WGU2), MAP_UP, A.in[18], scr, r, F.lane); continue; } r -= I_GU;
        if (r < I_DN) { p0_transpose_item(A.in[22], FF, D, (bf16*)(ws + WS_WD2), MAP_ID, nullptr, scr, r, F.lane); continue; } r -= I_DN;
        if (r < I_SQ) { p0_transpose_item(A.in[25], D, D, (bf16*)(ws + WS_WPG), MAP_ID, A.in[23], scr, r, F.lane); continue; } r -= I_SQ;
        p0_transpose_item(A.in[26], DPLE, D, (bf16*)(ws + WS_WPP), MAP_ID, nullptr, scr, r, F.lane);
    }
    bf16* XB = (bf16*)(ws + WS_XB); float* RS = (float*)(ws + WS_RS);
    for (int m = gw; m < MR; m += NGW) { const float* xr = (m < MP) ? A.in[0] + (size_t)m * D : A.in[1] + (size_t)(m - MP) * D; row_to_bf16_rs(F.lane, xr, XB + (size_t)m * D, RS + m); }
    bf16* PB = (bf16*)(ws + WS_PB);
    for (int m = gw; m < MR; m += NGW) { const float* pr = (m < MP) ? A.in[6] + (size_t)m * DPLE : A.in[7] + (size_t)(m - MP) * DPLE;
        const f32x4 v = *((const GAS f32x4*)pr + F.lane);
        *((GAS unsigned long long*)(PB + (size_t)m * DPLE) + F.lane) = (unsigned long long)pk2(v.x, v.y) | ((unsigned long long)pk2(v.z, v.w) << 32); }
    { float* rope = (float*)(ws + WS_ROPE); const int gt = gw * 64 + F.lane, NGT = NGW * 64;
      for (int i = gt; i < 8193 * 32; i += NGT) { const int idx = i >> 5, d = i & 31; const float pos = (float)(idx < SEQ ? idx : PAST);
          const float inv = powf(10000.0f, -(float)d * (1.0f / 32.0f)); const float ang = pos * inv;
          rope[2 * i] = cosf(ang); rope[2 * i + 1] = sinf(ang); } }
    { const int gt = gw * 64 + F.lane, NGT = NGW * 64;
      copy_shift(A.in[4], A.out + O_BKS, MS, LB, 128, gt, NGT);
      copy_shift(A.in[5], A.out + O_BVS, MS, LB, 128, gt, NGT); }
}

template <int MODE, int NSPLIT> __device__ __forceinline__ void norm_phase(Frame& F, const Args& A, const float* gpost, float coef) {
    unsigned char* ws = A.ws;
    const bf16* Y = (const bf16*)(ws + WS_Y); float* H = (float*)(ws + WS_H); bf16* XB = (bf16*)(ws + WS_XB); float* RS = (float*)(ws + WS_RS);
    const float* SL = (const float*)(ws + WS_SLAB); const bf16* PP = (const bf16*)(ws + WS_PP);
    int lane_ = F.lane; asm volatile("" : "+v"(lane_));
    const int gw = F.vcu * NWAVES + F.wave, NGW = F.G * NWAVES, lane = lane_;
    f32x4 g[4];
#pragma unroll
    for (int j = 0; j < 4; ++j) g[j] = *((const GAS f32x4*)gpost + lane + 64 * j) * coef;
    for (int m = gw; m < MR; m += NGW) {
        const float* hsrc = (MODE == 0) ? ((m < MP) ? A.in[0] + (size_t)m * D : A.in[1] + (size_t)(m - MP) * D) : H + (size_t)m * D;
        float* hdst = (MODE == 2) ? ((m < MP) ? A.out + O_YP + (size_t)m * D : A.out + O_YS + (size_t)(m - MP) * D) : H + (size_t)m * D;
        f32x4 y[4], h[4]; float s = 0.f;
        if (m < MP) {
            const GAS unsigned long long* y8 = (const GAS unsigned long long*)(Y + (size_t)m * D) + lane;
#pragma unroll
            for (int j = 0; j < 4; ++j) { const unsigned long long w = y8[64 * j]; const unsigned lo = (unsigned)w, hi = (unsigned)(w >> 32);
                y[j] = (f32x4){bf_lo(lo), bf_hi(lo), bf_lo(hi), bf_hi(hi)}; }
        } else {
#pragma unroll
            for (int j = 0; j < 4; ++j) y[j] = (f32x4){0.f, 0.f, 0.f, 0.f};
#pragma unroll 1
            for (int ks = 0; ks < NSPLIT; ++ks) { const GAS f32x4* sp = (const GAS f32x4*)(SL + ((size_t)ks * 128 + (m - MP)) * D) + lane;
#pragma unroll
                for (int j = 0; j < 4; ++j) y[j] = y[j] + sp[64 * j]; }
            if (MODE == 2) { const float r = RS[m]; const GAS unsigned long long* p8 = (const GAS unsigned long long*)(PP + (size_t)m * D) + lane;
#pragma unroll
                for (int j = 0; j < 4; ++j) { const unsigned long long w = p8[64 * j]; const unsigned lo = (unsigned)w, hi = (unsigned)(w >> 32);
                    const f32x4 pp = (f32x4){bf_lo(lo), bf_hi(lo), bf_lo(hi), bf_hi(hi)};
                    y[j].x = pp.x / (1.0f + __expf(-r * y[j].x)); y[j].y = pp.y / (1.0f + __expf(-r * y[j].y)); y[j].z = pp.z / (1.0f + __expf(-r * y[j].z)); y[j].w = pp.w / (1.0f + __expf(-r * y[j].w)); } }
        }
#pragma unroll
        for (int j = 0; j < 4; ++j) { s += (y[j].x * y[j].x + y[j].y * y[j].y) + (y[j].z * y[j].z + y[j].w * y[j].w); h[j] = *((const GAS f32x4*)hsrc + lane + 64 * j); }
        const float rstd = 1.0f / sqrtf(wave_sum(s) * (1.0f / D) + EPS);
        float s2 = 0.f;
#pragma unroll
        for (int j = 0; j < 4; ++j) { h[j] = h[j] + g[j] * (y[j] * rstd); s2 += (h[j].x * h[j].x + h[j].y * h[j].y) + (h[j].z * h[j].z + h[j].w * h[j].w);
            *((GAS f32x4*)hdst + lane + 64 * j) = h[j]; }
        if (MODE != 2) {
            s2 = wave_sum(s2);
            GAS unsigned long long* o8 = (GAS unsigned long long*)(XB + (size_t)m * D) + lane;
#pragma unroll
            for (int j = 0; j < 4; ++j) o8[64 * j] = (unsigned long long)pk2(h[j].x, h[j].y) | ((unsigned long long)pk2(h[j].z, h[j].w) << 32);
            if (lane == 0) RS[m] = 1.0f / sqrtf(s2 * (1.0f / D) + EPS);
        }
    }
}

__device__ __forceinline__ int crow(int r, int hi) { return (r & 3) + 8 * (r >> 2) + 4 * hi; }
__device__ __forceinline__ unsigned cvtpk(float lo, float hi) { unsigned r; asm volatile("v_cvt_pk_bf16_f32 %0, %1, %2" : "=v"(r) : "v"(lo), "v"(hi)); return r; }
__device__ __forceinline__ float xhalf_max(float v) { return fmaxf(v, __shfl_xor(v, 32)); }
__device__ __forceinline__ float xhalf_sum(float v) { return v + __shfl_xor(v, 32); }
__device__ __forceinline__ s16x4 vtr(const LAS unsigned char* p) { typedef short v4i16_t __attribute__((ext_vector_type(4))); return __builtin_bit_cast(s16x4, __builtin_amdgcn_ds_read_tr16_b64_v4i16((LAS v4i16_t*)p)); }

template <int MODE> __device__ __forceinline__ void attn_task(const bf16* QKV, int b, int qcol, int kcol, int vcol, int tq0_, int dil, LAS unsigned char* vt, int lane,
                                                              bf16* OP, float* LS, int head, float sinkl, const bf16* OP2, const bf16* OP3, const float* LS2, const float* LS3, bf16* ATT, int acol) {
    int tq0 = tq0_; asm volatile("" : "+s"(tq0));
    const int r32 = lane & 31, hi = lane >> 5;
    const GAS unsigned char* qb = (const GAS unsigned char*)QKV;
    const unsigned rowb = (unsigned)b * SEQ;
    bf16x8 qf[4];
    { const unsigned qo = ((rowb + tq0 + dil * r32) * NIN + qcol + hi * 32) * 2u;
#pragma unroll
      for (int d0 = 0; d0 < 4; ++d0) qf[d0] = *(const GAS bf16x8*)(qb + qo + d0 * 16); }
    float m_run = (MODE == 2) ? sinkl : -INFINITY, l_run = (MODE == 2) ? 1.0f : 0.0f;
    f32x16 o0 = {}, o1 = {};
    const int sq0 = tq0 / dil; int j0 = (128 - sq0) / 32; j0 = j0 < 0 ? 0 : j0;
    const int tk_base = tq0 - 128 * dil;
    const int g = lane >> 4, tq = (lane & 15) >> 2, tp = lane & 3;
    const int trow = 4 * (g >> 1) + tq, tsw = ((trow >> 1) & 1) << 6, tcol = 32 * (g & 1) + 8 * tp;
    const LAS unsigned char* ta0 = vt + trow * 128 + ((0 ^ tsw) + tcol);
    const LAS unsigned char* ta1 = vt + trow * 128 + ((64 ^ tsw) + tcol);
    const int vkey = lane >> 3, vch = lane & 7;
    const unsigned kstep = (unsigned)(32 * dil * NIN * 2), vustep = (unsigned)(8 * dil * NIN * 2);
    unsigned ko = ((rowb + tk_base + 32 * dil * j0 + dil * r32) * NIN + kcol + hi * 32) * 2u;
    unsigned vo = ((rowb + tk_base + 32 * dil * j0 + dil * vkey) * NIN + vcol + vch * 8) * 2u;
    bf16x8 kf[4], vf[4];
#pragma unroll
    for (int d0 = 0; d0 < 4; ++d0) kf[d0] = *(const GAS bf16x8*)(qb + ko + d0 * 16);
#pragma unroll
    for (int u = 0; u < 4; ++u) vf[u] = *(const GAS bf16x8*)(qb + vo + u * vustep);
#pragma unroll 1
    for (int j = j0; j < 5; ++j) {
        f32x16 s = {};
#pragma unroll
        for (int d0 = 0; d0 < 4; ++d0) s = __builtin_amdgcn_mfma_f32_32x32x16_bf16(kf[d0], qf[d0], s, 0, 0, 0);
#pragma unroll
        for (int u = 0; u < 4; ++u) { const int key = 8 * u + vkey; *(LAS bf16x8*)(vt + key * 128 + ((vch * 16) ^ (((key >> 1) & 1) << 6))) = vf[u]; }
        if (j < 4) { ko += kstep; vo += kstep; }
#pragma unroll
        for (int d0 = 0; d0 < 4; ++d0) kf[d0] = *(const GAS bf16x8*)(qb + ko + d0 * 16);
#pragma unroll
        for (int u = 0; u < 4; ++u) vf[u] = *(const GAS bf16x8*)(qb + vo + u * vustep);
        if (j == 0 || j == 4) {
            int qrel = r32 - 4 * hi; asm volatile("" : "+v"(qrel));
            if (j == 0) {
#pragma unroll
                for (int r = 0; r < 16; ++r) s[r] = ((r & 3) + 8 * (r >> 2) < qrel) ? -INFINITY : s[r];
            } else {
#pragma unroll
                for (int r = 0; r < 16; ++r) s[r] = ((r & 3) + 8 * (r >> 2) > qrel) ? -INFINITY : s[r];
            }
        }
        float mx = s[0];
#pragma unroll
        for (int r = 1; r < 16; ++r) mx = fmaxf(mx, s[r]);
        mx = xhalf_max(mx);
        const float m_new = fmaxf(m_run, mx);
        const float alpha = __builtin_amdgcn_exp2f(m_run - m_new);
        float rs = 0.f;
#pragma unroll
        for (int r = 0; r < 16; ++r) { s[r] = __builtin_amdgcn_exp2f(s[r] - m_new); rs += s[r]; }
        rs = xhalf_sum(rs);
        l_run = l_run * alpha + rs; m_run = m_new;
#pragma unroll
        for (int r = 0; r < 16; ++r) { o0[r] *= alpha; o1[r] *= alpha; }
        bf16x8 pk[2];
#pragma unroll
        for (int sl = 0; sl < 2; ++sl) { v4u w; w.x = cvtpk(s[8 * sl + 0], s[8 * sl + 1]); w.y = cvtpk(s[8 * sl + 2], s[8 * sl + 3]); w.z = cvtpk(s[8 * sl + 4], s[8 * sl + 5]); w.w = cvtpk(s[8 * sl + 6], s[8 * sl + 7]);
            pk[sl] = __builtin_bit_cast(bf16x8, w); }
#pragma unroll
        for (int sl = 0; sl < 2; ++sl) {
            const s16x4 a_lo = vtr(ta0 + 2048 * sl), a_hi = vtr(ta0 + 2048 * sl + 1024);
            const s16x4 b_lo = vtr(ta1 + 2048 * sl), b_hi = vtr(ta1 + 2048 * sl + 1024);
            const bf16x8 va = (bf16x8){a_lo[0], a_lo[1], a_lo[2], a_lo[3], a_hi[0], a_hi[1], a_hi[2], a_hi[3]};
            const bf16x8 vb = (bf16x8){b_lo[0], b_lo[1], b_lo[2], b_lo[3], b_hi[0], b_hi[1], b_hi[2], b_hi[3]};
            o0 = __builtin_amdgcn_mfma_f32_32x32x16_bf16(va, pk[sl], o0, 0, 0, 0);
            o1 = __builtin_amdgcn_mfma_f32_32x32x16_bf16(vb, pk[sl], o1, 0, 0, 0);
        }
    }
    const size_t qrow = (size_t)(rowb + tq0 + dil * r32);
    if (MODE == 0) {
        const float inv = 1.0f / l_run;
        bf16* op = OP + qrow * 512 + head * 64 + 4 * hi;
#pragma unroll
        for (int a = 0; a < 4; ++a) {
            u32x2g w0, w1; w0.x = cvtpk(o0[4 * a] * inv, o0[4 * a + 1] * inv); w0.y = cvtpk(o0[4 * a + 2] * inv, o0[4 * a + 3] * inv);
            w1.x = cvtpk(o1[4 * a] * inv, o1[4 * a + 1] * inv); w1.y = cvtpk(o1[4 * a + 2] * inv, o1[4 * a + 3] * inv);
            *(GAS u32x2g*)(op + 8 * a) = w0; *(GAS u32x2g*)(op + 32 + 8 * a) = w1; }
        if (hi == 0) LS[qrow * 8 + head] = m_run + __builtin_amdgcn_logf(l_run);
    } else if (MODE == 1) {
        const float l2 = LS2[qrow * 8 + head], l3 = LS3[qrow * 8 + head];
        const float M = fmaxf(m_run, fmaxf(l2, l3));
        const float w1 = __builtin_amdgcn_exp2f(m_run - M), w2 = __builtin_amdgcn_exp2f(l2 - M), w3 = __builtin_amdgcn_exp2f(l3 - M);
        const float inv = 1.0f / (l_run * w1 + w2 + w3);
        const float c1 = w1 * inv, c2 = w2 * inv, c3 = w3 * inv;
        const bf16* p2 = OP2 + qrow * 512 + head * 64 + 4 * hi; const bf16* p3 = OP3 + qrow * 512 + head * 64 + 4 * hi;
        bf16* op = ATT + qrow * D + acol + 4 * hi;
#pragma unroll
        for (int a = 0; a < 4; ++a) {
            const u32x2g a2 = *(const GAS u32x2g*)(p2 + 8 * a), b2 = *(const GAS u32x2g*)(p2 + 32 + 8 * a), a3 = *(const GAS u32x2g*)(p3 + 8 * a), b3 = *(const GAS u32x2g*)(p3 + 32 + 8 * a);
            float x0[4], x1[4];
            x0[0] = o0[4 * a] * c1 + bf_lo(a2.x) * c2 + bf_lo(a3.x) * c3; x0[1] = o0[4 * a + 1] * c1 + bf_hi(a2.x) * c2 + bf_hi(a3.x) * c3;
            x0[2] = o0[4 * a + 2] * c1 + bf_lo(a2.y) * c2 + bf_lo(a3.y) * c3; x0[3] = o0[4 * a + 3] * c1 + bf_hi(a2.y) * c2 + bf_hi(a3.y) * c3;
            x1[0] = o1[4 * a] * c1 + bf_lo(b2.x) * c2 + bf_lo(b3.x) * c3; x1[1] = o1[4 * a + 1] * c1 + bf_hi(b2.x) * c2 + bf_hi(b3.x) * c3;
            x1[2] = o1[4 * a + 2] * c1 + bf_lo(b2.y) * c2 + bf_lo(b3.y) * c3; x1[3] = o1[4 * a + 3] * c1 + bf_hi(b2.y) * c2 + bf_hi(b3.y) * c3;
            u32x2g w0, w1v; w0.x = cvtpk(x0[0], x0[1]); w0.y = cvtpk(x0[2], x0[3]); w1v.x = cvtpk(x1[0], x1[1]); w1v.y = cvtpk(x1[2], x1[3]);
            *(GAS u32x2g*)(op + 8 * a) = w0; *(GAS u32x2g*)(op + 32 + 8 * a) = w1v; }
    } else {
        const float inv = 1.0f / l_run;
        bf16* op = ATT + qrow * D + acol + 4 * hi;
#pragma unroll
        for (int a = 0; a < 4; ++a) {
            u32x2g w0, w1; w0.x = cvtpk(o0[4 * a] * inv, o0[4 * a + 1] * inv); w0.y = cvtpk(o0[4 * a + 2] * inv, o0[4 * a + 3] * inv);
            w1.x = cvtpk(o1[4 * a] * inv, o1[4 * a + 1] * inv); w1.y = cvtpk(o1[4 * a + 2] * inv, o1[4 * a + 3] * inv);
            *(GAS u32x2g*)(op + 8 * a) = w0; *(GAS u32x2g*)(op + 32 + 8 * a) = w1; }
    }
}

struct SPart { float m, l; f32x4 o; };
__device__ __forceinline__ void sample_scan(const float* kbase, const float* vbase, const float* knew, const float* vnew, int L, int rstride, int dil, const f32x4 q4, int lane, float& m_run, float& l_run, f32x4& o4) {
    const int sub = lane & 15, ks = lane >> 4;
#pragma unroll 4
    for (int st = 0; st < 33; ++st) {
        const int k = 4 * st + ks; const bool valid = k <= 128; const int idx = L - dil * (valid ? k : 128);
        const float* kp = (idx == L) ? knew : kbase + (size_t)idx * rstride; const float* vp = (idx == L) ? vnew : vbase + (size_t)idx * rstride;
        const f32x4 k4 = *((const GAS f32x4*)kp + sub), v4 = *((const GAS f32x4*)vp + sub);
        float s = (k4.x * q4.x + k4.y * q4.y) + (k4.z * q4.z + k4.w * q4.w);
        s += __shfl_xor(s, 1); s += __shfl_xor(s, 2); s += __shfl_xor(s, 4); s += __shfl_xor(s, 8);
        if (!valid) s = -INFINITY;
        const float m_new = fmaxf(m_run, s); const float alpha = __builtin_amdgcn_exp2f(m_run - m_new), p = __builtin_amdgcn_exp2f(s - m_new);
        l_run = l_run * alpha + p; o4 = o4 * alpha + v4 * p; m_run = m_new;
    }
}
__device__ __forceinline__ void sample_merge4(float& m_run, float& l_run, f32x4& o4) {
#pragma unroll
    for (int x = 16; x <= 32; x <<= 1) {
        const float mo = __shfl_xor(m_run, x), lo = __shfl_xor(l_run, x);
        f32x4 oo; oo.x = __shfl_xor(o4.x, x); oo.y = __shfl_xor(o4.y, x); oo.z = __shfl_xor(o4.z, x); oo.w = __shfl_xor(o4.w, x);
        const float M = fmaxf(m_run, mo), a = __builtin_amdgcn_exp2f(m_run - M), c = __builtin_amdgcn_exp2f(mo - M);
        l_run = l_run * a + lo * c; o4 = o4 * a + oo * c; m_run = M;
    }
}

__device__ __forceinline__ void attention_phase(Frame& F, const Args& A) {
    unsigned char* ws = A.ws;
    const bf16* QKV = (const bf16*)(ws + WS_QKV); bf16* ATT = (bf16*)(ws + WS_ATT);
    bf16* OP2 = (bf16*)(ws + WS_OP2); bf16* OP3 = (bf16*)(ws + WS_OP3); float* LS2 = (float*)(ws + WS_LS2); float* LS3 = (float*)(ws + WS_LS3);
    const int lane = F.lane, w = F.wave;
    LAS unsigned char* vt = F.lds + RING_OFF + w * 4096;
    LAS float* spart = (LAS float*)(F.lds + RING_OFF + 32768);
    const float* sinks = A.in[16];
    for (int u = F.vcu; u < 256; u += F.G) {
        const int b = u >> 7, h = (u >> 4) & 7, T0 = (u & 15) * 512;
#pragma unroll 1
        for (int k = 0; k < 2; ++k) attn_task<0>(QKV, b, 64 * h, 512 + 64 * h, 1024 + 64 * h, T0 + 2 * w + k, 16, vt, lane, OP3, LS3, h, 0.f, nullptr, nullptr, nullptr, nullptr, nullptr, 0);
#pragma unroll 1
        for (int k = 0; k < 2; ++k) { const int task = 2 * w + k; attn_task<0>(QKV, b, 64 * h, 512 + 64 * h, 1024 + 64 * h, T0 + 128 * (task >> 2) + (task & 3), 4, vt, lane, OP2, LS2, h, 0.f, nullptr, nullptr, nullptr, nullptr, nullptr, 0); }
#pragma unroll 1
        for (int k = 0; k < 2; ++k) attn_task<2>(QKV, b, 1536 + 64 * h, 2048 + 64 * (h >> 2), 2176 + 64 * (h >> 2), T0 + 32 * (2 * w + k), 1, vt, lane, nullptr, nullptr, h, sinks[h] * 1.4426950408889634f, nullptr, nullptr, nullptr, nullptr, ATT, 512 + 64 * h);
        if (u < 256) {
#pragma unroll 1
            for (int k = 0; k < 2; ++k) { const int task = w + 8 * k;
                const int sub = lane & 15;
                if (task < 12) {
                    const int pair = 4 * u + task / 3, pat = task % 3, sb = pair >> 3, sh = pair & 7, dil = pat == 0 ? 1 : (pat == 1 ? 4 : 16);
                    const bf16* qp = QKV + (size_t)(MP + sb) * NIN + 64 * sh + 4 * sub; const unsigned long long qw = *(const GAS unsigned long long*)qp;
                    const f32x4 q4 = (f32x4){bf_lo((unsigned)qw), bf_hi((unsigned)qw), bf_lo((unsigned)(qw >> 32)), bf_hi((unsigned)(qw >> 32))};
                    float m_run = -INFINITY, l_run = 0.f; f32x4 o4 = {0.f, 0.f, 0.f, 0.f};
                    sample_scan(A.in[2] + ((size_t)sb * LA * 8 + sh) * 64, A.in[3] + ((size_t)sb * LA * 8 + sh) * 64,
                                A.out + O_AKS + ((size_t)(sb * LA + LA - 1) * 8 + sh) * 64, A.out + O_AVS + ((size_t)(sb * LA + LA - 1) * 8 + sh) * 64, LA, 512, dil, q4, lane, m_run, l_run, o4);
                    sample_merge4(m_run, l_run, o4);
                    if (lane < 16) { LAS float* sp = spart + (task * 16 + sub) * 6; sp[0] = m_run; sp[1] = l_run; sp[2] = o4.x; sp[3] = o4.y; sp[4] = o4.z; sp[5] = o4.w; }
                } else {
                    const int pair = 4 * u + (task - 12), sb = pair >> 3, sh = pair & 7, kv = sh >> 2;
                    const bf16* qp = QKV + (size_t)(MP + sb) * NIN + 1536 + 64 * sh + 4 * sub; const unsigned long long qw = *(const GAS unsigned long long*)qp;
                    const f32x4 q4 = (f32x4){bf_lo((unsigned)qw), bf_hi((unsigned)qw), bf_lo((unsigned)(qw >> 32)), bf_hi((unsigned)(qw >> 32))};
                    float m_run = (lane < 16) ? sinks[sh] * 1.4426950408889634f : -INFINITY, l_run = (lane < 16) ? 1.0f : 0.f; f32x4 o4 = {0.f, 0.f, 0.f, 0.f};
                    sample_scan(A.in[4] + ((size_t)sb * LB * 2 + kv) * 64, A.in[5] + ((size_t)sb * LB * 2 + kv) * 64,
                                A.out + O_BKS + ((size_t)(sb * LB + LB - 1) * 2 + kv) * 64, A.out + O_BVS + ((size_t)(sb * LB + LB - 1) * 2 + kv) * 64, LB, 128, 1, q4, lane, m_run, l_run, o4);
                    sample_merge4(m_run, l_run, o4);
                    if (lane < 16) { const float inv = 1.0f / l_run; bf16* op = ATT + (size_t)(MP + sb) * D + 512 + 64 * sh + 4 * sub;
                        *(GAS unsigned long long*)op = (unsigned long long)cvtpk(o4.x * inv, o4.y * inv) | ((unsigned long long)cvtpk(o4.z * inv, o4.w * inv) << 32); }
                }
            }
        }
        __builtin_amdgcn_fence(__ATOMIC_RELEASE, "workgroup"); __syncthreads(); __builtin_amdgcn_fence(__ATOMIC_ACQUIRE, "workgroup");
#pragma unroll 1
        for (int k = 0; k < 2; ++k) attn_task<1>(QKV, b, 64 * h, 512 + 64 * h, 1024 + 64 * h, T0 + 32 * (2 * w + k), 1, vt, lane, nullptr, nullptr, h, 0.f, OP2, OP3, LS2, LS3, ATT, 64 * h);
        if (w < 4 && lane < 16) {
            const int pair = 4 * u + w, sb = pair >> 3, sh = pair & 7, sub = lane;
            float m_run = -INFINITY, l_run = 0.f; f32x4 o4 = {0.f, 0.f, 0.f, 0.f};
#pragma unroll
            for (int p = 0; p < 3; ++p) { const LAS float* sp = spart + ((3 * w + p) * 16 + sub) * 6; const float mo = sp[0], lo = sp[1]; const f32x4 oo = (f32x4){sp[2], sp[3], sp[4], sp[5]};
                const float M = fmaxf(m_run, mo), a = __builtin_amdgcn_exp2f(m_run - M), c = __builtin_amdgcn_exp2f(mo - M);
                l_run = l_run * a + lo * c; o4 = o4 * a + oo * c; m_run = M; }
            const float inv = 1.0f / l_run; bf16* op = ATT + (size_t)(MP + sb) * D + 64 * sh + 4 * sub;
            *(GAS unsigned long long*)op = (unsigned long long)cvtpk(o4.x * inv, o4.y * inv) | ((unsigned long long)cvtpk(o4.z * inv, o4.w * inv) << 32);
        }
        __syncthreads();
    }
}

__global__ void __launch_bounds__(NWAVES * 64, 2) fwd_kernel(Args args) {
    extern __shared__ __attribute__((aligned(16))) unsigned char lds[];
    Frame F;
    F.lds = (LAS unsigned char*)lds;
    F.MISC = (volatile LAS unsigned*)(F.lds + MISC_OFF);
    F.tid = threadIdx.x; F.lane = F.tid & 63; F.wave = __builtin_amdgcn_readfirstlane(F.tid >> 6);
    F.G = gridDim.x; { const int bx = blockIdx.x; F.vcu = (F.G % 8 == 0) ? (bx % 8) * (F.G / 8) + bx / 8 : bx; }
    F.ctl = (gu32*)(args.ws + WS_CTL);
    for (int u = F.tid; u < (LDS_BYTES - LDSCTL_OFF) / 4; u += NWAVES * 64) ((LAS unsigned*)(F.lds + LDSCTL_OFF))[u] = 0u;
    __syncthreads();
    XcdBarrier bar = xcd_barrier_post((unsigned*)(F.ctl + CW_BAR), F.MISC + 8);
#define GRID_BAR() xcd_barrier(bar)

#define XB ((bf16*)(args.ws + WS_XB))
#define RS ((float*)(args.ws + WS_RS))
#define ACT ((bf16*)(args.ws + WS_ACT))
#define Y ((bf16*)(args.ws + WS_Y))
#define QKV ((bf16*)(args.ws + WS_QKV))
#define ATT ((bf16*)(args.ws + WS_ATT))
#define PB ((bf16*)(args.ws + WS_PB))
#define PP ((bf16*)(args.ws + WS_PP))

    const int cpair = (int)blockIdx.x < 256 ? (int)blockIdx.x : 255;
    F.copy_cur = (int)blockIdx.x < 256 ? 0 : 4094;
#define COPY_SRC ((const unsigned char*)(args.in[2 + (cpair >> 7)] + (size_t)(cpair & 127) * LA * 512 + 512))
#define COPY_DST ((unsigned char*)(args.out + ((cpair >> 7) ? O_AVS : O_AKS) + (size_t)(cpair & 127) * LA * 512))
#define GEMM_PHASE(EPI, A_, B_, N_, K_, NSPLIT_, ...) do { pg8::Gemm g{A_, (const bf16*)(args.ws + B_), MT, N_, K_}; pg8::SampleOrder S; S.init(MP, N_, K_, NSPLIT_, F.G, (int)blockIdx.x); \
      pg8::EPI E{__VA_ARGS__}; pg8::StreamCopy C; C.src = COPY_SRC; C.dst = COPY_DST; C.cur = F.copy_cur + F.wave; C.last = 4093; C.lane_off = (unsigned)F.lane * 16u; \
      pg8::gemm_phase<pg8::EPI, pg8::SampleOrder, pg8::StreamCopy, PG8_ALIGN, PG8_SP2>(F.lds + RING_OFF, g, S, E, C); F.copy_cur = C.cur - F.wave; } while (0)

#ifndef SKIP_P0
    p0_prologue(F, args);
#endif
    GRID_BAR();
#ifndef SKIP_P1
    GEMM_PHASE(EpiSwiGLU, XB, WS_WGU1, 2 * FF, D, 1, ACT, FF, RS);
#endif
    GRID_BAR();
#ifndef SKIP_P2
    GEMM_PHASE(EpiPlain, ACT, WS_WD1, D, FF, 11, Y, D, (float*)(args.ws + WS_SLAB));
#endif
    GRID_BAR();
#ifndef SKIP_NORM
    norm_phase<0, 11>(F, args, args.in[9], 0.5f);
#endif
    GRID_BAR();
#ifndef SKIP_P3
    GEMM_PHASE(EpiRope, XB, WS_WIN, NIN, D, 1, QKV, RS, (const float*)(args.ws + WS_ROPE), args.out);
#endif
#ifndef SKIP_P3B
    GEMM_PHASE(EpiPlain, PB, WS_WPP, D, DPLE, 1, PP, D, nullptr);
#endif
    GRID_BAR();
#ifndef SKIP_P4
    attention_phase(F, args);
#ifdef PROBE_ATTN2
    GRID_BAR();
    attention_phase(F, args);
#endif
#endif
    GRID_BAR();
#ifndef SKIP_P5
    GEMM_PHASE(EpiPlain, ATT, WS_WOUT, D, D, 4, Y, D, (float*)(args.ws + WS_SLAB));
#endif
    GRID_BAR();
#ifndef SKIP_NORM
    norm_phase<1, 4>(F, args, args.in[14], 1.0f);
#endif
    GRID_BAR();
#ifndef SKIP_P6
    GEMM_PHASE(EpiSwiGLU, XB, WS_WGU2, 2 * FF, D, 1, ACT, FF, RS);
#endif
    GRID_BAR();
#ifndef SKIP_P7
    GEMM_PHASE(EpiPlain, ACT, WS_WD2, D, FF, 11, Y, D, (float*)(args.ws + WS_SLAB));
#endif
    GRID_BAR();
#ifndef SKIP_NORM
    norm_phase<1, 11>(F, args, args.in[19], 0.5f);
#endif
    GRID_BAR();
#ifndef SKIP_P8
    GEMM_PHASE(EpiPle, XB, WS_WPG, D, D, 4, Y, D, RS, PP, (float*)(args.ws + WS_SLAB));
#endif
    for (int pair = (int)blockIdx.x; pair < 256; pair += F.G) {
        const f32x4* s4 = (const f32x4*)(args.in[2 + (pair >> 7)] + (size_t)(pair & 127) * LA * 512 + 512); f32x4* d4 = (f32x4*)(args.out + ((pair >> 7) ? O_AVS : O_AKS) + (size_t)(pair & 127) * LA * 512);
        for (int c = (pair == (int)blockIdx.x ? F.copy_cur : 0) + F.wave; c < 4094; c += NWAVES) { const f32x4 v = __builtin_nontemporal_load(s4 + c * 64 + F.lane); __builtin_nontemporal_store(v, d4 + c * 64 + F.lane); }
    }
    GRID_BAR();
#ifndef SKIP_NORM
    norm_phase<2, 4>(F, args, args.in[24], 1.0f);
#endif
#undef GEMM_PHASE
#undef COPY_SRC
#undef COPY_DST
#undef GRID_BAR
#undef XB
#undef RS
#undef ACT
#undef Y
#undef QKV
#undef ATT
#undef PB
#undef PP
}

extern "C" void kernel_launch(void* const* d_in, const int* in_sizes, int n_in, void* d_out, int out_size, void* d_ws, size_t ws_size, hipStream_t stream) {
    static int grid = 0;
    if (grid == 0) {
        if (n_in != 27 || (size_t)out_size != O_END || ws_size < WS_END) { fprintf(stderr, "kernel_launch: unexpected shapes (n_in %d, out %d, ws %zu); nothing launched\n", n_in, out_size, ws_size); grid = -1; return; }
        int dev = 0, cus = 0, per_cu = 0;
        if (hipGetDevice(&dev) != hipSuccess || hipDeviceGetAttribute(&cus, hipDeviceAttributeMultiprocessorCount, dev) != hipSuccess) { grid = -1; return; }
        if (hipFuncSetAttribute((const void*)fwd_kernel, hipFuncAttributeMaxDynamicSharedMemorySize, LDS_BYTES) != hipSuccess) { fprintf(stderr, "kernel_launch: hipFuncSetAttribute failed\n"); grid = -1; return; }
        if (hipOccupancyMaxActiveBlocksPerMultiprocessor(&per_cu, (const void*)fwd_kernel, NWAVES * 64, LDS_BYTES) != hipSuccess || per_cu < 1) { fprintf(stderr, "kernel_launch: occupancy query says %d blocks per CU\n", per_cu); per_cu = 1; }
        (void)hipGetLastError();
        grid = cus;
    }
    if (grid < 0) return;
    if (hipMemsetAsync((char*)d_ws + WS_CTL, 0, CTL_ZERO_BYTES, stream) != hipSuccess) return;
    Args a{};
    for (int i = 0; i < 27; ++i) a.in[i] = (const float*)d_in[i];
    a.out = (float*)d_out; a.ws = (unsigned char*)d_ws;
    hipLaunchKernelGGL(fwd_kernel, dim3(grid), dim3(NWAVES * 64), LDS_BYTES, stream, a);
}
```

```cpp
#include <hip/hip_runtime.h>
#include <cstdio>
#include <cstdint>
#include <cmath>

#ifndef PG8_SP2
#define PG8_SP2 true
#endif
#ifndef PG8_ALIGN
#define PG8_ALIGN true
#endif
constexpr int NWAVES = 8;
constexpr int D = 1024, FF = 2816, NIN = 2304, DPLE = 256, SEQ = 8192, NB = 2;
constexpr int MP = NB * SEQ;
constexpr int MS = 128;
constexpr int MR = MP + MS;
constexpr int MT = 65 * 256;
constexpr int LA = 2048, LB = 128, PAST = 16384;
constexpr float EPS = 1e-6f;
constexpr float QSCALE = 0.125f * 1.4426950408889634f;

constexpr size_t O_YP = 0, O_YS = O_YP + (size_t)MP * D, O_AKP = O_YS + (size_t)MS * D, O_AVP = O_AKP + (size_t)NB * 2048 * 512,
    O_BKP = O_AVP + (size_t)NB * 2048 * 512, O_BVP = O_BKP + (size_t)NB * 128 * 128, O_AKS = O_BVP + (size_t)NB * 128 * 128,
    O_AVS = O_AKS + (size_t)MS * LA * 512, O_BKS = O_AVS + (size_t)MS * LA * 512, O_BVS = O_BKS + (size_t)MS * LB * 128, O_END = O_BVS + (size_t)MS * LB * 128;
static_assert(O_END == 293797888ull, "output size");

namespace pg8 {
#define PG8_LAS __attribute__((address_space(3)))
typedef unsigned short bf16_t;
typedef short bf16x8 __attribute__((ext_vector_type(8)));
typedef float f32x4 __attribute__((ext_vector_type(4)));
typedef unsigned u32x4 __attribute__((ext_vector_type(4)));
constexpr int BM = 256, BK = 64, HALF = 128, HTB = HALF * BK * 2  , STAGE_BYTES = 8 * HTB, NXCD = 8, WGM = 8;

__host__ __device__ __forceinline__ int lds_byte(int r, int c) { const int st = (r >> 4) * 2 + (c >> 5), rr = r & 15, cc = c & 31, ob = rr * 64 + cc * 2; return st * 1024 + (ob ^ (((ob >> 9) & 1) << 5)); }
__host__ __device__ __forceinline__ void stage_rc(int b, int& R, int& C) { const int st = b / 1024, sb = b % 1024, swz = sb ^ (((sb >> 9) & 1) << 5); R = (st >> 1) * 16 + swz / 64; C = (st & 1) * 32 + (swz % 64) / 2; }
__host__ __device__ __forceinline__ int perm32(int rho) { const int n = rho >> 4, i = rho & 15; return 8 * (i >> 2) + 4 * n + (i & 3); }

struct Unit { int pm, pn, kt0, nkt; };
struct Gemm { const bf16_t* A; const bf16_t* Bt; int M, N, K; };

struct StaticOrder {
    int nM, nN, nwg, G, c;
    __host__ __device__ void init(int M, int N, int G_, int c_) { nM = M / BM; nN = N / BM; nwg = nM * nN; G = G_; c = c_; }
    __host__ __device__ bool next(int i, Unit& u) const {
        const long L = (long)i * G + c; if (L >= nwg) return false;
        int wgid = (int)L; { const int q = nwg / NXCD, r = nwg % NXCD, xcd = wgid % NXCD, off = wgid / NXCD; wgid = (xcd < r ? xcd * (q + 1) : r * (q + 1) + (xcd - r) * q) + off; }
        const int nig = WGM * nN, gid = wgid / nig, fm = gid * WGM, gsz = (nM - fm) < WGM ? (nM - fm) : WGM;
        u.pm = fm + ((wgid % nig) % gsz); u.pn = (wgid % nig) / gsz; return true;
    }
    __device__ __forceinline__ void a_ready(const Unit&) const {}
    __device__ __forceinline__ void done(const Unit&) const {}
};

struct SampleOrder {
    StaticOrder P; int nkt_full, nsplit, ns;
    __host__ __device__ void init(int Mp, int N, int K, int nsplit_, int G_, int c_) { P.init(Mp, N, G_, c_); nkt_full = K / BK; nsplit = nsplit_; ns = (N / BM) * nsplit_; }
    __host__ __device__ bool next(int i, Unit& u) const {
        Unit t; t.pm = 0; t.pn = 0; t.kt0 = 0; t.nkt = 0; int pm, pn, kt0 = 0, nkt = nkt_full;
        if (P.next(i, t)) { pm = t.pm; pn = t.pn; }
        else { const long L = (long)i * P.G + P.c - P.nwg; if (L < 0 || L >= ns) return false;
            const int s = (int)L, ks = s / P.nN; pm = P.nM; pn = s - ks * P.nN; nkt = nkt_full / nsplit; kt0 = ks * nkt; }
        u.pm = pm; u.pn = pn; u.kt0 = kt0; u.nkt = nkt; return true;
    }
    __device__ __forceinline__ void a_ready(const Unit&) const {}
    __device__ __forceinline__ void done(const Unit&) const {}
};
struct NoCopy { static constexpr bool ACTIVE = false; __device__ __forceinline__ void prime() {} template <int KT> __device__ __forceinline__ void step() {} __device__ __forceinline__ void flush() {} };
struct StreamCopy {
    static constexpr bool ACTIVE = true;
    const unsigned char* src; unsigned char* dst; int cur, last; unsigned lane_off; f32x4 buf0, buf1; unsigned off0, off1;
    __device__ __forceinline__ unsigned chunk_off() { const int c = cur < last ? cur : last; cur += 8; return (unsigned)c * 1024u + lane_off; }
    static __device__ __forceinline__ void ld(f32x4& v, unsigned off, const unsigned char* base) { asm volatile("global_load_dwordx4 %0, %1, %2 nt" : "=v"(v) : "v"(off), "s"(base) : "memory"); }
    static __device__ __forceinline__ void st_w(const f32x4& v, unsigned off, unsigned char* base) { asm volatile("s_waitcnt vmcnt(18)\n\tglobal_store_dwordx4 %0, %1, %2 nt" : : "v"(off), "v"(v), "s"(base) : "memory"); }
    static __device__ __forceinline__ void st(const f32x4& v, unsigned off, unsigned char* base) { asm volatile("global_store_dwordx4 %0, %1, %2 nt" : : "v"(off), "v"(v), "s"(base) : "memory"); }
    __device__ __forceinline__ void prime() { off0 = chunk_off(); ld(buf0, off0, src); off1 = chunk_off(); ld(buf1, off1, src); }
    template <int KT> __device__ __forceinline__ void step() {
        if (KT == 0) { st_w(buf0, off0, dst); off0 = chunk_off(); ld(buf0, off0, src); }
        else         { st_w(buf1, off1, dst); off1 = chunk_off(); ld(buf1, off1, src); }
    }
    __device__ __forceinline__ void flush() { st(buf0, off0, dst); st(buf1, off1, dst); }
};

__device__ __forceinline__ unsigned cvt_pk_bf16(float lo, float hi) { unsigned r; asm volatile("v_cvt_pk_bf16_f32 %0, %1, %2" : "=v"(r) : "v"(lo), "v"(hi)); return r; }
typedef float f32x2 __attribute__((ext_vector_type(2)));

typedef unsigned u32x2 __attribute__((ext_vector_type(2)));
__device__ __forceinline__ float fast_sigmoid(float x) { return __builtin_amdgcn_rcpf(1.0f + __builtin_amdgcn_exp2f(-1.4426950408889634f * x)); }

__device__ __forceinline__ void store_slab(float* slab, const f32x4 (&acc)[2][2][4][2], const Unit& u, int wr, int wc, int fr, int fq) {
    const int ks = u.kt0 / u.nkt; float* base = slab + ((size_t)ks * 128 + wr * 64 + fr) * 1024 + u.pn * BM + wc * 32 + 8 * fq;
#pragma unroll
    for (int m = 0; m < 4; ++m)
#pragma unroll
        for (int bj = 0; bj < 2; ++bj) { float* p = base + (size_t)m * 16 * 1024 + bj * HALF; *(f32x4*)p = acc[0][bj][m][0]; *(f32x4*)(p + 4) = acc[0][bj][m][1]; }
}
struct EpiPlain {
    static constexpr bool PERM = true, AFTER_DRAIN = false;
    bf16_t* O; int ldc; float* slab;
    __device__ __forceinline__ void operator()(const f32x4 (&acc)[2][2][4][2], const Unit& u, int wr, int wc, int fr, int fq) const {
        if (slab != nullptr && u.pm == MP / BM) { store_slab(slab, acc, u, wr, wc, fr, fq); return; }
        const int row0 = u.pm * BM + wr * 64 + fr, col0 = u.pn * BM + wc * 32 + 8 * fq;
#pragma unroll
        for (int ai = 0; ai < 2; ++ai)
#pragma unroll
            for (int m = 0; m < 4; ++m) { bf16_t* rowp = O + (size_t)(row0 + ai * HALF + m * 16) * ldc + col0;
#pragma unroll
                for (int bj = 0; bj < 2; ++bj) { const f32x4 v0 = acc[ai][bj][m][0], v1 = acc[ai][bj][m][1];
                    u32x4 w; w.x = cvt_pk_bf16(v0[0], v0[1]); w.y = cvt_pk_bf16(v0[2], v0[3]); w.z = cvt_pk_bf16(v1[0], v1[1]); w.w = cvt_pk_bf16(v1[2], v1[3]);
                    *(u32x4*)(rowp + bj * HALF) = w; } }
    }
};

struct EpiSwiGLU {
    static constexpr bool PERM = true, AFTER_DRAIN = false;
    bf16_t* O; int ldc; const float* rs;
    __device__ __forceinline__ void operator()(const f32x4 (&acc)[2][2][4][2], const Unit& u, int wr, int wc, int fr, int fq) const {
        const int row0 = u.pm * BM + wr * 64 + fr, col0 = u.pn * HALF + wc * 32 + 8 * fq;
#pragma unroll
        for (int ai = 0; ai < 2; ++ai)
#pragma unroll
            for (int m = 0; m < 4; ++m) { const int row = row0 + ai * HALF + m * 16; const float r = rs[row];
                unsigned w[4];
#pragma unroll
                for (int bj = 0; bj < 2; ++bj) { const f32x4 g = acc[ai][bj][m][0] * r, up = acc[ai][bj][m][1] * r; float o[4];
#pragma unroll
                    for (int i = 0; i < 4; ++i) o[i] = g[i] * fast_sigmoid(g[i]) * up[i];
                    w[2 * bj] = cvt_pk_bf16(o[0], o[1]); w[2 * bj + 1] = cvt_pk_bf16(o[2], o[3]); }
                u32x4 wv; wv.x = w[0]; wv.y = w[1]; wv.z = w[2]; wv.w = w[3];
                *(u32x4*)(O + (size_t)row * ldc + col0) = wv; }
    }
};

struct EpiRope {
    static constexpr bool PERM = true, AFTER_DRAIN = false;
    bf16_t* O; const float* rs; const float* rope;
    float* out;
    __device__ __forceinline__ void operator()(const f32x4 (&acc)[2][2][4][2], const Unit& u, int wr, int wc, int fr, int fq) const {
        const int pn = u.pn; const int row0 = u.pm * BM + wr * 64 + fr;
        const int d0 = 16 * (wc & 1) + 4 * fq;
        const bool is_s = u.pm >= MP / BM;
#pragma unroll
        for (int ai = 0; ai < 2; ++ai)
#pragma unroll
            for (int m = 0; m < 4; ++m) { const int row = row0 + ai * HALF + m * 16; const float r = rs[row];
                const int t = is_s ? 0 : (row & (SEQ - 1)); const int b = is_s ? (row - MP) : (row / SEQ);
                const float* rp = rope + (unsigned)((is_s ? SEQ : t) * 64 + 2 * d0);
                const f32x4 cs0 = *(const f32x4*)rp, cs1 = *(const f32x4*)(rp + 4);
#pragma unroll
                for (int bj = 0; bj < 2; ++bj) {
                    const int hl = 2 * bj + (wc >> 1);
                    const bool rot = (pn < 4) || (pn == 6) || (pn == 7) || (pn == 8 && bj == 0);
                    const bool isq = (pn < 2) || (pn == 6) || (pn == 7);
                    f32x4 x1 = acc[ai][bj][m][0] * r, x2 = acc[ai][bj][m][1] * r;
                    if (rot) {
                        const f32x4 c = (f32x4){cs0[0], cs0[2], cs1[0], cs1[2]}, s = (f32x4){cs0[1], cs0[3], cs1[1], cs1[3]};
                        const f32x4 a = x1, bb = x2; x1 = a * c - bb * s; x2 = bb * c + a * s; }
                    long doff = -1;
                    if (pn >= 2 && pn <= 5) {
                        const int head = 4 * (pn & 1) + hl; const size_t base = (pn < 4) ? (is_s ? O_AKS : O_AKP) : (is_s ? O_AVS : O_AVP);
                        if (is_s) { if (row < MP + MS) doff = (long)(base + ((size_t)(b * 2048 + 2047) * 8 + head) * 64); }
                        else if (t >= SEQ - 2048) doff = (long)(base + ((size_t)(b * 2048 + (t - (SEQ - 2048))) * 8 + head) * 64);
                    } else if (pn == 8) {
                        const int kvh = wc >> 1; const size_t base = (bj == 0) ? (is_s ? O_BKS : O_BKP) : (is_s ? O_BVS : O_BVP);
                        if (is_s) { if (row < MP + MS) doff = (long)(base + ((size_t)(b * 128 + 127) * 2 + kvh) * 64); }
                        else if (t >= SEQ - 128) doff = (long)(base + ((size_t)(b * 128 + (t - (SEQ - 128))) * 2 + kvh) * 64);
                    }
                    if (doff >= 0) { float* dst = out + doff; *(f32x4*)(dst + d0) = x1; *(f32x4*)(dst + d0 + 32) = x2; }
                    if (isq) { x1 = x1 * QSCALE; x2 = x2 * QSCALE; }
                    bf16_t* op = O + (size_t)row * 2304 + pn * BM + 64 * hl + d0;
                    u32x2 w1, w2; w1.x = cvt_pk_bf16(x1[0], x1[1]); w1.y = cvt_pk_bf16(x1[2], x1[3]); w2.x = cvt_pk_bf16(x2[0], x2[1]); w2.y = cvt_pk_bf16(x2[2], x2[3]);
                    *(u32x2*)op = w1; *(u32x2*)(op + 32) = w2; } }
    }
};

struct EpiPle {
    static constexpr bool PERM = true, AFTER_DRAIN = false;
    bf16_t* O; int ldc; const float* rs; const bf16_t* PP; float* slab;
    __device__ __forceinline__ void operator()(const f32x4 (&acc)[2][2][4][2], const Unit& u, int wr, int wc, int fr, int fq) const {
        if (u.pm == MP / BM) { store_slab(slab, acc, u, wr, wc, fr, fq); return; }
        const int row0 = u.pm * BM + wr * 64 + fr, col0 = u.pn * BM + wc * 32 + 8 * fq;
#pragma unroll
        for (int ai = 0; ai < 2; ++ai)
#pragma unroll
            for (int m = 0; m < 4; ++m) { const int row = row0 + ai * HALF + m * 16; const float r = rs[row]; const size_t off = (size_t)row * ldc + col0;
#pragma unroll
                for (int bj = 0; bj < 2; ++bj) { const u32x4 pp = *(const u32x4*)(PP + off + bj * HALF);
                    const f32x4 v0 = acc[ai][bj][m][0] * r, v1 = acc[ai][bj][m][1] * r; float o[8];
#pragma unroll
                    for (int i = 0; i < 4; ++i) { const unsigned pw0 = pp[i >> 1], pw1 = pp[2 + (i >> 1)];
                        const float p0 = __uint_as_float((i & 1) ? (pw0 & 0xffff0000u) : (pw0 << 16)), p1 = __uint_as_float((i & 1) ? (pw1 & 0xffff0000u) : (pw1 << 16));
                        o[i] = fast_sigmoid(v0[i]) * p0; o[4 + i] = fast_sigmoid(v1[i]) * p1; }
                    u32x4 w; w.x = cvt_pk_bf16(o[0], o[1]); w.y = cvt_pk_bf16(o[2], o[3]); w.z = cvt_pk_bf16(o[4], o[5]); w.w = cvt_pk_bf16(o[6], o[7]);
                    *(u32x4*)(O + off + bj * HALF) = w; } }
    }
};

template <class Epi, class Sched, class Copy, bool ALIGN_EPI = false, bool SP2 = false>
__device__ __forceinline__ void gemm_phase(PG8_LAS unsigned char* lds, const Gemm g, const Sched& S, const Epi& E, Copy& C) {
    int tid_ = threadIdx.x; asm volatile("" : "+v"(tid_));
    const int tid = tid_, wid = __builtin_amdgcn_readfirstlane(tid >> 6), lane = tid & 63, wr = wid >> 2, wc = wid & 3, fr = lane & 15, fq = lane >> 4;
    const int K = g.K;
    unsigned voffA[2], voffB[2];
#pragma unroll
    for (int i = 0; i < 2; ++i) { int R, C; stage_rc(tid * 16 + i * 8192, R, C); const int Rb = Epi::PERM ? ((R & ~31) + perm32(R & 31)) : R;
        voffA[i] = (unsigned)(R * K + C) * 2u; voffB[i] = (unsigned)(Rb * K + C) * 2u; }
    const size_t kstep = (size_t)(BK * 2);
    const size_t hstep = (size_t)HALF * K * 2;
    const size_t tstep = 2 * hstep;
    const unsigned ldsw = (unsigned)wid * 1024u;
    const int aoff = lds_byte(wr * 64 + fr, fq * 8), boff = lds_byte(wc * 32 + fr, fq * 8);
#define PG8_SA(b, h) (((b) * 2 + (h)) * HTB)
#define PG8_SB(b, h) ((4 + (b) * 2 + (h)) * HTB)
#define PG8_STAGE(bufoff, gbase, voff) do { _Pragma("unroll") for (int _i = 0; _i < 2; ++_i) \
        __builtin_amdgcn_global_load_lds((const unsigned*)((const char*)(gbase) + (voff)[_i]), (PG8_LAS unsigned*)(lds + (bufoff) + ldsw + _i * 8192), 16, 0, 0); } while (0)
#define PG8_LDA(dst, b, h) do { _Pragma("unroll") for (int m = 0; m < 4; ++m) _Pragma("unroll") for (int k = 0; k < 2; ++k) dst[m][k] = *(const PG8_LAS bf16x8*)(lds + PG8_SA(b, h) + aoff + m * 2048 + k * 1024); } while (0)
#define PG8_LDB(dst, b, h) do { _Pragma("unroll") for (int n = 0; n < 2; ++n) _Pragma("unroll") for (int k = 0; k < 2; ++k) dst[n][k] = *(const PG8_LAS bf16x8*)(lds + PG8_SB(b, h) + boff + n * 2048 + k * 1024); } while (0)
#define PG8_MMA(ai, bj, At, Bt) do { __builtin_amdgcn_s_setprio(1); _Pragma("unroll") for (int m = 0; m < 4; ++m) _Pragma("unroll") for (int n = 0; n < 2; ++n) _Pragma("unroll") for (int k = 0; k < 2; ++k) \
        acc[ai][bj][m][n] = __builtin_amdgcn_mfma_f32_16x16x32_bf16(Bt[n][k], At[m][k], acc[ai][bj][m][n], 0, 0, 0); __builtin_amdgcn_s_setprio(0); } while (0)
#define PG8_WAIT_V(n) asm volatile("s_waitcnt vmcnt(" #n ")" ::: "memory")
#define PG8_WAIT_L(n) asm volatile("s_waitcnt lgkmcnt(" #n ")" ::: "memory")
#define PG8_WAIT_VA do { if constexpr (Copy::ACTIVE) { PG8_WAIT_V(12); } else { PG8_WAIT_V(8); } } while (0)
#define PG8_WAIT_VB do { if constexpr (Copy::ACTIVE) { PG8_WAIT_V(10); } else { PG8_WAIT_V(8); } } while (0)
#define PG8_BAR __builtin_amdgcn_s_barrier()
#define PG8_SCHED __builtin_amdgcn_sched_barrier(0)
    Unit cur, nxt; int ui = 0;
    if (!S.next(0, cur)) return;
    f32x4 acc[2][2][4][2];
#pragma unroll
    for (int a = 0; a < 2; ++a)
#pragma unroll
        for (int b = 0; b < 2; ++b)
#pragma unroll
            for (int m = 0; m < 4; ++m)
#pragma unroll
                for (int n = 0; n < 2; ++n) acc[a][b][m][n] = (f32x4){0.f, 0.f, 0.f, 0.f};
    bf16x8 At[4][2], B0[2][2], B1[2][2];
    const char* cA = (const char*)g.A + (size_t)cur.pm * tstep + (size_t)cur.kt0 * kstep; const char* cB = (const char*)g.Bt + (size_t)cur.pn * tstep + (size_t)cur.kt0 * kstep;
    S.a_ready(cur);
    C.prime();
    if constexpr (SP2) {
        PG8_STAGE(PG8_SB(0, 0), cB, voffB); PG8_STAGE(PG8_SB(0, 1), cB + hstep, voffB); PG8_STAGE(PG8_SA(0, 0), cA, voffA); PG8_STAGE(PG8_SA(0, 1), cA + hstep, voffA);
        if (wr == 1) PG8_BAR;
        PG8_WAIT_V(2); PG8_BAR;
        PG8_STAGE(PG8_SB(1, 0), cB + kstep, voffB); PG8_STAGE(PG8_SA(1, 0), cA + kstep, voffA); PG8_STAGE(PG8_SB(1, 1), cB + hstep + kstep, voffB);
        PG8_WAIT_V(6); PG8_BAR;
    } else {
        PG8_STAGE(PG8_SB(0, 0), cB, voffB); PG8_STAGE(PG8_SA(0, 0), cA, voffA); PG8_STAGE(PG8_SB(0, 1), cB + hstep, voffB); PG8_STAGE(PG8_SA(0, 1), cA + hstep, voffA);
        if (wr == 1) PG8_BAR;
        PG8_WAIT_V(4); PG8_BAR;
        PG8_STAGE(PG8_SB(1, 0), cB + kstep, voffB); PG8_STAGE(PG8_SA(1, 0), cA + kstep, voffA); PG8_STAGE(PG8_SB(1, 1), cB + hstep + kstep, voffB);
        PG8_WAIT_V(6); PG8_BAR;
    }
    for (;;) {
        const bool has_next = S.next(ui + 1, nxt);
        const char* nA = has_next ? (const char*)g.A + (size_t)nxt.pm * tstep + (size_t)nxt.kt0 * kstep : cA; const char* nB = has_next ? (const char*)g.Bt + (size_t)nxt.pn * tstep + (size_t)nxt.kt0 * kstep : cB;
        const int nt = cur.nkt;
#pragma nounroll
        for (int t = 0; t < nt; t += 2) {
            const bool last = (t == nt - 2);
            const char* a1 = cA + (size_t)(t + 1) * kstep;
            const char* a2 = last ? nA : cA + (size_t)(t + 2) * kstep; const char* b2 = last ? nB : cB + (size_t)(t + 2) * kstep;
            const char* a3 = a2 + kstep; const char* b3 = b2 + kstep;
            if (last && has_next) S.a_ready(nxt);
            if constexpr (SP2) {
            PG8_LDB(B0, 0, 0); PG8_LDB(B1, 0, 1); PG8_SCHED; PG8_LDA(At, 0, 0); PG8_STAGE(PG8_SA(1, 1), a1 + hstep, voffA);
            C.template step<0>(); PG8_WAIT_VA; PG8_WAIT_L(0); PG8_BAR; PG8_MMA(0, 0, At, B0); PG8_MMA(0, 1, At, B1); PG8_BAR; PG8_SCHED;
            PG8_LDA(At, 0, 1); PG8_STAGE(PG8_SB(0, 0), b2, voffB); PG8_STAGE(PG8_SB(0, 1), b2 + hstep, voffB); PG8_STAGE(PG8_SA(0, 0), a2, voffA);
            PG8_WAIT_VB; PG8_WAIT_L(0); PG8_BAR; PG8_MMA(1, 0, At, B0); PG8_MMA(1, 1, At, B1); PG8_BAR; PG8_SCHED;
            PG8_LDB(B0, 1, 0); PG8_LDB(B1, 1, 1); PG8_SCHED; PG8_LDA(At, 1, 0); PG8_STAGE(PG8_SA(0, 1), a2 + hstep, voffA);
            C.template step<1>(); PG8_WAIT_VA; PG8_WAIT_L(0); PG8_BAR; PG8_MMA(0, 0, At, B0); PG8_MMA(0, 1, At, B1); PG8_BAR; PG8_SCHED;
            PG8_LDA(At, 1, 1); PG8_STAGE(PG8_SB(1, 0), b3, voffB); PG8_STAGE(PG8_SB(1, 1), b3 + hstep, voffB); PG8_STAGE(PG8_SA(1, 0), a3, voffA);
            PG8_WAIT_VB; PG8_WAIT_L(0); PG8_BAR; PG8_MMA(1, 0, At, B0); PG8_MMA(1, 1, At, B1); PG8_BAR; PG8_SCHED;
            } else {
            PG8_LDB(B0, 0, 0); PG8_SCHED; PG8_LDA(At, 0, 0); PG8_STAGE(PG8_SA(1, 1), a1 + hstep, voffA);
            PG8_WAIT_L(8); PG8_BAR; PG8_WAIT_L(0); PG8_MMA(0, 0, At, B0); PG8_BAR; PG8_SCHED;
            PG8_LDB(B1, 0, 1); PG8_STAGE(PG8_SB(0, 0), b2, voffB);
            PG8_BAR; PG8_WAIT_L(0); PG8_MMA(0, 1, At, B1); PG8_BAR;
            PG8_LDA(At, 0, 1); PG8_STAGE(PG8_SA(0, 0), a2, voffA);
            PG8_BAR; PG8_WAIT_L(0); PG8_MMA(1, 0, At, B0); PG8_BAR; PG8_SCHED;
            PG8_STAGE(PG8_SB(0, 1), b2 + hstep, voffB);
            PG8_WAIT_V(6); PG8_BAR; PG8_MMA(1, 1, At, B1); PG8_BAR;
            PG8_LDB(B0, 1, 0); PG8_SCHED; PG8_LDA(At, 1, 0); PG8_STAGE(PG8_SA(0, 1), a2 + hstep, voffA);
            PG8_WAIT_L(8); PG8_BAR; PG8_WAIT_L(0); PG8_MMA(0, 0, At, B0); PG8_BAR; PG8_SCHED;
            PG8_LDB(B1, 1, 1); PG8_STAGE(PG8_SB(1, 0), b3, voffB);
            PG8_BAR; PG8_WAIT_L(0); PG8_MMA(0, 1, At, B1); PG8_BAR;
            PG8_LDA(At, 1, 1); PG8_STAGE(PG8_SA(1, 0), a3, voffA);
            PG8_BAR; PG8_WAIT_L(0); PG8_MMA(1, 0, At, B0); PG8_BAR; PG8_SCHED;
            PG8_STAGE(PG8_SB(1, 1), b3 + hstep, voffB);
            PG8_WAIT_V(6); PG8_BAR; PG8_MMA(1, 1, At, B1); PG8_BAR;
            }
        }
        if constexpr (ALIGN_EPI) { if (wr == 0) PG8_BAR; }
        if constexpr (!Epi::AFTER_DRAIN) { E(acc, cur, wr, wc, fr, fq); S.done(cur); }
        if (!has_next) break;
#pragma unroll
        for (int a = 0; a < 2; ++a)
#pragma unroll
            for (int b = 0; b < 2; ++b)
#pragma unroll
                for (int m = 0; m < 4; ++m)
#pragma unroll
                    for (int n = 0; n < 2; ++n) acc[a][b][m][n] = (f32x4){0.f, 0.f, 0.f, 0.f};
        cur = nxt; cA = nA; cB = nB; ++ui;
        if constexpr (ALIGN_EPI) { if (wr == 1) PG8_BAR; }
    }
    PG8_WAIT_V(0);
    C.flush();
    if constexpr (!ALIGN_EPI) { if (wr == 0) PG8_BAR; }
    PG8_BAR;
    if constexpr (Epi::AFTER_DRAIN) { E.fused(acc, cur, wr, wc, fr, fq, lds, wid, lane); S.done(cur); }
#undef PG8_SA
#undef PG8_SB
#undef PG8_STAGE
#undef PG8_LDA
#undef PG8_LDB
#undef PG8_MMA
#undef PG8_WAIT_V
#undef PG8_WAIT_L
#undef PG8_WAIT_VA
#undef PG8_WAIT_VB
#undef PG8_BAR
#undef PG8_SCHED
}
}
constexpr size_t MiB = 1u << 20;
constexpr size_t WS_CTL = 0, CTL_ZERO_BYTES = 1 * MiB;
constexpr size_t WS_WGU1 = 2 * MiB, WS_WD1 = 14 * MiB, WS_WIN = 20 * MiB, WS_WOUT = 25 * MiB, WS_WGU2 = 28 * MiB, WS_WD2 = 40 * MiB, WS_WPG = 46 * MiB, WS_WPP = 49 * MiB, WS_ROPE = 50 * MiB;
constexpr size_t WS_RS = 54 * MiB;
constexpr size_t WS_XB = 56 * MiB;
constexpr size_t WS_H = 92 * MiB;
constexpr size_t WS_ACT = 160 * MiB;
constexpr size_t WS_Y = 252 * MiB;
constexpr size_t WS_QKV = 288 * MiB;
constexpr size_t WS_ATT = 364 * MiB;
constexpr size_t WS_OP2 = 400 * MiB, WS_OP3 = 418 * MiB;
constexpr size_t WS_LS2 = 436 * MiB, WS_LS3 = 437 * MiB;
constexpr size_t WS_PB = 438 * MiB;
constexpr size_t WS_PP = 448 * MiB;
constexpr size_t WS_SLAB = 484 * MiB;
constexpr size_t WS_END = 492 * MiB;
static_assert(WS_WGU1 + (size_t)2 * FF * D * 2 <= WS_WD1 && WS_WD1 + (size_t)D * FF * 2 <= WS_WIN && WS_WIN + (size_t)NIN * D * 2 <= WS_WOUT && WS_WOUT + (size_t)D * D * 2 <= WS_WGU2 &&
              WS_WGU2 + (size_t)2 * FF * D * 2 <= WS_WD2 && WS_WD2 + (size_t)D * FF * 2 <= WS_WPG && WS_WPG + (size_t)D * D * 2 <= WS_WPP && WS_WPP + (size_t)D * DPLE * 2 <= WS_ROPE &&
              WS_ROPE + (size_t)8193 * 64 * 4 <= WS_RS && WS_RS + (size_t)MT * 4 <= WS_XB && WS_XB + (size_t)MT * D * 2 <= WS_H && WS_H + (size_t)MT * D * 4 <= WS_ACT &&
              WS_ACT + (size_t)MT * FF * 2 <= WS_Y && WS_Y + (size_t)MT * D * 2 <= WS_QKV && WS_QKV + (size_t)MT * NIN * 2 <= WS_ATT && WS_ATT + (size_t)MT * D * 2 <= WS_OP2 &&
              WS_OP2 + (size_t)MP * 512 * 2 <= WS_OP3 && WS_OP3 + (size_t)MP * 512 * 2 <= WS_LS2 && WS_LS2 + (size_t)MP * 8 * 4 <= WS_LS3 && WS_LS3 + (size_t)MP * 8 * 4 <= WS_PB &&
              WS_PB + (size_t)MT * DPLE * 2 <= WS_PP && WS_PP + (size_t)MT * D * 2 <= WS_SLAB && WS_SLAB + (size_t)11 * 128 * D * 4 <= WS_END, "d_ws map");
constexpr int CW_BAR = 4096;
constexpr int CW_CUR = 8192;
constexpr int CW_DONE = 8256;
constexpr int RING_OFF = 0, RING_BYTES = 131072;
constexpr int LDSCTL_OFF = RING_BYTES, MISC_OFF = LDSCTL_OFF + 320;
constexpr int LDS_BYTES = 147456;
static_assert(MISC_OFF + 128 <= LDS_BYTES, "LDS map");

#define GAS __attribute__((address_space(1)))
#define LAS __attribute__((address_space(3)))
typedef unsigned short bf16;
typedef unsigned v4u __attribute__((ext_vector_type(4)));
typedef float f32x4 __attribute__((ext_vector_type(4)));
typedef short bf16x8 __attribute__((ext_vector_type(8)));
typedef GAS unsigned gu32;
typedef GAS unsigned long long gu64;
#define RLX_AGENT __ATOMIC_RELAXED, __HIP_MEMORY_SCOPE_AGENT
#define LDS_WAIT() asm volatile("s_waitcnt lgkmcnt(0)" ::: "memory")
#define VM_WAIT() asm volatile("s_waitcnt vmcnt(0)" ::: "memory")
__device__ __forceinline__ unsigned long long rt() { return __builtin_amdgcn_s_memrealtime(); }
__device__ __forceinline__ unsigned f2bf(float f) { unsigned u = __builtin_bit_cast(unsigned, f); return (u + 0x7fffu + ((u >> 16) & 1u)) >> 16; }
__device__ __forceinline__ unsigned pk2(float lo, float hi) { return f2bf(lo) | (f2bf(hi) << 16); }

#define XB_TMO      128
#define XB_XCNT(j)  (256  + 64 * (j))
#define XB_XSUB(j)  (1280 + 64 * (j))
#define XB_XGEN(j)  (2304 + 64 * (j))
#define XB_TOP      3328
#define XB_TOPGEN   3392
#define XCD_BAR_WORDS 3456
#define XB_SPIN_CAP (1u << 18)

__device__ __forceinline__ unsigned xb_ld(unsigned* p)              { return __hip_atomic_load(p, __ATOMIC_RELAXED, __HIP_MEMORY_SCOPE_AGENT); }
__device__ __forceinline__ unsigned xb_add(unsigned* p, unsigned v) { return __hip_atomic_fetch_add(p, v, __ATOMIC_RELAXED, __HIP_MEMORY_SCOPE_AGENT); }
__device__ __forceinline__ unsigned xb_xcc_id() { return (unsigned)__builtin_amdgcn_s_getreg((3 << 11) | 20) & 0xFu; }
#define XB_SPIN(cond, bar) do { unsigned _sp = 0; while (cond) { __builtin_amdgcn_s_sleep(1); \
    if ((++_sp & 255u) == 0u) { if (xb_ld(&(bar)[XB_TMO])) break; if (_sp > XB_SPIN_CAP) { atomicAdd(&(bar)[XB_TMO], 1u); break; } } } } while (0)

struct XcdBarrier {
    unsigned* bar; unsigned x;
    volatile LAS unsigned* st;
};

__device__ __forceinline__ XcdBarrier xcd_barrier_post(unsigned* bar, volatile LAS unsigned* st) {
    XcdBarrier b; b.bar = bar; b.x = xb_xcc_id(); b.st = st;
    if (threadIdx.x == 0) (void)xb_add(&bar[XB_XCNT(b.x)], 1u);
    return b;
}
__device__ __forceinline__ void xcd_barrier_complete(unsigned* bar, unsigned x, unsigned& nloc, unsigned& nx) {
    const unsigned G = gridDim.x * gridDim.y * gridDim.z;
    unsigned sum, cnt, mine, sp = 0u;
    for (;;) {
        sum = 0u; cnt = 0u; mine = 0u;
#pragma unroll
        for (unsigned j = 0; j < 16; ++j) { const unsigned c = xb_ld(&bar[XB_XCNT(j)]); sum += c; cnt += (c > 0u) ? 1u : 0u; mine = (j == x) ? c : mine; }
        if (sum == G) break;
        __builtin_amdgcn_s_sleep(1);
        if ((++sp & 255u) == 0u) { if (xb_ld(&bar[XB_TMO])) break; if (sp > XB_SPIN_CAP) { atomicAdd(&bar[XB_TMO], 1u); break; } }
    }
    nloc = mine > 0u ? mine : 1u; nx = cnt > 0u ? cnt : 1u;
}

__device__ __forceinline__ void xcd_barrier(const XcdBarrier& b) {
    asm volatile("s_waitcnt vmcnt(0)" ::: "memory");
    __syncthreads();
    if (threadIdx.x == 0) {
        unsigned* bar = b.bar;
        __builtin_amdgcn_s_waitcnt(0);
        unsigned nloc = b.st[0], nx = b.st[1];
        if (nloc == 0u) { xcd_barrier_complete(bar, b.x, nloc, nx); b.st[0] = nloc; b.st[1] = nx; }
        const unsigned old = xb_add(&bar[XB_XSUB(b.x)], 1u);
        const unsigned gen = old / nloc;
        if (old + 1u == (gen + 1u) * nloc) {
            __builtin_amdgcn_fence(__ATOMIC_RELEASE, "agent");
            asm volatile("s_waitcnt vmcnt(0)" ::: "memory");
            const unsigned og = xb_add(&bar[XB_TOP], 1u);
            const unsigned tg = og / nx;
            if (og + 1u == (tg + 1u) * nx) xb_add(&bar[XB_TOPGEN], 1u);
            else XB_SPIN(xb_ld(&bar[XB_TOPGEN]) == tg, bar);
            __builtin_amdgcn_fence(__ATOMIC_ACQUIRE, "agent");
            xb_add(&bar[XB_XGEN(b.x)], 1u);
            asm volatile("s_waitcnt vmcnt(0)" ::: "memory");
        } else {
            XB_SPIN(xb_ld(&bar[XB_XGEN(b.x)]) == gen, bar);
            __builtin_amdgcn_fence(__ATOMIC_ACQUIRE, "agent");
            asm volatile("s_waitcnt vmcnt(0)" ::: "memory");
        }
    }
    __syncthreads();
}

typedef unsigned u32x2g __attribute__((ext_vector_type(2)));
typedef float f32x16 __attribute__((ext_vector_type(16)));
typedef short s16x4 __attribute__((ext_vector_type(4)));
struct Args { const float* in[27]; float* out; unsigned char* ws; };
struct Frame {
    LAS unsigned char* lds;
    volatile LAS unsigned* MISC;
    gu32* ctl;
    int tid, lane, wave;
    int vcu, G;
    int copy_cur;
};
__device__ __forceinline__ float wave_sum(float v) {
#pragma unroll
    for (int o = 1; o < 64; o <<= 1) v += __shfl_xor(v, o);
    return v;
}
__device__ __forceinline__ float bf_lo(unsigned w) { return __uint_as_float(w << 16); }
__device__ __forceinline__ float bf_hi(unsigned w) { return __uint_as_float(w & 0xffff0000u); }

enum { MAP_ID = 0, MAP_GATE = 1, MAP_UP = 2, MAP_ROPE = 3 };
__host__ __device__ __forceinline__ int map_row(int kind, int n) {
    if (kind == MAP_ID) return n;
    if (kind == MAP_ROPE) {
        const int pn = n >> 8, c = n & 255, hl = c >> 6, d = c & 63;
        const int bj = hl >> 1, wch = hl & 1, nn = d >> 5, dd = d & 31, wcl = dd >> 4, fq = (dd >> 2) & 3, i = dd & 3;
        const int wc = wch * 2 + wcl;
        return pn * 256 + 128 * bj + 32 * wc + 8 * fq + 4 * nn + i;
    }
    const int pn = n >> 7, o = n & 127, wc = o >> 5, fq = (o >> 3) & 3, bj = (o >> 2) & 1, i = o & 3;
    return pn * 256 + 128 * bj + 32 * wc + 8 * fq + 4 * (kind == MAP_UP ? 1 : 0) + i;
}
__device__ __forceinline__ void p0_transpose_item(const float* W, int K, int N, bf16* WT, int kind, const float* gain, LAS float* scr, int item, int lane) {
    const int nblk = N / 32, kb = item / nblk, nb = item % nblk, k0 = 64 * kb, n0 = 32 * nb;
    float wv[32];
#pragma unroll
    for (int i = 0; i < 32; ++i) { const int kk = 2 * i + (lane >> 5); wv[i] = W[(size_t)(k0 + kk) * N + n0 + (lane & 31)]; }
#pragma unroll
    for (int i = 0; i < 32; ++i) { const int kk = 2 * i + (lane >> 5); const float g = gain ? gain[k0 + kk] : 1.0f; scr[kk * 33 + (lane & 31)] = wv[i] * g; }
    LDS_WAIT(); asm volatile("" ::: "memory");
    const int c = lane & 7;
#pragma unroll
    for (int j = 0; j < 4; ++j) { const int n = (lane >> 3) + 8 * j; const LAS float* s = scr + (8 * c) * 33 + n;
        v4u o; o.x = pk2(s[0 * 33], s[1 * 33]); o.y = pk2(s[2 * 33], s[3 * 33]); o.z = pk2(s[4 * 33], s[5 * 33]); o.w = pk2(s[6 * 33], s[7 * 33]);
        *(GAS v4u*)(WT + (size_t)map_row(kind, n0 + n) * K + k0 + 8 * c) = o; }
    LDS_WAIT(); asm volatile("" ::: "memory");
}
__device__ __forceinline__ void row_to_bf16_rs(int lane, const float* xrow, bf16* orow, float* rs) {
    const GAS f32x4* xr = (const GAS f32x4*)xrow + lane;
    f32x4 v[4]; float s = 0.f;
#pragma unroll
    for (int j = 0; j < 4; ++j) { v[j] = xr[64 * j]; s += (v[j].x * v[j].x + v[j].y * v[j].y) + (v[j].z * v[j].z + v[j].w * v[j].w); }
    s = wave_sum(s);
    GAS unsigned long long* o8 = (GAS unsigned long long*)orow + lane;
#pragma unroll
    for (int j = 0; j < 4; ++j) o8[64 * j] = (unsigned long long)pk2(v[j].x, v[j].y) | ((unsigned long long)pk2(v[j].z, v[j].w) << 32);
    if (lane == 0) *rs = 1.0f / sqrtf(s * (1.0f / D) + EPS);
}

__device__ __forceinline__ void rows2_to_bf16_rs(int lane, const float* xa, const float* xb, bf16* oa, bf16* ob, float* ra, float* rb) {
    const GAS f32x4* pa = (const GAS f32x4*)xa + lane; const GAS f32x4* pb = (const GAS f32x4*)xb + lane;
    f32x4 va[4], vb[4]; float sa = 0.f, sb = 0.f;
#pragma unroll
    for (int j = 0; j < 4; ++j) { va[j] = pa[64 * j]; vb[j] = pb[64 * j]; }
#pragma unroll
    for (int j = 0; j < 4; ++j) { sa += (va[j].x * va[j].x + va[j].y * va[j].y) + (va[j].z * va[j].z + va[j].w * va[j].w); sb += (vb[j].x * vb[j].x + vb[j].y * vb[j].y) + (vb[j].z * vb[j].z + vb[j].w * vb[j].w); }
    sa = wave_sum(sa); sb = wave_sum(sb);
    GAS unsigned long long* qa = (GAS unsigned long long*)oa + lane; GAS unsigned long long* qb = (GAS unsigned long long*)ob + lane;
#pragma unroll
    for (int j = 0; j < 4; ++j) { qa[64 * j] = (unsigned long long)pk2(va[j].x, va[j].y) | ((unsigned long long)pk2(va[j].z, va[j].w) << 32); qb[64 * j] = (unsigned long long)pk2(vb[j].x, vb[j].y) | ((unsigned long long)pk2(vb[j].z, vb[j].w) << 32); }
    if (lane == 0) { *ra = 1.0f / sqrtf(sa * (1.0f / D) + EPS); *rb = 1.0f / sqrtf(sb * (1.0f / D) + EPS); }
}

__device__ __forceinline__ void copy_shift(const float* src, float* dst, int nbatch, int L, int RW, int gtid, int gthreads) {
    const unsigned per_b4 = (unsigned)(L - 1) * RW / 4, blk4 = (unsigned)L * RW / 4, shift4 = (unsigned)RW / 4, total = per_b4 * (unsigned)nbatch;
    const GAS f32x4* s4 = (const GAS f32x4*)src; GAS f32x4* d4 = (GAS f32x4*)dst;
    for (unsigned i0 = gtid; i0 < total; i0 += 4u * gthreads) { f32x4 v[4]; unsigned o[4];
#pragma unroll
        for (int q = 0; q < 4; ++q) { unsigned i = i0 + q * gthreads; i = i < total ? i : total - 1; const unsigned b = i / per_b4, e = i - b * per_b4; o[q] = b * blk4 + e; v[q] = __builtin_nontemporal_load(s4 + o[q] + shift4); }
#pragma unroll
        for (int q = 0; q < 4; ++q) __builtin_nontemporal_store(v[q], d4 + o[q]); }
}

__device__ __forceinline__ void p0_prologue(Frame& F, const Args& A) {
    unsigned char* ws = A.ws;
    LAS float* scr = (LAS float*)(F.lds + RING_OFF + F.wave * 16384);
    const int gw = F.vcu * NWAVES + F.wave, NGW = F.G * NWAVES;
    constexpr int I_GU = (D / 64) * (FF / 32), I_DN = (FF / 64) * (D / 32), I_IN = (D / 64) * (NIN / 32), I_SQ = (D / 64) * (D / 32), I_PP = (DPLE / 64) * (D / 32);
    constexpr int NITEMS = 4 * I_GU + 2 * I_DN + I_IN + 2 * I_SQ + I_PP;
    for (int it = gw; it < NITEMS; it += NGW) {
        int r = it;
        if (r < I_GU) { p0_transpose_item(A.in[10], D, FF, (bf16*)(ws + WS_WGU1), MAP_GATE, A.in[8], scr, r, F.lane); continue; } r -= I_GU;
        if (r < I_GU) { p0_transpose_item(A.in[11], D, FF, (bf16*)(ws + WS_WGU1), MAP_UP, A.in[8], scr, r, F.lane); continue; } r -= I_GU;
        if (r < I_DN) { p0_transpose_item(A.in[12], FF, D, (bf16*)(ws + WS_WD1), MAP_ID, nullptr, scr, r, F.lane); continue; } r -= I_DN;
        if (r < I_IN) { p0_transpose_item(A.in[15], D, NIN, (bf16*)(ws + WS_WIN), MAP_ROPE, A.in[13], scr, r, F.lane); continue; } r -= I_IN;
        if (r < I_SQ) { p0_transpose_item(A.in[17], D, D, (bf16*)(ws + WS_WOUT), MAP_ID, nullptr, scr, r, F.lane); continue; } r -= I_SQ;
        if (r < I_GU) { p0_transpose_item(A.in[20], D, FF, (bf16*)(ws + WS_WGU2), MAP_GATE, A.in[18], scr, r, F.lane); continue; } r -= I_GU;
        if (r < I_GU) { p0_transpose_item(A.in[21], D, FF, (bf16*)(ws + WS_WGU2), MAP_UP, A.in[18], scr, r, F.lane); continue; } r -= I_GU;
        if (r < I_DN) { p0_transpose_item(A.in[22], FF, D, (bf16*)(ws + WS_WD2), MAP_ID, nullptr, scr, r, F.lane); continue; } r -= I_DN;
        if (r < I_SQ) { p0_transpose_item(A.in[25], D, D, (bf16*)(ws + WS_WPG), MAP_ID, A.in[23], scr, r, F.lane); continue; } r -= I_SQ;
        p0_transpose_item(A.in[26], DPLE, D, (bf16*)(ws + WS_WPP), MAP_ID, nullptr, scr, r, F.lane);
    }
    bf16* XB = (bf16*)(ws + WS_XB); float* RS = (float*)(ws + WS_RS);
    for (int m = gw; m < MR; m += 2 * NGW) { const int m2 = (m + NGW < MR) ? m + NGW : m;
        const float* xr = (m < MP) ? A.in[0] + (size_t)m * D : A.in[1] + (size_t)(m - MP) * D; const float* xr2 = (m2 < MP) ? A.in[0] + (size_t)m2 * D : A.in[1] + (size_t)(m2 - MP) * D;
        rows2_to_bf16_rs(F.lane, xr, xr2, XB + (size_t)m * D, XB + (size_t)m2 * D, RS + m, RS + m2); }
    bf16* PB = (bf16*)(ws + WS_PB);
    for (int m0 = gw; m0 < MR; m0 += 4 * NGW) { f32x4 v[4]; int mm[4];
#pragma unroll
        for (int q = 0; q < 4; ++q) { const int m = (m0 + q * NGW < MR) ? m0 + q * NGW : m0; mm[q] = m; const float* pr = (m < MP) ? A.in[6] + (size_t)m * DPLE : A.in[7] + (size_t)(m - MP) * DPLE; v[q] = *((const GAS f32x4*)pr + F.lane); }
#pragma unroll
        for (int q = 0; q < 4; ++q) *((GAS unsigned long long*)(PB + (size_t)mm[q] * DPLE) + F.lane) = (unsigned long long)pk2(v[q].x, v[q].y) | ((unsigned long long)pk2(v[q].z, v[q].w) << 32); }
    { float* rope = (float*)(ws + WS_ROPE); const int gt = gw * 64 + F.lane, NGT = NGW * 64;
      for (int i = gt; i < 8193 * 32; i += NGT) { const int idx = i >> 5, d = i & 31; const float pos = (float)(idx < SEQ ? idx : PAST);
          const float inv = powf(10000.0f, -(float)d * (1.0f / 32.0f)); const float ang = pos * inv;
          rope[2 * i] = cosf(ang); rope[2 * i + 1] = sinf(ang); } }
    { const int gt = gw * 64 + F.lane, NGT = NGW * 64;
      copy_shift(A.in[4], A.out + O_BKS, MS, LB, 128, gt, NGT);
      copy_shift(A.in[5], A.out + O_BVS, MS, LB, 128, gt, NGT); }
}

constexpr int CHUNK_OPS = 32, CHUNKS_PER_BUF = 128, NCHUNKS = 256 * CHUNKS_PER_BUF, OPS_PER_BUF = 4094;
__device__ __forceinline__ void side_copy(const Args& A, gu32* ctl, int lane, int done_word, unsigned done_target) {
    for (;;) {
        unsigned id = 0; if (lane == 0) id = __hip_atomic_fetch_add(ctl + CW_CUR, 1u, RLX_AGENT); id = (unsigned)__builtin_amdgcn_readfirstlane((int)id);
        if (id >= (unsigned)NCHUNKS) break;
        const int buf = (int)(id >> 7), sub = (int)(id & 127), op0 = sub * CHUNK_OPS, nops = (OPS_PER_BUF - op0) < CHUNK_OPS ? (OPS_PER_BUF - op0) : CHUNK_OPS;
        const GAS f32x4* s4 = (const GAS f32x4*)(A.in[2 + (buf >> 7)] + (size_t)(buf & 127) * LA * 512 + 512) + (size_t)op0 * 64 + lane;
        GAS f32x4* d4 = (GAS f32x4*)(A.out + ((buf >> 7) ? O_AVS : O_AKS) + (size_t)(buf & 127) * LA * 512) + (size_t)op0 * 64 + lane;
        f32x4 v[CHUNK_OPS];
#pragma unroll
        for (int q = 0; q < CHUNK_OPS; ++q) { const int qq = q < nops ? q : nops - 1; v[q] = __builtin_nontemporal_load(s4 + qq * 64); }
#pragma unroll
        for (int q = 0; q < CHUNK_OPS; ++q) { const int qq = q < nops ? q : nops - 1; __builtin_nontemporal_store(v[q], d4 + qq * 64); }
        if (done_word >= 0 && (unsigned)__builtin_amdgcn_readfirstlane((int)__hip_atomic_load(ctl + done_word, RLX_AGENT)) >= done_target) break;
    }
}

#ifdef PROBE_COPYX2
__device__ __forceinline__ void side_copy2(const Args& A, gu32* ctl, int lane) {
    for (;;) {
        unsigned id = 0; if (lane == 0) id = __hip_atomic_fetch_add(ctl + CW_CUR + 64 * 20, 1u, RLX_AGENT); id = (unsigned)__builtin_amdgcn_readfirstlane((int)id);
        if (id >= (unsigned)NCHUNKS) break;
        const int buf = (int)(id >> 7), sub = (int)(id & 127), op0 = sub * CHUNK_OPS, nops = (OPS_PER_BUF - op0) < CHUNK_OPS ? (OPS_PER_BUF - op0) : CHUNK_OPS;
        const GAS f32x4* s4 = (const GAS f32x4*)(A.in[2 + (buf >> 7)] + (size_t)(buf & 127) * LA * 512 + 512) + (size_t)op0 * 64 + lane;
        GAS f32x4* d4 = (GAS f32x4*)(A.out + ((buf >> 7) ? O_AVS : O_AKS) + (size_t)(buf & 127) * LA * 512) + (size_t)op0 * 64 + lane;
        f32x4 v[CHUNK_OPS];
#pragma unroll
        for (int q = 0; q < CHUNK_OPS; ++q) { const int qq = q < nops ? q : nops - 1; v[q] = __builtin_nontemporal_load(s4 + qq * 64); }
#pragma unroll
        for (int q = 0; q < CHUNK_OPS; ++q) { const int qq = q < nops ? q : nops - 1; __builtin_nontemporal_store(v[q], d4 + qq * 64); }
    }
}
#endif
template <int MODE, int NSPLIT> __device__ __forceinline__ void norm_phase(Frame& F, const Args& A, const float* gpost, float coef) {
    unsigned char* ws = A.ws;
    const bf16* Y = (const bf16*)(ws + WS_Y); bf16* XB = (bf16*)(ws + WS_XB); float* RS = (float*)(ws + WS_RS);
    const float* SL = (const float*)(ws + WS_SLAB); const bf16* PP = (const bf16*)(ws + WS_PP);
    int lane_ = F.lane; asm volatile("" : "+v"(lane_));
    const int gw = F.vcu * NWAVES + F.wave, NGW = F.G * NWAVES, lane = lane_;
    f32x4 g[4];
#pragma unroll
    for (int j = 0; j < 4; ++j) g[j] = *((const GAS f32x4*)gpost + lane + 64 * j) * coef;
    for (int m = gw; m < MR; m += NGW) {
        const float* hsrc = (m < MP) ? A.in[0] + (size_t)m * D : A.in[1] + (size_t)(m - MP) * D;
        float* hdst = (m < MP) ? A.out + O_YP + (size_t)m * D : A.out + O_YS + (size_t)(m - MP) * D;
        f32x4 y[4], h[4]; float s = 0.f;
        if (m < MP) {
            const GAS unsigned long long* y8 = (const GAS unsigned long long*)(Y + (size_t)m * D) + lane;
#pragma unroll
            for (int j = 0; j < 4; ++j) { const unsigned long long w = y8[64 * j]; const unsigned lo = (unsigned)w, hi = (unsigned)(w >> 32);
                y[j] = (f32x4){bf_lo(lo), bf_hi(lo), bf_lo(hi), bf_hi(hi)}; }
        } else {
#pragma unroll
            for (int j = 0; j < 4; ++j) y[j] = (f32x4){0.f, 0.f, 0.f, 0.f};
#pragma unroll 1
            for (int ks = 0; ks < NSPLIT; ++ks) { const GAS f32x4* sp = (const GAS f32x4*)(SL + ((size_t)ks * 128 + (m - MP)) * D) + lane;
#pragma unroll
                for (int j = 0; j < 4; ++j) y[j] = y[j] + sp[64 * j]; }
            if (MODE == 2) { const float r = RS[m]; const GAS unsigned long long* p8 = (const GAS unsigned long long*)(PP + (size_t)m * D) + lane;
#pragma unroll
                for (int j = 0; j < 4; ++j) { const unsigned long long w = p8[64 * j]; const unsigned lo = (unsigned)w, hi = (unsigned)(w >> 32);
                    const f32x4 pp = (f32x4){bf_lo(lo), bf_hi(lo), bf_lo(hi), bf_hi(hi)};
                    y[j].x = pp.x / (1.0f + __expf(-r * y[j].x)); y[j].y = pp.y / (1.0f + __expf(-r * y[j].y)); y[j].z = pp.z / (1.0f + __expf(-r * y[j].z)); y[j].w = pp.w / (1.0f + __expf(-r * y[j].w)); } }
        }
#pragma unroll
        for (int j = 0; j < 4; ++j) { s += (y[j].x * y[j].x + y[j].y * y[j].y) + (y[j].z * y[j].z + y[j].w * y[j].w);
            if (MODE == 0) h[j] = *((const GAS f32x4*)hsrc + lane + 64 * j);
            else { const unsigned long long w = *((const GAS unsigned long long*)(XB + (size_t)m * D) + lane + 64 * j); const unsigned lo = (unsigned)w, hi = (unsigned)(w >> 32);
                h[j] = (f32x4){bf_lo(lo), bf_hi(lo), bf_lo(hi), bf_hi(hi)}; } }
        const float rstd = 1.0f / sqrtf(wave_sum(s) * (1.0f / D) + EPS);
        float s2 = 0.f;
#pragma unroll
        for (int j = 0; j < 4; ++j) { h[j] = h[j] + g[j] * (y[j] * rstd); s2 += (h[j].x * h[j].x + h[j].y * h[j].y) + (h[j].z * h[j].z + h[j].w * h[j].w);
            if (MODE == 2) *((GAS f32x4*)hdst + lane + 64 * j) = h[j]; }
        if (MODE != 2) {
            s2 = wave_sum(s2);
            GAS unsigned long long* o8 = (GAS unsigned long long*)(XB + (size_t)m * D) + lane;
#pragma unroll
            for (int j = 0; j < 4; ++j) o8[64 * j] = (unsigned long long)pk2(h[j].x, h[j].y) | ((unsigned long long)pk2(h[j].z, h[j].w) << 32);
            if (lane == 0) RS[m] = 1.0f / sqrtf(s2 * (1.0f / D) + EPS);
        }
    }
}

__device__ __forceinline__ int crow(int r, int hi) { return (r & 3) + 8 * (r >> 2) + 4 * hi; }
__device__ __forceinline__ unsigned cvtpk(float lo, float hi) { unsigned r; asm volatile("v_cvt_pk_bf16_f32 %0, %1, %2" : "=v"(r) : "v"(lo), "v"(hi)); return r; }
__device__ __forceinline__ float xhalf_max(float v) { return fmaxf(v, __shfl_xor(v, 32)); }
__device__ __forceinline__ float xhalf_sum(float v) { return v + __shfl_xor(v, 32); }
__device__ __forceinline__ s16x4 vtr(const LAS unsigned char* p) { typedef short v4i16_t __attribute__((ext_vector_type(4))); return __builtin_bit_cast(s16x4, __builtin_amdgcn_ds_read_tr16_b64_v4i16((LAS v4i16_t*)p)); }

template <int MODE> __device__ __forceinline__ void attn_task(const bf16* QKV, int b, int qcol, int kcol, int vcol, int tq0_, int dil, LAS unsigned char* vt, int lane,
                                                              bf16* OP, float* LS, int head, float sinkl, const bf16* OP2, const bf16* OP3, const float* LS2, const float* LS3, bf16* ATT, int acol) {
    int tq0 = tq0_; asm volatile("" : "+s"(tq0));
    const int r32 = lane & 31, hi = lane >> 5;
    const GAS unsigned char* qb = (const GAS unsigned char*)QKV;
    const unsigned rowb = (unsigned)b * SEQ;
    bf16x8 qf[4];
    { const unsigned qo = ((rowb + tq0 + dil * r32) * NIN + qcol + hi * 32) * 2u;
#pragma unroll
      for (int d0 = 0; d0 < 4; ++d0) qf[d0] = *(const GAS bf16x8*)(qb + qo + d0 * 16); }
    float m_run = (MODE == 2) ? sinkl : -INFINITY, l_run = (MODE == 2) ? 1.0f : 0.0f;
    f32x16 o0 = {}, o1 = {};
    const int sq0 = tq0 / dil; int j0 = (128 - sq0) / 32; j0 = j0 < 0 ? 0 : j0;
    const int tk_base = tq0 - 128 * dil;
    const int g = lane >> 4, tq = (lane & 15) >> 2, tp = lane & 3;
    const int trow = 4 * (g >> 1) + tq, tsw = ((trow >> 1) & 1) << 6, tcol = 32 * (g & 1) + 8 * tp;
    const LAS unsigned char* ta0 = vt + trow * 128 + ((0 ^ tsw) + tcol);
    const LAS unsigned char* ta1 = vt + trow * 128 + ((64 ^ tsw) + tcol);
    const int vkey = lane >> 3, vch = lane & 7;
    const unsigned kstep = (unsigned)(32 * dil * NIN * 2), vustep = (unsigned)(8 * dil * NIN * 2);
    unsigned ko = ((rowb + tk_base + 32 * dil * j0 + dil * r32) * NIN + kcol + hi * 32) * 2u;
    unsigned vo = ((rowb + tk_base + 32 * dil * j0 + dil * vkey) * NIN + vcol + vch * 8) * 2u;
    bf16x8 kf[4], vf[4];
#pragma unroll
    for (int d0 = 0; d0 < 4; ++d0) kf[d0] = *(const GAS bf16x8*)(qb + ko + d0 * 16);
#pragma unroll
    for (int u = 0; u < 4; ++u) vf[u] = *(const GAS bf16x8*)(qb + vo + u * vustep);
#pragma unroll 1
    for (int j = j0; j < 5; ++j) {
        f32x16 s = {};
#pragma unroll
        for (int d0 = 0; d0 < 4; ++d0) s = __builtin_amdgcn_mfma_f32_32x32x16_bf16(kf[d0], qf[d0], s, 0, 0, 0);
#pragma unroll
        for (int u = 0; u < 4; ++u) { const int key = 8 * u + vkey; *(LAS bf16x8*)(vt + key * 128 + ((vch * 16) ^ (((key >> 1) & 1) << 6))) = vf[u]; }
        if (j < 4) { ko += kstep; vo += kstep; }
#pragma unroll
        for (int d0 = 0; d0 < 4; ++d0) kf[d0] = *(const GAS bf16x8*)(qb + ko + d0 * 16);
#pragma unroll
        for (int u = 0; u < 4; ++u) vf[u] = *(const GAS bf16x8*)(qb + vo + u * vustep);
        if (j == 0 || j == 4) {
            int qrel = r32 - 4 * hi; asm volatile("" : "+v"(qrel));
            if (j == 0) {
#pragma unroll
                for (int r = 0; r < 16; ++r) s[r] = ((r & 3) + 8 * (r >> 2) < qrel) ? -INFINITY : s[r];
            } else {
#pragma unroll
                for (int r = 0; r < 16; ++r) s[r] = ((r & 3) + 8 * (r >> 2) > qrel) ? -INFINITY : s[r];
            }
        }
        float mx = s[0];
#pragma unroll
        for (int r = 1; r < 16; ++r) mx = fmaxf(mx, s[r]);
        mx = xhalf_max(mx);
        const float m_new = fmaxf(m_run, mx);
        const float alpha = __builtin_amdgcn_exp2f(m_run - m_new);
        float rs = 0.f;
#pragma unroll
        for (int r = 0; r < 16; ++r) { s[r] = __builtin_amdgcn_exp2f(s[r] - m_new); rs += s[r]; }
        rs = xhalf_sum(rs);
        l_run = l_run * alpha + rs; m_run = m_new;
#pragma unroll
        for (int r = 0; r < 16; ++r) { o0[r] *= alpha; o1[r] *= alpha; }
        bf16x8 pk[2];
#pragma unroll
        for (int sl = 0; sl < 2; ++sl) { v4u w; w.x = cvtpk(s[8 * sl + 0], s[8 * sl + 1]); w.y = cvtpk(s[8 * sl + 2], s[8 * sl + 3]); w.z = cvtpk(s[8 * sl + 4], s[8 * sl + 5]); w.w = cvtpk(s[8 * sl + 6], s[8 * sl + 7]);
            pk[sl] = __builtin_bit_cast(bf16x8, w); }
#pragma unroll
        for (int sl = 0; sl < 2; ++sl) {
            const s16x4 a_lo = vtr(ta0 + 2048 * sl), a_hi = vtr(ta0 + 2048 * sl + 1024);
            const s16x4 b_lo = vtr(ta1 + 2048 * sl), b_hi = vtr(ta1 + 2048 * sl + 1024);
            const bf16x8 va = (bf16x8){a_lo[0], a_lo[1], a_lo[2], a_lo[3], a_hi[0], a_hi[1], a_hi[2], a_hi[3]};
            const bf16x8 vb = (bf16x8){b_lo[0], b_lo[1], b_lo[2], b_lo[3], b_hi[0], b_hi[1], b_hi[2], b_hi[3]};
            o0 = __builtin_amdgcn_mfma_f32_32x32x16_bf16(va, pk[sl], o0, 0, 0, 0);
            o1 = __builtin_amdgcn_mfma_f32_32x32x16_bf16(vb, pk[sl], o1, 0, 0, 0);
        }
    }
    const size_t qrow = (size_t)(rowb + tq0 + dil * r32);
    if (MODE == 0) {
        const float inv = 1.0f / l_run;
        bf16* op = OP + qrow * 512 + head * 64 + 4 * hi;
#pragma unroll
        for (int a = 0; a < 4; ++a) {
            u32x2g w0, w1; w0.x = cvtpk(o0[4 * a] * inv, o0[4 * a + 1] * inv); w0.y = cvtpk(o0[4 * a + 2] * inv, o0[4 * a + 3] * inv);
            w1.x = cvtpk(o1[4 * a] * inv, o1[4 * a + 1] * inv); w1.y = cvtpk(o1[4 * a + 2] * inv, o1[4 * a + 3] * inv);
            *(GAS u32x2g*)(op + 8 * a) = w0; *(GAS u32x2g*)(op + 32 + 8 * a) = w1; }
        if (hi == 0) LS[qrow * 8 + head] = m_run + __builtin_amdgcn_logf(l_run);
    } else if (MODE == 1) {
        const float l2 = LS2[qrow * 8 + head], l3 = LS3[qrow * 8 + head];
        const float M = fmaxf(m_run, fmaxf(l2, l3));
        const float w1 = __builtin_amdgcn_exp2f(m_run - M), w2 = __builtin_amdgcn_exp2f(l2 - M), w3 = __builtin_amdgcn_exp2f(l3 - M);
        const float inv = 1.0f / (l_run * w1 + w2 + w3);
        const float c1 = w1 * inv, c2 = w2 * inv, c3 = w3 * inv;
        const bf16* p2 = OP2 + qrow * 512 + head * 64 + 4 * hi; const bf16* p3 = OP3 + qrow * 512 + head * 64 + 4 * hi;
        bf16* op = ATT + qrow * D + acol + 4 * hi;
#pragma unroll
        for (int a = 0; a < 4; ++a) {
            const u32x2g a2 = *(const GAS u32x2g*)(p2 + 8 * a), b2 = *(const GAS u32x2g*)(p2 + 32 + 8 * a), a3 = *(const GAS u32x2g*)(p3 + 8 * a), b3 = *(const GAS u32x2g*)(p3 + 32 + 8 * a);
            float x0[4], x1[4];
            x0[0] = o0[4 * a] * c1 + bf_lo(a2.x) * c2 + bf_lo(a3.x) * c3; x0[1] = o0[4 * a + 1] * c1 + bf_hi(a2.x) * c2 + bf_hi(a3.x) * c3;
            x0[2] = o0[4 * a + 2] * c1 + bf_lo(a2.y) * c2 + bf_lo(a3.y) * c3; x0[3] = o0[4 * a + 3] * c1 + bf_hi(a2.y) * c2 + bf_hi(a3.y) * c3;
            x1[0] = o1[4 * a] * c1 + bf_lo(b2.x) * c2 + bf_lo(b3.x) * c3; x1[1] = o1[4 * a + 1] * c1 + bf_hi(b2.x) * c2 + bf_hi(b3.x) * c3;
            x1[2] = o1[4 * a + 2] * c1 + bf_lo(b2.y) * c2 + bf_lo(b3.y) * c3; x1[3] = o1[4 * a + 3] * c1 + bf_hi(b2.y) * c2 + bf_hi(b3.y) * c3;
            u32x2g w0, w1v; w0.x = cvtpk(x0[0], x0[1]); w0.y = cvtpk(x0[2], x0[3]); w1v.x = cvtpk(x1[0], x1[1]); w1v.y = cvtpk(x1[2], x1[3]);
            *(GAS u32x2g*)(op + 8 * a) = w0; *(GAS u32x2g*)(op + 32 + 8 * a) = w1v; }
    } else {
        const float inv = 1.0f / l_run;
        bf16* op = ATT + qrow * D + acol + 4 * hi;
#pragma unroll
        for (int a = 0; a < 4; ++a) {
            u32x2g w0, w1; w0.x = cvtpk(o0[4 * a] * inv, o0[4 * a + 1] * inv); w0.y = cvtpk(o0[4 * a + 2] * inv, o0[4 * a + 3] * inv);
            w1.x = cvtpk(o1[4 * a] * inv, o1[4 * a + 1] * inv); w1.y = cvtpk(o1[4 * a + 2] * inv, o1[4 * a + 3] * inv);
            *(GAS u32x2g*)(op + 8 * a) = w0; *(GAS u32x2g*)(op + 32 + 8 * a) = w1; }
    }
}

struct SPart { float m, l; f32x4 o; };
__device__ __forceinline__ void sample_scan(const float* kbase, const float* vbase, const float* knew, const float* vnew, int L, int rstride, int dil, const f32x4 q4, int lane, float& m_run, float& l_run, f32x4& o4) {
    const int sub = lane & 15, ks = lane >> 4;
#pragma unroll 4
    for (int st = 0; st < 33; ++st) {
        const int k = 4 * st + ks; const bool valid = k <= 128; const int idx = L - dil * (valid ? k : 128);
        const float* kp = (idx == L) ? knew : kbase + (size_t)idx * rstride; const float* vp = (idx == L) ? vnew : vbase + (size_t)idx * rstride;
        const f32x4 k4 = *((const GAS f32x4*)kp + sub), v4 = *((const GAS f32x4*)vp + sub);
        float s = (k4.x * q4.x + k4.y * q4.y) + (k4.z * q4.z + k4.w * q4.w);
        s += __shfl_xor(s, 1); s += __shfl_xor(s, 2); s += __shfl_xor(s, 4); s += __shfl_xor(s, 8);
        if (!valid) s = -INFINITY;
        const float m_new = fmaxf(m_run, s); const float alpha = __builtin_amdgcn_exp2f(m_run - m_new), p = __builtin_amdgcn_exp2f(s - m_new);
        l_run = l_run * alpha + p; o4 = o4 * alpha + v4 * p; m_run = m_new;
    }
}
__device__ __forceinline__ void sample_merge4(float& m_run, float& l_run, f32x4& o4) {
#pragma unroll
    for (int x = 16; x <= 32; x <<= 1) {
        const float mo = __shfl_xor(m_run, x), lo = __shfl_xor(l_run, x);
        f32x4 oo; oo.x = __shfl_xor(o4.x, x); oo.y = __shfl_xor(o4.y, x); oo.z = __shfl_xor(o4.z, x); oo.w = __shfl_xor(o4.w, x);
        const float M = fmaxf(m_run, mo), a = __builtin_amdgcn_exp2f(m_run - M), c = __builtin_amdgcn_exp2f(mo - M);
        l_run = l_run * a + lo * c; o4 = o4 * a + oo * c; m_run = M;
    }
}

__device__ __forceinline__ void attention_phase(Frame& F, const Args& A) {
    unsigned char* ws = A.ws;
    const bf16* QKV = (const bf16*)(ws + WS_QKV); bf16* ATT = (bf16*)(ws + WS_ATT);
    bf16* OP2 = (bf16*)(ws + WS_OP2); bf16* OP3 = (bf16*)(ws + WS_OP3); float* LS2 = (float*)(ws + WS_LS2); float* LS3 = (float*)(ws + WS_LS3);
    const int lane = F.lane, w = F.wave;
    LAS unsigned char* vt = F.lds + RING_OFF + w * 4096;
    LAS float* spart = (LAS float*)(F.lds + RING_OFF + 32768);
    const float* sinks = A.in[16];
    for (int u = F.vcu; u < 256; u += F.G) {
        const int b = u >> 7, h = (u >> 4) & 7, T0 = (u & 15) * 512;
#pragma unroll 1
        for (int k = 0; k < 2; ++k) attn_task<0>(QKV, b, 64 * h, 512 + 64 * h, 1024 + 64 * h, T0 + 2 * w + k, 16, vt, lane, OP3, LS3, h, 0.f, nullptr, nullptr, nullptr, nullptr, nullptr, 0);
#pragma unroll 1
        for (int k = 0; k < 2; ++k) { const int task = 2 * w + k; attn_task<0>(QKV, b, 64 * h, 512 + 64 * h, 1024 + 64 * h, T0 + 128 * (task >> 2) + (task & 3), 4, vt, lane, OP2, LS2, h, 0.f, nullptr, nullptr, nullptr, nullptr, nullptr, 0); }
#pragma unroll 1
        for (int k = 0; k < 2; ++k) attn_task<2>(QKV, b, 1536 + 64 * h, 2048 + 64 * (h >> 2), 2176 + 64 * (h >> 2), T0 + 32 * (2 * w + k), 1, vt, lane, nullptr, nullptr, h, sinks[h] * 1.4426950408889634f, nullptr, nullptr, nullptr, nullptr, ATT, 512 + 64 * h);
        if (u < 256) {
#pragma unroll 1
            for (int k = 0; k < 2; ++k) { const int task = w + 8 * k;
                const int sub = lane & 15;
                if (task < 12) {
                    const int pair = 4 * u + task / 3, pat = task % 3, sb = pair >> 3, sh = pair & 7, dil = pat == 0 ? 1 : (pat == 1 ? 4 : 16);
                    const bf16* qp = QKV + (size_t)(MP + sb) * NIN + 64 * sh + 4 * sub; const unsigned long long qw = *(const GAS unsigned long long*)qp;
                    const f32x4 q4 = (f32x4){bf_lo((unsigned)qw), bf_hi((unsigned)qw), bf_lo((unsigned)(qw >> 32)), bf_hi((unsigned)(qw >> 32))};
                    float m_run = -INFINITY, l_run = 0.f; f32x4 o4 = {0.f, 0.f, 0.f, 0.f};
                    sample_scan(A.in[2] + ((size_t)sb * LA * 8 + sh) * 64, A.in[3] + ((size_t)sb * LA * 8 + sh) * 64,
                                A.out + O_AKS + ((size_t)(sb * LA + LA - 1) * 8 + sh) * 64, A.out + O_AVS + ((size_t)(sb * LA + LA - 1) * 8 + sh) * 64, LA, 512, dil, q4, lane, m_run, l_run, o4);
                    sample_merge4(m_run, l_run, o4);
                    if (lane < 16) { LAS float* sp = spart + (task * 16 + sub) * 6; sp[0] = m_run; sp[1] = l_run; sp[2] = o4.x; sp[3] = o4.y; sp[4] = o4.z; sp[5] = o4.w; }
                } else {
                    const int pair = 4 * u + (task - 12), sb = pair >> 3, sh = pair & 7, kv = sh >> 2;
                    const bf16* qp = QKV + (size_t)(MP + sb) * NIN + 1536 + 64 * sh + 4 * sub; const unsigned long long qw = *(const GAS unsigned long long*)qp;
                    const f32x4 q4 = (f32x4){bf_lo((unsigned)qw), bf_hi((unsigned)qw), bf_lo((unsigned)(qw >> 32)), bf_hi((unsigned)(qw >> 32))};
                    float m_run = (lane < 16) ? sinks[sh] * 1.4426950408889634f : -INFINITY, l_run = (lane < 16) ? 1.0f : 0.f; f32x4 o4 = {0.f, 0.f, 0.f, 0.f};
                    sample_scan(A.in[4] + ((size_t)sb * LB * 2 + kv) * 64, A.in[5] + ((size_t)sb * LB * 2 + kv) * 64,
                                A.out + O_BKS + ((size_t)(sb * LB + LB - 1) * 2 + kv) * 64, A.out + O_BVS + ((size_t)(sb * LB + LB - 1) * 2 + kv) * 64, LB, 128, 1, q4, lane, m_run, l_run, o4);
                    sample_merge4(m_run, l_run, o4);
                    if (lane < 16) { const float inv = 1.0f / l_run; bf16* op = ATT + (size_t)(MP + sb) * D + 512 + 64 * sh + 4 * sub;
                        *(GAS unsigned long long*)op = (unsigned long long)cvtpk(o4.x * inv, o4.y * inv) | ((unsigned long long)cvtpk(o4.z * inv, o4.w * inv) << 32); }
                }
            }
        }
        __builtin_amdgcn_fence(__ATOMIC_RELEASE, "workgroup"); __syncthreads(); __builtin_amdgcn_fence(__ATOMIC_ACQUIRE, "workgroup");
#pragma unroll 1
        for (int k = 0; k < 2; ++k) attn_task<1>(QKV, b, 64 * h, 512 + 64 * h, 1024 + 64 * h, T0 + 32 * (2 * w + k), 1, vt, lane, nullptr, nullptr, h, 0.f, OP2, OP3, LS2, LS3, ATT, 64 * h);
        if (w < 4 && lane < 16) {
            const int pair = 4 * u + w, sb = pair >> 3, sh = pair & 7, sub = lane;
            float m_run = -INFINITY, l_run = 0.f; f32x4 o4 = {0.f, 0.f, 0.f, 0.f};
#pragma unroll
            for (int p = 0; p < 3; ++p) { const LAS float* sp = spart + ((3 * w + p) * 16 + sub) * 6; const float mo = sp[0], lo = sp[1]; const f32x4 oo = (f32x4){sp[2], sp[3], sp[4], sp[5]};
                const float M = fmaxf(m_run, mo), a = __builtin_amdgcn_exp2f(m_run - M), c = __builtin_amdgcn_exp2f(mo - M);
                l_run = l_run * a + lo * c; o4 = o4 * a + oo * c; m_run = M; }
            const float inv = 1.0f / l_run; bf16* op = ATT + (size_t)(MP + sb) * D + 64 * sh + 4 * sub;
            *(GAS unsigned long long*)op = (unsigned long long)cvtpk(o4.x * inv, o4.y * inv) | ((unsigned long long)cvtpk(o4.z * inv, o4.w * inv) << 32);
        }
        __syncthreads();
    }
}

__global__ void __launch_bounds__(NWAVES * 64, 2) fwd_kernel(Args args) {
    extern __shared__ __attribute__((aligned(16))) unsigned char lds[];
    Frame F;
    F.lds = (LAS unsigned char*)lds;
    F.MISC = (volatile LAS unsigned*)(F.lds + MISC_OFF);
    F.tid = threadIdx.x; F.lane = F.tid & 63; F.wave = __builtin_amdgcn_readfirstlane(F.tid >> 6);
    F.G = gridDim.x; { const int bx = blockIdx.x; F.vcu = (F.G % 8 == 0) ? (bx % 8) * (F.G / 8) + bx / 8 : bx; }
    F.ctl = (gu32*)(args.ws + WS_CTL);
    for (int u = F.tid; u < (LDS_BYTES - LDSCTL_OFF) / 4; u += NWAVES * 64) ((LAS unsigned*)(F.lds + LDSCTL_OFF))[u] = 0u;
    __syncthreads();
    XcdBarrier bar = xcd_barrier_post((unsigned*)(F.ctl + CW_BAR), F.MISC + 8);
#define GRID_BAR() xcd_barrier(bar)

#define XB ((bf16*)(args.ws + WS_XB))
#define RS ((float*)(args.ws + WS_RS))
#define ACT ((bf16*)(args.ws + WS_ACT))
#define Y ((bf16*)(args.ws + WS_Y))
#define QKV ((bf16*)(args.ws + WS_QKV))
#define ATT ((bf16*)(args.ws + WS_ATT))
#define PB ((bf16*)(args.ws + WS_PB))
#define PP ((bf16*)(args.ws + WS_PP))

#define GEMM_PHASE(EPI, NG_, A_, B_, N_, K_, NSPLIT_, ...) do { pg8::Gemm g{A_, (const bf16*)(args.ws + B_), MT, N_, K_}; pg8::SampleOrder S; S.init(MP, N_, K_, NSPLIT_, NG_, (int)blockIdx.x); \
      pg8::EPI E{__VA_ARGS__}; pg8::NoCopy C; \
      pg8::gemm_phase<pg8::EPI, pg8::SampleOrder, pg8::NoCopy, PG8_ALIGN, PG8_SP2>(F.lds + RING_OFF, g, S, E, C); } while (0)
#ifdef NO_SIDE_COPY
    const int NG1 = F.G, NG3 = F.G;
#else
    const int NG1 = (F.G == 256) ? 240 : F.G, NG3 = (F.G == 256) ? 200 : F.G;
#endif
#define SIGNAL_DONE(k) do { if (F.tid == 0) __hip_atomic_fetch_add(F.ctl + CW_DONE + 64 * (k), 1u, RLX_AGENT); } while (0)

#ifndef SKIP_P0
    p0_prologue(F, args);
#endif
#ifdef PROBE_P0X2
    GRID_BAR();
    p0_prologue(F, args);
#endif
    GRID_BAR();
#ifndef SKIP_P1
    if ((int)blockIdx.x < NG1) { GEMM_PHASE(EpiSwiGLU, NG1, XB, WS_WGU1, 2 * FF, D, 1, ACT, FF, RS); SIGNAL_DONE(0); }
    else side_copy(args, F.ctl, F.lane, CW_DONE + 64 * 0, (unsigned)NG1 / 2);
#endif
    GRID_BAR();
#ifdef PROBE_P1X2
    GEMM_PHASE(EpiSwiGLU, F.G, XB, WS_WGU1, 2 * FF, D, 1, ACT, FF, RS);
    GRID_BAR();
#endif
#ifdef PROBE_P2X2
    GEMM_PHASE(EpiPlain, F.G, ACT, WS_WD1, D, FF, 11, Y, D, (float*)(args.ws + WS_SLAB));
    GRID_BAR();
#endif
#ifndef SKIP_P2
    GEMM_PHASE(EpiPlain, F.G, ACT, WS_WD1, D, FF, 11, Y, D, (float*)(args.ws + WS_SLAB));
#endif
    GRID_BAR();
#ifndef SKIP_NORM
    norm_phase<0, 11>(F, args, args.in[9], 0.5f);
#endif
    GRID_BAR();
#ifndef SKIP_P3
    if ((int)blockIdx.x < NG3) {
        GEMM_PHASE(EpiRope, NG3, XB, WS_WIN, NIN, D, 1, QKV, RS, (const float*)(args.ws + WS_ROPE), args.out);
        GEMM_PHASE(EpiPlain, NG3, PB, WS_WPP, D, DPLE, 1, PP, D, nullptr);
        SIGNAL_DONE(1);
    } else side_copy(args, F.ctl, F.lane, CW_DONE + 64 * 1, (unsigned)NG3 / 2);
#endif
    GRID_BAR();
#ifndef SKIP_P4
    attention_phase(F, args);
#endif
    GRID_BAR();
#ifndef SKIP_P5
    GEMM_PHASE(EpiPlain, F.G, ATT, WS_WOUT, D, D, 4, Y, D, (float*)(args.ws + WS_SLAB));
#endif
    GRID_BAR();
#ifndef SKIP_NORM
    norm_phase<1, 4>(F, args, args.in[14], 1.0f);
#endif
    GRID_BAR();
#ifndef SKIP_P6
    if ((int)blockIdx.x < NG1) { GEMM_PHASE(EpiSwiGLU, NG1, XB, WS_WGU2, 2 * FF, D, 1, ACT, FF, RS); SIGNAL_DONE(2); }
    else side_copy(args, F.ctl, F.lane, CW_DONE + 64 * 2, (unsigned)NG1 / 2);
#endif
    GRID_BAR();
#ifndef SKIP_P7
    GEMM_PHASE(EpiPlain, F.G, ACT, WS_WD2, D, FF, 11, Y, D, (float*)(args.ws + WS_SLAB));
#endif
    GRID_BAR();
#ifndef SKIP_NORM
    norm_phase<1, 11>(F, args, args.in[19], 0.5f);
#endif
    GRID_BAR();
#ifndef SKIP_P8
    GEMM_PHASE(EpiPle, F.G, XB, WS_WPG, D, D, 4, Y, D, RS, PP, (float*)(args.ws + WS_SLAB));
#endif
    side_copy(args, F.ctl, F.lane, -1, 0u);
#ifdef PROBE_COPYX2
    GRID_BAR();
    side_copy2(args, F.ctl, F.lane);
#endif
    GRID_BAR();
#ifndef SKIP_NORM
    norm_phase<2, 4>(F, args, args.in[24], 1.0f);
#endif
#ifdef PROBE_NORMFX2
    GRID_BAR();
    norm_phase<2, 4>(F, args, args.in[24], 1.0f);
#endif
#undef GEMM_PHASE
#undef SIGNAL_DONE
#undef GRID_BAR
#undef XB
#undef RS
#undef ACT
#undef Y
#undef QKV
#undef ATT
#undef PB
#undef PP
}

extern "C" void kernel_launch(void* const* d_in, const int* in_sizes, int n_in, void* d_out, int out_size, void* d_ws, size_t ws_size, hipStream_t stream) {
    static int grid = 0;
    if (grid == 0) {
        if (n_in != 27 || (size_t)out_size != O_END || ws_size < WS_END) { fprintf(stderr, "kernel_launch: unexpected shapes (n_in %d, out %d, ws %zu); nothing launched\n", n_in, out_size, ws_size); grid = -1; return; }
        int dev = 0, cus = 0, per_cu = 0;
        if (hipGetDevice(&dev) != hipSuccess || hipDeviceGetAttribute(&cus, hipDeviceAttributeMultiprocessorCount, dev) != hipSuccess) { grid = -1; return; }
        if (hipFuncSetAttribute((const void*)fwd_kernel, hipFuncAttributeMaxDynamicSharedMemorySize, LDS_BYTES) != hipSuccess) { fprintf(stderr, "kernel_launch: hipFuncSetAttribute failed\n"); grid = -1; return; }
        if (hipOccupancyMaxActiveBlocksPerMultiprocessor(&per_cu, (const void*)fwd_kernel, NWAVES * 64, LDS_BYTES) != hipSuccess || per_cu < 1) { fprintf(stderr, "kernel_launch: occupancy query says %d blocks per CU\n", per_cu); per_cu = 1; }
        (void)hipGetLastError();
        grid = cus;
    }
    if (grid < 0) return;
    if (hipMemsetAsync((char*)d_ws + WS_CTL, 0, CTL_ZERO_BYTES, stream) != hipSuccess) return;
    Args a{};
    for (int i = 0; i < 27; ++i) a.in[i] = (const float*)d_in[i];
    a.out = (float*)d_out; a.ws = (unsigned char*)d_ws;
    hipLaunchKernelGGL(fwd_kernel, dim3(grid), dim3(NWAVES * 64), LDS_BYTES, stream, a);
}
```

```cpp
#include <hip/hip_runtime.h>
#include <cstdio>
#include <cstdint>
#include <cmath>

#ifndef PG8_SP2
#define PG8_SP2 true
#endif
#ifndef PG8_ALIGN
#define PG8_ALIGN true
#endif
constexpr int NWAVES = 8;
constexpr int D = 1024, FF = 2816, NIN = 2304, DPLE = 256, SEQ = 8192, NB = 2;
constexpr int MP = NB * SEQ;
constexpr int MS = 128;
constexpr int MR = MP + MS;
constexpr int MT = 65 * 256;
constexpr int LA = 2048, LB = 128, PAST = 16384;
constexpr float EPS = 1e-6f;
constexpr float QSCALE = 0.125f * 1.4426950408889634f;

constexpr size_t O_YP = 0, O_YS = O_YP + (size_t)MP * D, O_AKP = O_YS + (size_t)MS * D, O_AVP = O_AKP + (size_t)NB * 2048 * 512,
    O_BKP = O_AVP + (size_t)NB * 2048 * 512, O_BVP = O_BKP + (size_t)NB * 128 * 128, O_AKS = O_BVP + (size_t)NB * 128 * 128,
    O_AVS = O_AKS + (size_t)MS * LA * 512, O_BKS = O_AVS + (size_t)MS * LA * 512, O_BVS = O_BKS + (size_t)MS * LB * 128, O_END = O_BVS + (size_t)MS * LB * 128;
static_assert(O_END == 293797888ull, "output size");

namespace pg8 {
#define PG8_LAS __attribute__((address_space(3)))
typedef unsigned short bf16_t;
typedef short bf16x8 __attribute__((ext_vector_type(8)));
typedef float f32x4 __attribute__((ext_vector_type(4)));
typedef unsigned u32x4 __attribute__((ext_vector_type(4)));
constexpr int BM = 256, BK = 64, HALF = 128, HTB = HALF * BK * 2  , STAGE_BYTES = 8 * HTB, NXCD = 8, WGM = 8;

__host__ __device__ __forceinline__ int lds_byte(int r, int c) { const int st = (r >> 4) * 2 + (c >> 5), rr = r & 15, cc = c & 31, ob = rr * 64 + cc * 2; return st * 1024 + (ob ^ (((ob >> 9) & 1) << 5)); }
__host__ __device__ __forceinline__ void stage_rc(int b, int& R, int& C) { const int st = b / 1024, sb = b % 1024, swz = sb ^ (((sb >> 9) & 1) << 5); R = (st >> 1) * 16 + swz / 64; C = (st & 1) * 32 + (swz % 64) / 2; }
__host__ __device__ __forceinline__ int perm32(int rho) { const int n = rho >> 4, i = rho & 15; return 8 * (i >> 2) + 4 * n + (i & 3); }

struct Unit { int pm, pn, kt0, nkt; };
struct Gemm { const bf16_t* A; const bf16_t* Bt; int M, N, K; };

struct StaticOrder {
    int nM, nN, nwg, G, c;
    __host__ __device__ void init(int M, int N, int G_, int c_) { nM = M / BM; nN = N / BM; nwg = nM * nN; G = G_; c = c_; }
    __host__ __device__ bool next(int i, Unit& u) const {
        const long L = (long)i * G + c; if (L >= nwg) return false;
        int wgid = (int)L; { const int q = nwg / NXCD, r = nwg % NXCD, xcd = wgid % NXCD, off = wgid / NXCD; wgid = (xcd < r ? xcd * (q + 1) : r * (q + 1) + (xcd - r) * q) + off; }
        const int nig = WGM * nN, gid = wgid / nig, fm = gid * WGM, gsz = (nM - fm) < WGM ? (nM - fm) : WGM;
        u.pm = fm + ((wgid % nig) % gsz); u.pn = (wgid % nig) / gsz; return true;
    }
    __device__ __forceinline__ void a_ready(const Unit&) const {}
    __device__ __forceinline__ void done(const Unit&) const {}
};

struct SampleOrder {
    StaticOrder P; int nkt_full, nsplit, ns;
    __host__ __device__ void init(int Mp, int N, int K, int nsplit_, int G_, int c_) { P.init(Mp, N, G_, c_); nkt_full = K / BK; nsplit = nsplit_; ns = (N / BM) * nsplit_; }
    __host__ __device__ bool next(int i, Unit& u) const {
        Unit t; t.pm = 0; t.pn = 0; t.kt0 = 0; t.nkt = 0; int pm, pn, kt0 = 0, nkt = nkt_full;
        if (P.next(i, t)) { pm = t.pm; pn = t.pn; }
        else { const long L = (long)i * P.G + P.c - P.nwg; if (L < 0 || L >= ns) return false;
            const int s = (int)L, ks = s / P.nN; pm = P.nM; pn = s - ks * P.nN; nkt = nkt_full / nsplit; kt0 = ks * nkt; }
        u.pm = pm; u.pn = pn; u.kt0 = kt0; u.nkt = nkt; return true;
    }
    __device__ __forceinline__ void a_ready(const Unit&) const {}
    __device__ __forceinline__ void done(const Unit&) const {}
};
struct NoCopy { static constexpr bool ACTIVE = false; __device__ __forceinline__ void prime() {} template <int KT> __device__ __forceinline__ void step() {} __device__ __forceinline__ void flush() {} };
struct StreamCopy {
    static constexpr bool ACTIVE = true;
    const unsigned char* src; unsigned char* dst; int cur, last; unsigned lane_off; f32x4 buf0, buf1; unsigned off0, off1;
    __device__ __forceinline__ unsigned chunk_off() { const int c = cur < last ? cur : last; cur += 8; return (unsigned)c * 1024u + lane_off; }
    static __device__ __forceinline__ void ld(f32x4& v, unsigned off, const unsigned char* base) { asm volatile("global_load_dwordx4 %0, %1, %2 nt" : "=v"(v) : "v"(off), "s"(base) : "memory"); }
    static __device__ __forceinline__ void st_w(const f32x4& v, unsigned off, unsigned char* base) { asm volatile("s_waitcnt vmcnt(18)\n\tglobal_store_dwordx4 %0, %1, %2 nt" : : "v"(off), "v"(v), "s"(base) : "memory"); }
    static __device__ __forceinline__ void st(const f32x4& v, unsigned off, unsigned char* base) { asm volatile("global_store_dwordx4 %0, %1, %2 nt" : : "v"(off), "v"(v), "s"(base) : "memory"); }
    __device__ __forceinline__ void prime() { off0 = chunk_off(); ld(buf0, off0, src); off1 = chunk_off(); ld(buf1, off1, src); }
    template <int KT> __device__ __forceinline__ void step() {
        if (KT == 0) { st_w(buf0, off0, dst); off0 = chunk_off(); ld(buf0, off0, src); }
        else         { st_w(buf1, off1, dst); off1 = chunk_off(); ld(buf1, off1, src); }
    }
    __device__ __forceinline__ void flush() { st(buf0, off0, dst); st(buf1, off1, dst); }
};

__device__ __forceinline__ unsigned cvt_pk_bf16(float lo, float hi) { unsigned r; asm volatile("v_cvt_pk_bf16_f32 %0, %1, %2" : "=v"(r) : "v"(lo), "v"(hi)); return r; }
typedef float f32x2 __attribute__((ext_vector_type(2)));

typedef unsigned u32x2 __attribute__((ext_vector_type(2)));
__device__ __forceinline__ float fast_sigmoid(float x) { return __builtin_amdgcn_rcpf(1.0f + __builtin_amdgcn_exp2f(-1.4426950408889634f * x)); }

__device__ __forceinline__ void store_slab(float* slab, const f32x4 (&acc)[2][2][4][2], const Unit& u, int wr, int wc, int fr, int fq) {
    const int ks = u.kt0 / u.nkt; float* base = slab + ((size_t)ks * 128 + wr * 64 + fr) * 1024 + u.pn * BM + wc * 32 + 8 * fq;
#pragma unroll
    for (int m = 0; m < 4; ++m)
#pragma unroll
        for (int bj = 0; bj < 2; ++bj) { float* p = base + (size_t)m * 16 * 1024 + bj * HALF; *(f32x4*)p = acc[0][bj][m][0]; *(f32x4*)(p + 4) = acc[0][bj][m][1]; }
}
struct EpiPlain {
    static constexpr bool PERM = true, AFTER_DRAIN = false;
    bf16_t* O; int ldc; float* slab;
    __device__ __forceinline__ void operator()(const f32x4 (&acc)[2][2][4][2], const Unit& u, int wr, int wc, int fr, int fq) const {
        if (slab != nullptr && u.pm == MP / BM) { store_slab(slab, acc, u, wr, wc, fr, fq); return; }
        const int row0 = u.pm * BM + wr * 64 + fr, col0 = u.pn * BM + wc * 32 + 8 * fq;
#pragma unroll
        for (int ai = 0; ai < 2; ++ai)
#pragma unroll
            for (int m = 0; m < 4; ++m) { bf16_t* rowp = O + (size_t)(row0 + ai * HALF + m * 16) * ldc + col0;
#pragma unroll
                for (int bj = 0; bj < 2; ++bj) { const f32x4 v0 = acc[ai][bj][m][0], v1 = acc[ai][bj][m][1];
                    u32x4 w; w.x = cvt_pk_bf16(v0[0], v0[1]); w.y = cvt_pk_bf16(v0[2], v0[3]); w.z = cvt_pk_bf16(v1[0], v1[1]); w.w = cvt_pk_bf16(v1[2], v1[3]);
                    *(u32x4*)(rowp + bj * HALF) = w; } }
    }
};

struct EpiSwiGLU {
    static constexpr bool PERM = true, AFTER_DRAIN = false;
    bf16_t* O; int ldc; const float* rs;
    __device__ __forceinline__ void operator()(const f32x4 (&acc)[2][2][4][2], const Unit& u, int wr, int wc, int fr, int fq) const {
        const int row0 = u.pm * BM + wr * 64 + fr, col0 = u.pn * HALF + wc * 32 + 8 * fq;
        float rv[2][4];
#pragma unroll
        for (int ai = 0; ai < 2; ++ai)
#pragma unroll
            for (int m = 0; m < 4; ++m) rv[ai][m] = rs[row0 + ai * HALF + m * 16];
#pragma unroll
        for (int ai = 0; ai < 2; ++ai)
#pragma unroll
            for (int m = 0; m < 4; ++m) { const int row = row0 + ai * HALF + m * 16; const float r = rv[ai][m];
                unsigned w[4];
#pragma unroll
                for (int bj = 0; bj < 2; ++bj) { const f32x4 g = acc[ai][bj][m][0] * r, up = acc[ai][bj][m][1] * r; float o[4];
#pragma unroll
                    for (int i = 0; i < 4; ++i) o[i] = g[i] * fast_sigmoid(g[i]) * up[i];
                    w[2 * bj] = cvt_pk_bf16(o[0], o[1]); w[2 * bj + 1] = cvt_pk_bf16(o[2], o[3]); }
                u32x4 wv; wv.x = w[0]; wv.y = w[1]; wv.z = w[2]; wv.w = w[3];
                *(u32x4*)(O + (size_t)row * ldc + col0) = wv; }
    }
};

struct EpiRope {
    static constexpr bool PERM = true, AFTER_DRAIN = false;
    bf16_t* O; const float* rs; const float* rope;
    float* out;
    __device__ __forceinline__ void operator()(const f32x4 (&acc)[2][2][4][2], const Unit& u, int wr, int wc, int fr, int fq) const {
        const int pn = u.pn; const int row0 = u.pm * BM + wr * 64 + fr;
        const int d0 = 16 * (wc & 1) + 4 * fq;
        const bool is_s = u.pm >= MP / BM;
#pragma unroll
        for (int ai = 0; ai < 2; ++ai) {
            float rv[4]; f32x4 csa[4], csb[4];
#pragma unroll
            for (int m = 0; m < 4; ++m) { const int row = row0 + ai * HALF + m * 16; rv[m] = rs[row];
                const float* rp = rope + (unsigned)((is_s ? SEQ : (row & (SEQ - 1))) * 64 + 2 * d0); csa[m] = *(const f32x4*)rp; csb[m] = *(const f32x4*)(rp + 4); }
#pragma unroll
            for (int m = 0; m < 4; ++m) { const int row = row0 + ai * HALF + m * 16; const float r = rv[m];
                const int t = is_s ? 0 : (row & (SEQ - 1)); const int b = is_s ? (row - MP) : (row / SEQ);
                const f32x4 cs0 = csa[m], cs1 = csb[m];
#pragma unroll
                for (int bj = 0; bj < 2; ++bj) {
                    const int hl = 2 * bj + (wc >> 1);
                    const bool rot = (pn < 4) || (pn == 6) || (pn == 7) || (pn == 8 && bj == 0);
                    const bool isq = (pn < 2) || (pn == 6) || (pn == 7);
                    f32x4 x1 = acc[ai][bj][m][0] * r, x2 = acc[ai][bj][m][1] * r;
                    if (rot) {
                        const f32x4 c = (f32x4){cs0[0], cs0[2], cs1[0], cs1[2]}, s = (f32x4){cs0[1], cs0[3], cs1[1], cs1[3]};
                        const f32x4 a = x1, bb = x2; x1 = a * c - bb * s; x2 = bb * c + a * s; }
                    long doff = -1;
                    if (pn >= 2 && pn <= 5) {
                        const int head = 4 * (pn & 1) + hl; const size_t base = (pn < 4) ? (is_s ? O_AKS : O_AKP) : (is_s ? O_AVS : O_AVP);
                        if (is_s) { if (row < MP + MS) doff = (long)(base + ((size_t)(b * 2048 + 2047) * 8 + head) * 64); }
                        else if (t >= SEQ - 2048) doff = (long)(base + ((size_t)(b * 2048 + (t - (SEQ - 2048))) * 8 + head) * 64);
                    } else if (pn == 8) {
                        const int kvh = wc >> 1; const size_t base = (bj == 0) ? (is_s ? O_BKS : O_BKP) : (is_s ? O_BVS : O_BVP);
                        if (is_s) { if (row < MP + MS) doff = (long)(base + ((size_t)(b * 128 + 127) * 2 + kvh) * 64); }
                        else if (t >= SEQ - 128) doff = (long)(base + ((size_t)(b * 128 + (t - (SEQ - 128))) * 2 + kvh) * 64);
                    }
                    if (doff >= 0) { float* dst = out + doff; *(f32x4*)(dst + d0) = x1; *(f32x4*)(dst + d0 + 32) = x2; }
                    if (isq) { x1 = x1 * QSCALE; x2 = x2 * QSCALE; }
                    bf16_t* op = O + (size_t)row * 2304 + pn * BM + 64 * hl + d0;
                    u32x2 w1, w2; w1.x = cvt_pk_bf16(x1[0], x1[1]); w1.y = cvt_pk_bf16(x1[2], x1[3]); w2.x = cvt_pk_bf16(x2[0], x2[1]); w2.y = cvt_pk_bf16(x2[2], x2[3]);
                    *(u32x2*)op = w1; *(u32x2*)(op + 32) = w2; } } }
    }
};

struct EpiPle {
    static constexpr bool PERM = true, AFTER_DRAIN = false;
    bf16_t* O; int ldc; const float* rs; const bf16_t* PP; float* slab;
    __device__ __forceinline__ void operator()(const f32x4 (&acc)[2][2][4][2], const Unit& u, int wr, int wc, int fr, int fq) const {
        if (u.pm == MP / BM) { store_slab(slab, acc, u, wr, wc, fr, fq); return; }
        const int row0 = u.pm * BM + wr * 64 + fr, col0 = u.pn * BM + wc * 32 + 8 * fq;
#pragma unroll
        for (int ai = 0; ai < 2; ++ai) {
            float rv[4]; u32x4 ppv[4][2];
#pragma unroll
            for (int m = 0; m < 4; ++m) { const int row = row0 + ai * HALF + m * 16; rv[m] = rs[row];
#pragma unroll
                for (int bj = 0; bj < 2; ++bj) ppv[m][bj] = *(const u32x4*)(PP + (size_t)row * ldc + col0 + bj * HALF); }
#pragma unroll
            for (int m = 0; m < 4; ++m) { const int row = row0 + ai * HALF + m * 16; const float r = rv[m]; const size_t off = (size_t)row * ldc + col0;
#pragma unroll
                for (int bj = 0; bj < 2; ++bj) { const u32x4 pp = ppv[m][bj];
                    const f32x4 v0 = acc[ai][bj][m][0] * r, v1 = acc[ai][bj][m][1] * r; float o[8];
#pragma unroll
                    for (int i = 0; i < 4; ++i) { const unsigned pw0 = pp[i >> 1], pw1 = pp[2 + (i >> 1)];
                        const float p0 = __uint_as_float((i & 1) ? (pw0 & 0xffff0000u) : (pw0 << 16)), p1 = __uint_as_float((i & 1) ? (pw1 & 0xffff0000u) : (pw1 << 16));
                        o[i] = fast_sigmoid(v0[i]) * p0; o[4 + i] = fast_sigmoid(v1[i]) * p1; }
                    u32x4 w; w.x = cvt_pk_bf16(o[0], o[1]); w.y = cvt_pk_bf16(o[2], o[3]); w.z = cvt_pk_bf16(o[4], o[5]); w.w = cvt_pk_bf16(o[6], o[7]);
                    *(u32x4*)(O + off + bj * HALF) = w; } } }
    }
};

template <class Epi, class Sched, class Copy, bool ALIGN_EPI = false, bool SP2 = false>
__device__ __forceinline__ void gemm_phase(PG8_LAS unsigned char* lds, const Gemm g, const Sched& S, const Epi& E, Copy& C) {
    int tid_ = threadIdx.x; asm volatile("" : "+v"(tid_));
    const int tid = tid_, wid = __builtin_amdgcn_readfirstlane(tid >> 6), lane = tid & 63, wr = wid >> 2, wc = wid & 3, fr = lane & 15, fq = lane >> 4;
    const int K = g.K;
    unsigned voffA[2], voffB[2];
#pragma unroll
    for (int i = 0; i < 2; ++i) { int R, C; stage_rc(tid * 16 + i * 8192, R, C); const int Rb = Epi::PERM ? ((R & ~31) + perm32(R & 31)) : R;
        voffA[i] = (unsigned)(R * K + C) * 2u; voffB[i] = (unsigned)(Rb * K + C) * 2u; }
    const size_t kstep = (size_t)(BK * 2);
    const size_t hstep = (size_t)HALF * K * 2;
    const size_t tstep = 2 * hstep;
    const unsigned ldsw = (unsigned)wid * 1024u;
    const int aoff = lds_byte(wr * 64 + fr, fq * 8), boff = lds_byte(wc * 32 + fr, fq * 8);
#define PG8_SA(b, h) (((b) * 2 + (h)) * HTB)
#define PG8_SB(b, h) ((4 + (b) * 2 + (h)) * HTB)
#define PG8_STAGE(bufoff, gbase, voff) do { _Pragma("unroll") for (int _i = 0; _i < 2; ++_i) \
        __builtin_amdgcn_global_load_lds((const unsigned*)((const char*)(gbase) + (voff)[_i]), (PG8_LAS unsigned*)(lds + (bufoff) + ldsw + _i * 8192), 16, 0, 0); } while (0)
#define PG8_LDA(dst, b, h) do { _Pragma("unroll") for (int m = 0; m < 4; ++m) _Pragma("unroll") for (int k = 0; k < 2; ++k) dst[m][k] = *(const PG8_LAS bf16x8*)(lds + PG8_SA(b, h) + aoff + m * 2048 + k * 1024); } while (0)
#define PG8_LDB(dst, b, h) do { _Pragma("unroll") for (int n = 0; n < 2; ++n) _Pragma("unroll") for (int k = 0; k < 2; ++k) dst[n][k] = *(const PG8_LAS bf16x8*)(lds + PG8_SB(b, h) + boff + n * 2048 + k * 1024); } while (0)
#define PG8_MMA(ai, bj, At, Bt) do { __builtin_amdgcn_s_setprio(1); _Pragma("unroll") for (int m = 0; m < 4; ++m) _Pragma("unroll") for (int n = 0; n < 2; ++n) _Pragma("unroll") for (int k = 0; k < 2; ++k) \
        acc[ai][bj][m][n] = __builtin_amdgcn_mfma_f32_16x16x32_bf16(Bt[n][k], At[m][k], acc[ai][bj][m][n], 0, 0, 0); __builtin_amdgcn_s_setprio(0); } while (0)
#define PG8_WAIT_V(n) asm volatile("s_waitcnt vmcnt(" #n ")" ::: "memory")
#define PG8_WAIT_L(n) asm volatile("s_waitcnt lgkmcnt(" #n ")" ::: "memory")
#define PG8_WAIT_VA do { if constexpr (Copy::ACTIVE) { PG8_WAIT_V(12); } else { PG8_WAIT_V(8); } } while (0)
#define PG8_WAIT_VB do { if constexpr (Copy::ACTIVE) { PG8_WAIT_V(10); } else { PG8_WAIT_V(8); } } while (0)
#define PG8_BAR __builtin_amdgcn_s_barrier()
#define PG8_SCHED __builtin_amdgcn_sched_barrier(0)
    Unit cur, nxt; int ui = 0;
    if (!S.next(0, cur)) return;
    f32x4 acc[2][2][4][2];
#pragma unroll
    for (int a = 0; a < 2; ++a)
#pragma unroll
        for (int b = 0; b < 2; ++b)
#pragma unroll
            for (int m = 0; m < 4; ++m)
#pragma unroll
                for (int n = 0; n < 2; ++n) acc[a][b][m][n] = (f32x4){0.f, 0.f, 0.f, 0.f};
    bf16x8 At[4][2], B0[2][2], B1[2][2];
    const char* cA = (const char*)g.A + (size_t)cur.pm * tstep + (size_t)cur.kt0 * kstep; const char* cB = (const char*)g.Bt + (size_t)cur.pn * tstep + (size_t)cur.kt0 * kstep;
    S.a_ready(cur);
    C.prime();
    if constexpr (SP2) {
        PG8_STAGE(PG8_SB(0, 0), cB, voffB); PG8_STAGE(PG8_SB(0, 1), cB + hstep, voffB); PG8_STAGE(PG8_SA(0, 0), cA, voffA); PG8_STAGE(PG8_SA(0, 1), cA + hstep, voffA);
        if (wr == 1) PG8_BAR;
        PG8_WAIT_V(2); PG8_BAR;
        PG8_STAGE(PG8_SB(1, 0), cB + kstep, voffB); PG8_STAGE(PG8_SA(1, 0), cA + kstep, voffA); PG8_STAGE(PG8_SB(1, 1), cB + hstep + kstep, voffB);
        PG8_WAIT_V(6); PG8_BAR;
    } else {
        PG8_STAGE(PG8_SB(0, 0), cB, voffB); PG8_STAGE(PG8_SA(0, 0), cA, voffA); PG8_STAGE(PG8_SB(0, 1), cB + hstep, voffB); PG8_STAGE(PG8_SA(0, 1), cA + hstep, voffA);
        if (wr == 1) PG8_BAR;
        PG8_WAIT_V(4); PG8_BAR;
        PG8_STAGE(PG8_SB(1, 0), cB + kstep, voffB); PG8_STAGE(PG8_SA(1, 0), cA + kstep, voffA); PG8_STAGE(PG8_SB(1, 1), cB + hstep + kstep, voffB);
        PG8_WAIT_V(6); PG8_BAR;
    }
    for (;;) {
        const bool has_next = S.next(ui + 1, nxt);
        const char* nA = has_next ? (const char*)g.A + (size_t)nxt.pm * tstep + (size_t)nxt.kt0 * kstep : cA; const char* nB = has_next ? (const char*)g.Bt + (size_t)nxt.pn * tstep + (size_t)nxt.kt0 * kstep : cB;
        const int nt = cur.nkt;
#pragma nounroll
        for (int t = 0; t < nt; t += 2) {
            const bool last = (t == nt - 2);
            const char* a1 = cA + (size_t)(t + 1) * kstep;
            const char* a2 = last ? nA : cA + (size_t)(t + 2) * kstep; const char* b2 = last ? nB : cB + (size_t)(t + 2) * kstep;
            const char* a3 = a2 + kstep; const char* b3 = b2 + kstep;
            if (last && has_next) S.a_ready(nxt);
            if constexpr (SP2) {
            PG8_LDB(B0, 0, 0); PG8_LDB(B1, 0, 1); PG8_SCHED; PG8_LDA(At, 0, 0); PG8_STAGE(PG8_SA(1, 1), a1 + hstep, voffA);
            C.template step<0>(); PG8_WAIT_VA; PG8_WAIT_L(0); PG8_BAR; PG8_MMA(0, 0, At, B0); PG8_MMA(0, 1, At, B1); PG8_BAR; PG8_SCHED;
            PG8_LDA(At, 0, 1); PG8_STAGE(PG8_SB(0, 0), b2, voffB); PG8_STAGE(PG8_SB(0, 1), b2 + hstep, voffB); PG8_STAGE(PG8_SA(0, 0), a2, voffA);
            PG8_WAIT_VB; PG8_WAIT_L(0); PG8_BAR; PG8_MMA(1, 0, At, B0); PG8_MMA(1, 1, At, B1); PG8_BAR; PG8_SCHED;
            PG8_LDB(B0, 1, 0); PG8_LDB(B1, 1, 1); PG8_SCHED; PG8_LDA(At, 1, 0); PG8_STAGE(PG8_SA(0, 1), a2 + hstep, voffA);
            C.template step<1>(); PG8_WAIT_VA; PG8_WAIT_L(0); PG8_BAR; PG8_MMA(0, 0, At, B0); PG8_MMA(0, 1, At, B1); PG8_BAR; PG8_SCHED;
            PG8_LDA(At, 1, 1); PG8_STAGE(PG8_SB(1, 0), b3, voffB); PG8_STAGE(PG8_SB(1, 1), b3 + hstep, voffB); PG8_STAGE(PG8_SA(1, 0), a3, voffA);
            PG8_WAIT_VB; PG8_WAIT_L(0); PG8_BAR; PG8_MMA(1, 0, At, B0); PG8_MMA(1, 1, At, B1); PG8_BAR; PG8_SCHED;
            } else {
            PG8_LDB(B0, 0, 0); PG8_SCHED; PG8_LDA(At, 0, 0); PG8_STAGE(PG8_SA(1, 1), a1 + hstep, voffA);
            PG8_WAIT_L(8); PG8_BAR; PG8_WAIT_L(0); PG8_MMA(0, 0, At, B0); PG8_BAR; PG8_SCHED;
            PG8_LDB(B1, 0, 1); PG8_STAGE(PG8_SB(0, 0), b2, voffB);
            PG8_BAR; PG8_WAIT_L(0); PG8_MMA(0, 1, At, B1); PG8_BAR;
            PG8_LDA(At, 0, 1); PG8_STAGE(PG8_SA(0, 0), a2, voffA);
            PG8_BAR; PG8_WAIT_L(0); PG8_MMA(1, 0, At, B0); PG8_BAR; PG8_SCHED;
            PG8_STAGE(PG8_SB(0, 1), b2 + hstep, voffB);
            PG8_WAIT_V(6); PG8_BAR; PG8_MMA(1, 1, At, B1); PG8_BAR;
            PG8_LDB(B0, 1, 0); PG8_SCHED; PG8_LDA(At, 1, 0); PG8_STAGE(PG8_SA(0, 1), a2 + hstep, voffA);
            PG8_WAIT_L(8); PG8_BAR; PG8_WAIT_L(0); PG8_MMA(0, 0, At, B0); PG8_BAR; PG8_SCHED;
            PG8_LDB(B1, 1, 1); PG8_STAGE(PG8_SB(1, 0), b3, voffB);
            PG8_BAR; PG8_WAIT_L(0); PG8_MMA(0, 1, At, B1); PG8_BAR;
            PG8_LDA(At, 1, 1); PG8_STAGE(PG8_SA(1, 0), a3, voffA);
            PG8_BAR; PG8_WAIT_L(0); PG8_MMA(1, 0, At, B0); PG8_BAR; PG8_SCHED;
            PG8_STAGE(PG8_SB(1, 1), b3 + hstep, voffB);
            PG8_WAIT_V(6); PG8_BAR; PG8_MMA(1, 1, At, B1); PG8_BAR;
            }
        }
        if constexpr (ALIGN_EPI) { if (wr == 0) PG8_BAR; }
        if constexpr (!Epi::AFTER_DRAIN) { E(acc, cur, wr, wc, fr, fq); S.done(cur); }
        if (!has_next) break;
#pragma unroll
        for (int a = 0; a < 2; ++a)
#pragma unroll
            for (int b = 0; b < 2; ++b)
#pragma unroll
                for (int m = 0; m < 4; ++m)
#pragma unroll
                    for (int n = 0; n < 2; ++n) acc[a][b][m][n] = (f32x4){0.f, 0.f, 0.f, 0.f};
        cur = nxt; cA = nA; cB = nB; ++ui;
        if constexpr (ALIGN_EPI) { if (wr == 1) PG8_BAR; }
    }
    PG8_WAIT_V(0);
    C.flush();
    if constexpr (!ALIGN_EPI) { if (wr == 0) PG8_BAR; }
    PG8_BAR;
    if constexpr (Epi::AFTER_DRAIN) { E.fused(acc, cur, wr, wc, fr, fq, lds, wid, lane); S.done(cur); }
#undef PG8_SA
#undef PG8_SB
#undef PG8_STAGE
#undef PG8_LDA
#undef PG8_LDB
#undef PG8_MMA
#undef PG8_WAIT_V
#undef PG8_WAIT_L
#undef PG8_WAIT_VA
#undef PG8_WAIT_VB
#undef PG8_BAR
#undef PG8_SCHED
}
}
namespace pg8 {
struct StreamCopy4 {
    const unsigned char* src; unsigned char* dst; int cur, tw, last; unsigned lane_off; f32x4 b0, b1, b2, b3;
    __device__ __forceinline__ void skip() { cur += 4; }
    __device__ __forceinline__ unsigned off_of(int c0) const { int c = c0 + tw; c = c < last ? c : last; return (unsigned)c * 1024u + lane_off; }
    static __device__ __forceinline__ void ld(f32x4& v, unsigned off, const unsigned char* base) { asm volatile("global_load_dwordx4 %0, %1, %2 nt" : "=v"(v) : "v"(off), "s"(base) : "memory"); }
    static __device__ __forceinline__ void st_w6(const f32x4& v, unsigned off, unsigned char* base) { asm volatile("s_waitcnt vmcnt(6)\n\tglobal_store_dwordx4 %0, %1, %2 nt\n\ts_nop 0" : : "v"(off), "v"(v), "s"(base) : "memory"); }
    static __device__ __forceinline__ void st(const f32x4& v, unsigned off, unsigned char* base) { asm volatile("global_store_dwordx4 %0, %1, %2 nt\n\ts_nop 0" : : "v"(off), "v"(v), "s"(base) : "memory"); }
    __device__ __forceinline__ void prime() { ld(b0, off_of(cur), src); ld(b1, off_of(cur + 4), src); ld(b2, off_of(cur + 8), src); ld(b3, off_of(cur + 12), src); cur += 16;
        asm volatile("s_waitcnt vmcnt(0)" ::: "memory"); }
    template <int P> __device__ __forceinline__ void step() {
        const unsigned so = off_of(cur - 16), lo = off_of(cur); cur += 4;
        if (P == 0) { st_w6(b0, so, dst); ld(b0, lo, src); }
        if (P == 1) { st_w6(b1, so, dst); ld(b1, lo, src); }
        if (P == 2) { st_w6(b2, so, dst); ld(b2, lo, src); }
        if (P == 3) { st_w6(b3, so, dst); ld(b3, lo, src); }
    }
    __device__ __forceinline__ void flush() { st(b0, off_of(cur - 16), dst); st(b1, off_of(cur - 12), dst); st(b2, off_of(cur - 8), dst); st(b3, off_of(cur - 4), dst); }
};
#define RS_SA(b, h) (((b) * 2 + (h)) * HTB)
#define RS_SB(b, h) ((4 + (b) * 2 + (h)) * HTB)
#define RS_STAGE(bufoff, gbase, voff) do { _Pragma("unroll") for (int _i = 0; _i < 4; ++_i) \
        __builtin_amdgcn_global_load_lds((const unsigned*)((const char*)(gbase) + (size_t)_i * pstep + (voff)), (PG8_LAS unsigned*)(lds + (bufoff) + ldsw + _i * 4096), 16, 0, 0); } while (0)
#define RS_LDA(dst, b, h) do { _Pragma("unroll") for (int m = 0; m < 4; ++m) _Pragma("unroll") for (int k = 0; k < 2; ++k) dst[m][k] = *(const PG8_LAS bf16x8*)(lds + RS_SA(b, h) + aoff + m * 2048 + k * 1024); } while (0)
#define RS_LDB(dst, b, h) do { _Pragma("unroll") for (int n = 0; n < 2; ++n) _Pragma("unroll") for (int k = 0; k < 2; ++k) dst[n][k] = *(const PG8_LAS bf16x8*)(lds + RS_SB(b, h) + boff + n * 2048 + k * 1024); } while (0)
#define RS_MMA(ai, bj, At, Bt) do { __builtin_amdgcn_s_setprio(1); _Pragma("unroll") for (int m = 0; m < 4; ++m) _Pragma("unroll") for (int n = 0; n < 2; ++n) _Pragma("unroll") for (int k = 0; k < 2; ++k) \
        acc[ai][bj][m][n] = __builtin_amdgcn_mfma_f32_16x16x32_bf16(Bt[n][k], At[m][k], acc[ai][bj][m][n], 0, 0, 0); __builtin_amdgcn_s_setprio(0); } while (0)
#define RS_WAIT_V(n) asm volatile("s_waitcnt vmcnt(" #n ")" ::: "memory")
#define RS_WAIT_L(n) asm volatile("s_waitcnt lgkmcnt(" #n ")" ::: "memory")
#define RS_BAR __builtin_amdgcn_s_barrier()
#define RS_SCHED __builtin_amdgcn_sched_barrier(0)
template <bool STAGER, class Epi, class Sched>
__device__ __forceinline__ void rs_role(PG8_LAS unsigned char* lds, const Gemm g, const Sched& S, const Epi& E, StreamCopy4& C) {
    int tid_ = threadIdx.x; asm volatile("" : "+v"(tid_));
    const int tid = tid_, wid = __builtin_amdgcn_readfirstlane(tid >> 6), lane = tid & 63, wr = STAGER ? 0 : 1, wc = wid & 3, fr = lane & 15, fq = lane >> 4;
    const int K = g.K;
    unsigned voffA = 0, voffB = 0;
    if (STAGER) { int R, Cc; stage_rc((tid & 255) * 16, R, Cc); const int Rb = Epi::PERM ? ((R & ~31) + perm32(R & 31)) : R; voffA = (unsigned)(R * K + Cc) * 2u; voffB = (unsigned)(Rb * K + Cc) * 2u; }
    const size_t kstep = (size_t)(BK * 2), hstep = (size_t)HALF * K * 2, tstep = 2 * hstep, pstep = (size_t)32 * K * 2;
    const unsigned ldsw = (unsigned)(wid & 3) * 1024u;
    const int aoff = lds_byte(wr * 64 + fr, fq * 8), boff = lds_byte(wc * 32 + fr, fq * 8);
    Unit cur, nxt; int ui = 0;
    if (!S.next(0, cur)) return;
    f32x4 acc[2][2][4][2];
#pragma unroll
    for (int a = 0; a < 2; ++a)
#pragma unroll
        for (int b = 0; b < 2; ++b)
#pragma unroll
            for (int m = 0; m < 4; ++m)
#pragma unroll
                for (int n = 0; n < 2; ++n) acc[a][b][m][n] = (f32x4){0.f, 0.f, 0.f, 0.f};
    bf16x8 At[4][2], B0[2][2], B1[2][2];
    const char* cA = (const char*)g.A + (size_t)cur.pm * tstep + (size_t)cur.kt0 * kstep; const char* cB = (const char*)g.Bt + (size_t)cur.pn * tstep + (size_t)cur.kt0 * kstep;
    if (STAGER) {
        RS_STAGE(RS_SB(0, 0), cB, voffB); RS_STAGE(RS_SB(0, 1), cB + hstep, voffB); RS_STAGE(RS_SA(0, 0), cA, voffA); RS_STAGE(RS_SA(0, 1), cA + hstep, voffA);
        RS_WAIT_V(4); RS_BAR;
        RS_STAGE(RS_SB(1, 0), cB + kstep, voffB); RS_STAGE(RS_SA(1, 0), cA + kstep, voffA); RS_STAGE(RS_SB(1, 1), cB + hstep + kstep, voffB);
        RS_WAIT_V(12); RS_BAR;
        C.skip(); C.skip(); C.skip(); C.skip();
    } else {
        C.prime();
        RS_BAR; RS_BAR; RS_BAR;
    }
    for (;;) {
        const bool has_next = S.next(ui + 1, nxt);
        const char* nA = has_next ? (const char*)g.A + (size_t)nxt.pm * tstep + (size_t)nxt.kt0 * kstep : cA; const char* nB = has_next ? (const char*)g.Bt + (size_t)nxt.pn * tstep + (size_t)nxt.kt0 * kstep : cB;
        const int nt = cur.nkt;
#pragma nounroll
        for (int t = 0; t < nt; t += 2) {
            const bool last = (t == nt - 2);
            const char* a1 = cA + (size_t)(t + 1) * kstep;
            const char* a2 = last ? nA : cA + (size_t)(t + 2) * kstep; const char* b2 = last ? nB : cB + (size_t)(t + 2) * kstep;
            const char* a3 = a2 + kstep; const char* b3 = b2 + kstep;
            RS_LDB(B0, 0, 0); RS_LDB(B1, 0, 1); RS_SCHED; RS_LDA(At, 0, 0);
            if (STAGER) { RS_STAGE(RS_SA(1, 1), a1 + hstep, voffA); RS_WAIT_V(16); C.skip(); } else { C.template step<0>(); }
            RS_WAIT_L(0); RS_BAR; RS_MMA(0, 0, At, B0); RS_MMA(0, 1, At, B1); RS_BAR; RS_SCHED;
            RS_LDA(At, 0, 1);
            if (STAGER) { RS_STAGE(RS_SB(0, 0), b2, voffB); RS_STAGE(RS_SB(0, 1), b2 + hstep, voffB); RS_STAGE(RS_SA(0, 0), a2, voffA); RS_WAIT_V(16); C.skip(); } else { C.template step<1>(); }
            RS_WAIT_L(0); RS_BAR; RS_MMA(1, 0, At, B0); RS_MMA(1, 1, At, B1); RS_BAR; RS_SCHED;
            RS_LDB(B0, 1, 0); RS_LDB(B1, 1, 1); RS_SCHED; RS_LDA(At, 1, 0);
            if (STAGER) { RS_STAGE(RS_SA(0, 1), a2 + hstep, voffA); RS_WAIT_V(16); C.skip(); } else { C.template step<2>(); }
            RS_WAIT_L(0); RS_BAR; RS_MMA(0, 0, At, B0); RS_MMA(0, 1, At, B1); RS_BAR; RS_SCHED;
            RS_LDA(At, 1, 1);
            if (STAGER) { RS_STAGE(RS_SB(1, 0), b3, voffB); RS_STAGE(RS_SB(1, 1), b3 + hstep, voffB); RS_STAGE(RS_SA(1, 0), a3, voffA); RS_WAIT_V(16); C.skip(); } else { C.template step<3>(); }
            RS_WAIT_L(0); RS_BAR; RS_MMA(1, 0, At, B0); RS_MMA(1, 1, At, B1); RS_BAR; RS_SCHED;
        }
        if (STAGER) RS_BAR;
        E(acc, cur, wr, wc, fr, fq);
        if (!has_next) break;
#pragma unroll
        for (int a = 0; a < 2; ++a)
#pragma unroll
            for (int b = 0; b < 2; ++b)
#pragma unroll
                for (int m = 0; m < 4; ++m)
#pragma unroll
                    for (int n = 0; n < 2; ++n) acc[a][b][m][n] = (f32x4){0.f, 0.f, 0.f, 0.f};
        cur = nxt; cA = nA; cB = nB; ++ui;
        if (!STAGER) RS_BAR;
    }
    RS_WAIT_V(0);
    if (!STAGER) C.flush();
    RS_BAR;
}
template <class Epi, class Sched>
__device__ __forceinline__ void gemm_phase_rs(PG8_LAS unsigned char* lds, const Gemm g, const Sched& S, const Epi& E, StreamCopy4& C) {
    static_assert(!Epi::AFTER_DRAIN, "gemm_phase_rs: in-loop epilogues only");
    const int wid = __builtin_amdgcn_readfirstlane((int)threadIdx.x >> 6);
    if (wid < 4) rs_role<true>(lds, g, S, E, C); else rs_role<false>(lds, g, S, E, C);
}
#undef RS_SA
#undef RS_SB
#undef RS_STAGE
#undef RS_LDA
#undef RS_LDB
#undef RS_MMA
#undef RS_WAIT_V
#undef RS_WAIT_L
#undef RS_BAR
#undef RS_SCHED
}
constexpr size_t MiB = 1u << 20;
constexpr size_t WS_CTL = 0, CTL_ZERO_BYTES = 1 * MiB;
constexpr size_t WS_WGU1 = 2 * MiB, WS_WD1 = 14 * MiB, WS_WIN = 20 * MiB, WS_WOUT = 25 * MiB, WS_WGU2 = 28 * MiB, WS_WD2 = 40 * MiB, WS_WPG = 46 * MiB, WS_WPP = 49 * MiB, WS_ROPE = 50 * MiB;
constexpr size_t WS_RS = 54 * MiB;
constexpr size_t WS_XB = 56 * MiB;
constexpr size_t WS_H = 92 * MiB;
constexpr size_t WS_ACT = 160 * MiB;
constexpr size_t WS_Y = 252 * MiB;
constexpr size_t WS_QKV = 288 * MiB;
constexpr size_t WS_ATT = 364 * MiB;
constexpr size_t WS_OP2 = 400 * MiB, WS_OP3 = 418 * MiB;
constexpr size_t WS_LS2 = 436 * MiB, WS_LS3 = 437 * MiB;
constexpr size_t WS_PB = 438 * MiB;
constexpr size_t WS_PP = 448 * MiB;
constexpr size_t WS_SLAB = 484 * MiB;
constexpr size_t WS_END = 492 * MiB;
static_assert(WS_WGU1 + (size_t)2 * FF * D * 2 <= WS_WD1 && WS_WD1 + (size_t)D * FF * 2 <= WS_WIN && WS_WIN + (size_t)NIN * D * 2 <= WS_WOUT && WS_WOUT + (size_t)D * D * 2 <= WS_WGU2 &&
              WS_WGU2 + (size_t)2 * FF * D * 2 <= WS_WD2 && WS_WD2 + (size_t)D * FF * 2 <= WS_WPG && WS_WPG + (size_t)D * D * 2 <= WS_WPP && WS_WPP + (size_t)D * DPLE * 2 <= WS_ROPE &&
              WS_ROPE + (size_t)8193 * 64 * 4 <= WS_RS && WS_RS + (size_t)MT * 4 <= WS_XB && WS_XB + (size_t)MT * D * 2 <= WS_H && WS_H + (size_t)MT * D * 4 <= WS_ACT &&
              WS_ACT + (size_t)MT * FF * 2 <= WS_Y && WS_Y + (size_t)MT * D * 2 <= WS_QKV && WS_QKV + (size_t)MT * NIN * 2 <= WS_ATT && WS_ATT + (size_t)MT * D * 2 <= WS_OP2 &&
              WS_OP2 + (size_t)MP * 512 * 2 <= WS_OP3 && WS_OP3 + (size_t)MP * 512 * 2 <= WS_LS2 && WS_LS2 + (size_t)MP * 8 * 4 <= WS_LS3 && WS_LS3 + (size_t)MP * 8 * 4 <= WS_PB &&
              WS_PB + (size_t)MT * DPLE * 2 <= WS_PP && WS_PP + (size_t)MT * D * 2 <= WS_SLAB && WS_SLAB + (size_t)11 * 128 * D * 4 <= WS_END, "d_ws map");
constexpr int CW_BAR = 4096;
constexpr int CW_CUR = 8192;
constexpr int CW_DONE = 8256;
constexpr int RING_OFF = 0, RING_BYTES = 131072;
constexpr int LDSCTL_OFF = RING_BYTES, MISC_OFF = LDSCTL_OFF + 320;
constexpr int LDS_BYTES = 147456;
static_assert(MISC_OFF + 128 <= LDS_BYTES, "LDS map");

#define GAS __attribute__((address_space(1)))
#define LAS __attribute__((address_space(3)))
typedef unsigned short bf16;
typedef unsigned v4u __attribute__((ext_vector_type(4)));
typedef float f32x4 __attribute__((ext_vector_type(4)));
typedef short bf16x8 __attribute__((ext_vector_type(8)));
typedef GAS unsigned gu32;
typedef GAS unsigned long long gu64;
#define RLX_AGENT __ATOMIC_RELAXED, __HIP_MEMORY_SCOPE_AGENT
#define LDS_WAIT() asm volatile("s_waitcnt lgkmcnt(0)" ::: "memory")
#define VM_WAIT() asm volatile("s_waitcnt vmcnt(0)" ::: "memory")
__device__ __forceinline__ unsigned long long rt() { return __builtin_amdgcn_s_memrealtime(); }
__device__ __forceinline__ unsigned f2bf(float f) { unsigned u = __builtin_bit_cast(unsigned, f); return (u + 0x7fffu + ((u >> 16) & 1u)) >> 16; }
__device__ __forceinline__ unsigned pk2(float lo, float hi) { return f2bf(lo) | (f2bf(hi) << 16); }

#define XB_TMO      128
#define XB_XCNT(j)  (256  + 64 * (j))
#define XB_XSUB(j)  (1280 + 64 * (j))
#define XB_XGEN(j)  (2304 + 64 * (j))
#define XB_TOP      3328
#define XB_TOPGEN   3392
#define XCD_BAR_WORDS 3456
#define XB_SPIN_CAP (1u << 18)

__device__ __forceinline__ unsigned xb_ld(unsigned* p)              { return __hip_atomic_load(p, __ATOMIC_RELAXED, __HIP_MEMORY_SCOPE_AGENT); }
__device__ __forceinline__ unsigned xb_add(unsigned* p, unsigned v) { return __hip_atomic_fetch_add(p, v, __ATOMIC_RELAXED, __HIP_MEMORY_SCOPE_AGENT); }
__device__ __forceinline__ unsigned xb_xcc_id() { return (unsigned)__builtin_amdgcn_s_getreg((3 << 11) | 20) & 0xFu; }
#define XB_SPIN(cond, bar) do { unsigned _sp = 0; while (cond) { __builtin_amdgcn_s_sleep(1); \
    if ((++_sp & 255u) == 0u) { if (xb_ld(&(bar)[XB_TMO])) break; if (_sp > XB_SPIN_CAP) { atomicAdd(&(bar)[XB_TMO], 1u); break; } } } } while (0)

struct XcdBarrier {
    unsigned* bar; unsigned x;
    volatile LAS unsigned* st;
};

__device__ __forceinline__ XcdBarrier xcd_barrier_post(unsigned* bar, volatile LAS unsigned* st) {
    XcdBarrier b; b.bar = bar; b.x = xb_xcc_id(); b.st = st;
    if (threadIdx.x == 0) (void)xb_add(&bar[XB_XCNT(b.x)], 1u);
    return b;
}
__device__ __forceinline__ void xcd_barrier_complete(unsigned* bar, unsigned x, unsigned& nloc, unsigned& nx) {
    const unsigned G = gridDim.x * gridDim.y * gridDim.z;
    unsigned sum, cnt, mine, sp = 0u;
    for (;;) {
        sum = 0u; cnt = 0u; mine = 0u;
#pragma unroll
        for (unsigned j = 0; j < 16; ++j) { const unsigned c = xb_ld(&bar[XB_XCNT(j)]); sum += c; cnt += (c > 0u) ? 1u : 0u; mine = (j == x) ? c : mine; }
        if (sum == G) break;
        __builtin_amdgcn_s_sleep(1);
        if ((++sp & 255u) == 0u) { if (xb_ld(&bar[XB_TMO])) break; if (sp > XB_SPIN_CAP) { atomicAdd(&bar[XB_TMO], 1u); break; } }
    }
    nloc = mine > 0u ? mine : 1u; nx = cnt > 0u ? cnt : 1u;
}

__device__ __forceinline__ void xcd_barrier(const XcdBarrier& b) {
    asm volatile("s_waitcnt vmcnt(0)" ::: "memory");
    __syncthreads();
    if (threadIdx.x == 0) {
        unsigned* bar = b.bar;
        __builtin_amdgcn_s_waitcnt(0);
        unsigned nloc = b.st[0], nx = b.st[1];
        if (nloc == 0u) { xcd_barrier_complete(bar, b.x, nloc, nx); b.st[0] = nloc; b.st[1] = nx; }
        const unsigned old = xb_add(&bar[XB_XSUB(b.x)], 1u);
        const unsigned gen = old / nloc;
        if (old + 1u == (gen + 1u) * nloc) {
            __builtin_amdgcn_fence(__ATOMIC_RELEASE, "agent");
            asm volatile("s_waitcnt vmcnt(0)" ::: "memory");
            const unsigned og = xb_add(&bar[XB_TOP], 1u);
            const unsigned tg = og / nx;
            if (og + 1u == (tg + 1u) * nx) xb_add(&bar[XB_TOPGEN], 1u);
            else XB_SPIN(xb_ld(&bar[XB_TOPGEN]) == tg, bar);
            __builtin_amdgcn_fence(__ATOMIC_ACQUIRE, "agent");
            xb_add(&bar[XB_XGEN(b.x)], 1u);
            asm volatile("s_waitcnt vmcnt(0)" ::: "memory");
        } else {
            XB_SPIN(xb_ld(&bar[XB_XGEN(b.x)]) == gen, bar);
            __builtin_amdgcn_fence(__ATOMIC_ACQUIRE, "agent");
            asm volatile("s_waitcnt vmcnt(0)" ::: "memory");
        }
    }
    __syncthreads();
}

typedef unsigned u32x2g __attribute__((ext_vector_type(2)));
typedef float f32x16 __attribute__((ext_vector_type(16)));
typedef short s16x4 __attribute__((ext_vector_type(4)));
struct Args { const float* in[27]; float* out; unsigned char* ws; };
struct Frame {
    LAS unsigned char* lds;
    volatile LAS unsigned* MISC;
    gu32* ctl;
    int tid, lane, wave;
    int vcu, G;
    int copy_cur;
};
__device__ __forceinline__ float wave_sum(float v) {
#pragma unroll
    for (int o = 1; o < 64; o <<= 1) v += __shfl_xor(v, o);
    return v;
}
__device__ __forceinline__ float bf_lo(unsigned w) { return __uint_as_float(w << 16); }
__device__ __forceinline__ float bf_hi(unsigned w) { return __uint_as_float(w & 0xffff0000u); }

enum { MAP_ID = 0, MAP_GATE = 1, MAP_UP = 2, MAP_ROPE = 3 };
__host__ __device__ __forceinline__ int map_row(int kind, int n) {
    if (kind == MAP_ID) return n;
    if (kind == MAP_ROPE) {
        const int pn = n >> 8, c = n & 255, hl = c >> 6, d = c & 63;
        const int bj = hl >> 1, wch = hl & 1, nn = d >> 5, dd = d & 31, wcl = dd >> 4, fq = (dd >> 2) & 3, i = dd & 3;
        const int wc = wch * 2 + wcl;
        return pn * 256 + 128 * bj + 32 * wc + 8 * fq + 4 * nn + i;
    }
    const int pn = n >> 7, o = n & 127, wc = o >> 5, fq = (o >> 3) & 3, bj = (o >> 2) & 1, i = o & 3;
    return pn * 256 + 128 * bj + 32 * wc + 8 * fq + 4 * (kind == MAP_UP ? 1 : 0) + i;
}
__device__ __forceinline__ void p0_transpose_item(const float* W, int K, int N, bf16* WT, int kind, const float* gain, LAS float* scr, int item, int lane) {
    const int nblk = N / 32, kb = item / nblk, nb = item % nblk, k0 = 64 * kb, n0 = 32 * nb;
    float wv[32];
#pragma unroll
    for (int i = 0; i < 32; ++i) { const int kk = 2 * i + (lane >> 5); wv[i] = W[(size_t)(k0 + kk) * N + n0 + (lane & 31)]; }
#pragma unroll
    for (int i = 0; i < 32; ++i) { const int kk = 2 * i + (lane >> 5); const float g = gain ? gain[k0 + kk] : 1.0f; scr[kk * 33 + (lane & 31)] = wv[i] * g; }
    LDS_WAIT(); asm volatile("" ::: "memory");
    const int c = lane & 7;
#pragma unroll
    for (int j = 0; j < 4; ++j) { const int n = (lane >> 3) + 8 * j; const LAS float* s = scr + (8 * c) * 33 + n;
        v4u o; o.x = pk2(s[0 * 33], s[1 * 33]); o.y = pk2(s[2 * 33], s[3 * 33]); o.z = pk2(s[4 * 33], s[5 * 33]); o.w = pk2(s[6 * 33], s[7 * 33]);
        *(GAS v4u*)(WT + (size_t)map_row(kind, n0 + n) * K + k0 + 8 * c) = o; }
    LDS_WAIT(); asm volatile("" ::: "memory");
}
__device__ __forceinline__ void row_to_bf16_rs(int lane, const float* xrow, bf16* orow, float* rs) {
    const GAS f32x4* xr = (const GAS f32x4*)xrow + lane;
    f32x4 v[4]; float s = 0.f;
#pragma unroll
    for (int j = 0; j < 4; ++j) { v[j] = xr[64 * j]; s += (v[j].x * v[j].x + v[j].y * v[j].y) + (v[j].z * v[j].z + v[j].w * v[j].w); }
    s = wave_sum(s);
    GAS unsigned long long* o8 = (GAS unsigned long long*)orow + lane;
#pragma unroll
    for (int j = 0; j < 4; ++j) o8[64 * j] = (unsigned long long)pk2(v[j].x, v[j].y) | ((unsigned long long)pk2(v[j].z, v[j].w) << 32);
    if (lane == 0) *rs = 1.0f / sqrtf(s * (1.0f / D) + EPS);
}

__device__ __forceinline__ void rows2_to_bf16_rs(int lane, const float* xa, const float* xb, bf16* oa, bf16* ob, float* ra, float* rb) {
    const GAS f32x4* pa = (const GAS f32x4*)xa + lane; const GAS f32x4* pb = (const GAS f32x4*)xb + lane;
    f32x4 va[4], vb[4]; float sa = 0.f, sb = 0.f;
#pragma unroll
    for (int j = 0; j < 4; ++j) { va[j] = pa[64 * j]; vb[j] = pb[64 * j]; }
#pragma unroll
    for (int j = 0; j < 4; ++j) { sa += (va[j].x * va[j].x + va[j].y * va[j].y) + (va[j].z * va[j].z + va[j].w * va[j].w); sb += (vb[j].x * vb[j].x + vb[j].y * vb[j].y) + (vb[j].z * vb[j].z + vb[j].w * vb[j].w); }
    sa = wave_sum(sa); sb = wave_sum(sb);
    GAS unsigned long long* qa = (GAS unsigned long long*)oa + lane; GAS unsigned long long* qb = (GAS unsigned long long*)ob + lane;
#pragma unroll
    for (int j = 0; j < 4; ++j) { qa[64 * j] = (unsigned long long)pk2(va[j].x, va[j].y) | ((unsigned long long)pk2(va[j].z, va[j].w) << 32); qb[64 * j] = (unsigned long long)pk2(vb[j].x, vb[j].y) | ((unsigned long long)pk2(vb[j].z, vb[j].w) << 32); }
    if (lane == 0) { *ra = 1.0f / sqrtf(sa * (1.0f / D) + EPS); *rb = 1.0f / sqrtf(sb * (1.0f / D) + EPS); }
}

__device__ __forceinline__ void copy_shift(const float* src, float* dst, int nbatch, int L, int RW, int gtid, int gthreads) {
    const unsigned per_b4 = (unsigned)(L - 1) * RW / 4, blk4 = (unsigned)L * RW / 4, shift4 = (unsigned)RW / 4, total = per_b4 * (unsigned)nbatch;
    const GAS f32x4* s4 = (const GAS f32x4*)src; GAS f32x4* d4 = (GAS f32x4*)dst;
    for (unsigned i0 = gtid; i0 < total; i0 += 4u * gthreads) { f32x4 v[4]; unsigned o[4];
#pragma unroll
        for (int q = 0; q < 4; ++q) { unsigned i = i0 + q * gthreads; i = i < total ? i : total - 1; const unsigned b = i / per_b4, e = i - b * per_b4; o[q] = b * blk4 + e; v[q] = __builtin_nontemporal_load(s4 + o[q] + shift4); }
#pragma unroll
        for (int q = 0; q < 4; ++q) __builtin_nontemporal_store(v[q], d4 + o[q]); }
}

__device__ __forceinline__ void p0_prologue(Frame& F, const Args& A) {
    unsigned char* ws = A.ws;
    LAS float* scr = (LAS float*)(F.lds + RING_OFF + F.wave * 16384);
    const int gw = F.vcu * NWAVES + F.wave, NGW = F.G * NWAVES;
    constexpr int I_GU = (D / 64) * (FF / 32), I_DN = (FF / 64) * (D / 32), I_IN = (D / 64) * (NIN / 32), I_SQ = (D / 64) * (D / 32), I_PP = (DPLE / 64) * (D / 32);
    constexpr int NITEMS = 4 * I_GU + 2 * I_DN + I_IN + 2 * I_SQ + I_PP;
    for (int it = gw; it < NITEMS; it += NGW) {
        int r = it;
        if (r < I_GU) { p0_transpose_item(A.in[10], D, FF, (bf16*)(ws + WS_WGU1), MAP_GATE, A.in[8], scr, r, F.lane); continue; } r -= I_GU;
        if (r < I_GU) { p0_transpose_item(A.in[11], D, FF, (bf16*)(ws + WS_WGU1), MAP_UP, A.in[8], scr, r, F.lane); continue; } r -= I_GU;
        if (r < I_DN) { p0_transpose_item(A.in[12], FF, D, (bf16*)(ws + WS_WD1), MAP_ID, nullptr, scr, r, F.lane); continue; } r -= I_DN;
        if (r < I_IN) { p0_transpose_item(A.in[15], D, NIN, (bf16*)(ws + WS_WIN), MAP_ROPE, A.in[13], scr, r, F.lane); continue; } r -= I_IN;
        if (r < I_SQ) { p0_transpose_item(A.in[17], D, D, (bf16*)(ws + WS_WOUT), MAP_ID, nullptr, scr, r, F.lane); continue; } r -= I_SQ;
        if (r < I_GU) { p0_transpose_item(A.in[20], D, FF, (bf16*)(ws + WS_WGU2), MAP_GATE, A.in[18], scr, r, F.lane); continue; } r -= I_GU;
        if (r < I_GU) { p0_transpose_item(A.in[21], D, FF, (bf16*)(ws + WS_WGU2), MAP_UP, A.in[18], scr, r, F.lane); continue; } r -= I_GU;
        if (r < I_DN) { p0_transpose_item(A.in[22], FF, D, (bf16*)(ws + WS_WD2), MAP_ID, nullptr, scr, r, F.lane); continue; } r -= I_DN;
        if (r < I_SQ) { p0_transpose_item(A.in[25], D, D, (bf16*)(ws + WS_WPG), MAP_ID, A.in[23], scr, r, F.lane); continue; } r -= I_SQ;
        p0_transpose_item(A.in[26], DPLE, D, (bf16*)(ws + WS_WPP), MAP_ID, nullptr, scr, r, F.lane);
    }
    bf16* XB = (bf16*)(ws + WS_XB); float* RS = (float*)(ws + WS_RS);
    for (int m = gw; m < MR; m += 2 * NGW) { const int m2 = (m + NGW < MR) ? m + NGW : m;
        const float* xr = (m < MP) ? A.in[0] + (size_t)m * D : A.in[1] + (size_t)(m - MP) * D; const float* xr2 = (m2 < MP) ? A.in[0] + (size_t)m2 * D : A.in[1] + (size_t)(m2 - MP) * D;
        rows2_to_bf16_rs(F.lane, xr, xr2, XB + (size_t)m * D, XB + (size_t)m2 * D, RS + m, RS + m2); }
    bf16* PB = (bf16*)(ws + WS_PB);
    for (int m0 = gw; m0 < MR; m0 += 4 * NGW) { f32x4 v[4]; int mm[4];
#pragma unroll
        for (int q = 0; q < 4; ++q) { const int m = (m0 + q * NGW < MR) ? m0 + q * NGW : m0; mm[q] = m; const float* pr = (m < MP) ? A.in[6] + (size_t)m * DPLE : A.in[7] + (size_t)(m - MP) * DPLE; v[q] = *((const GAS f32x4*)pr + F.lane); }
#pragma unroll
        for (int q = 0; q < 4; ++q) *((GAS unsigned long long*)(PB + (size_t)mm[q] * DPLE) + F.lane) = (unsigned long long)pk2(v[q].x, v[q].y) | ((unsigned long long)pk2(v[q].z, v[q].w) << 32); }
    { float* rope = (float*)(ws + WS_ROPE); const int gt = gw * 64 + F.lane, NGT = NGW * 64;
      for (int i = gt; i < 8193 * 32; i += NGT) { const int idx = i >> 5, d = i & 31; const float pos = (float)(idx < SEQ ? idx : PAST);
          const float inv = powf(10000.0f, -(float)d * (1.0f / 32.0f)); const float ang = pos * inv;
          rope[2 * i] = cosf(ang); rope[2 * i + 1] = sinf(ang); } }
    { const int gt = gw * 64 + F.lane, NGT = NGW * 64;
      copy_shift(A.in[4], A.out + O_BKS, MS, LB, 128, gt, NGT);
      copy_shift(A.in[5], A.out + O_BVS, MS, LB, 128, gt, NGT); }
}

constexpr int CHUNK_OPS = 32, CHUNKS_PER_BUF = 128, NCHUNKS = 256 * CHUNKS_PER_BUF, OPS_PER_BUF = 4094;
__device__ __forceinline__ void side_copy(const Args& A, gu32* ctl, int lane, int done_word, unsigned done_target) {
    for (;;) {
        unsigned id = 0; if (lane == 0) id = __hip_atomic_fetch_add(ctl + CW_CUR, 1u, RLX_AGENT); id = (unsigned)__builtin_amdgcn_readfirstlane((int)id);
        if (id >= (unsigned)NCHUNKS) break;
        const int buf = (int)(id >> 7), sub = (int)(id & 127), op0 = sub * CHUNK_OPS, nops = (OPS_PER_BUF - op0) < CHUNK_OPS ? (OPS_PER_BUF - op0) : CHUNK_OPS;
        const GAS f32x4* s4 = (const GAS f32x4*)(A.in[2 + (buf >> 7)] + (size_t)(buf & 127) * LA * 512 + 512) + (size_t)op0 * 64 + lane;
        GAS f32x4* d4 = (GAS f32x4*)(A.out + ((buf >> 7) ? O_AVS : O_AKS) + (size_t)(buf & 127) * LA * 512) + (size_t)op0 * 64 + lane;
        f32x4 v[CHUNK_OPS];
#pragma unroll
        for (int q = 0; q < CHUNK_OPS; ++q) { const int qq = q < nops ? q : nops - 1; v[q] = __builtin_nontemporal_load(s4 + qq * 64); }
#pragma unroll
        for (int q = 0; q < CHUNK_OPS; ++q) { const int qq = q < nops ? q : nops - 1; __builtin_nontemporal_store(v[q], d4 + qq * 64); }
        if (done_word >= 0 && (unsigned)__builtin_amdgcn_readfirstlane((int)__hip_atomic_load(ctl + done_word, RLX_AGENT)) >= done_target) break;
    }
}

#ifdef PROBE_COPYX2
__device__ __forceinline__ void side_copy2(const Args& A, gu32* ctl, int lane) {
    for (;;) {
        unsigned id = 0; if (lane == 0) id = __hip_atomic_fetch_add(ctl + CW_CUR + 64 * 20, 1u, RLX_AGENT); id = (unsigned)__builtin_amdgcn_readfirstlane((int)id);
        if (id >= (unsigned)NCHUNKS) break;
        const int buf = (int)(id >> 7), sub = (int)(id & 127), op0 = sub * CHUNK_OPS, nops = (OPS_PER_BUF - op0) < CHUNK_OPS ? (OPS_PER_BUF - op0) : CHUNK_OPS;
        const GAS f32x4* s4 = (const GAS f32x4*)(A.in[2 + (buf >> 7)] + (size_t)(buf & 127) * LA * 512 + 512) + (size_t)op0 * 64 + lane;
        GAS f32x4* d4 = (GAS f32x4*)(A.out + ((buf >> 7) ? O_AVS : O_AKS) + (size_t)(buf & 127) * LA * 512) + (size_t)op0 * 64 + lane;
        f32x4 v[CHUNK_OPS];
#pragma unroll
        for (int q = 0; q < CHUNK_OPS; ++q) { const int qq = q < nops ? q : nops - 1; v[q] = __builtin_nontemporal_load(s4 + qq * 64); }
#pragma unroll
        for (int q = 0; q < CHUNK_OPS; ++q) { const int qq = q < nops ? q : nops - 1; __builtin_nontemporal_store(v[q], d4 + qq * 64); }
    }
}
#endif
template <int MODE, int NSPLIT> __device__ __forceinline__ void norm_phase(Frame& F, const Args& A, const float* gpost, float coef) {
    unsigned char* ws = A.ws;
    const bf16* Y = (const bf16*)(ws + WS_Y); bf16* XB = (bf16*)(ws + WS_XB); float* RS = (float*)(ws + WS_RS);
    const float* SL = (const float*)(ws + WS_SLAB); const bf16* PP = (const bf16*)(ws + WS_PP);
    int lane_ = F.lane; asm volatile("" : "+v"(lane_));
    const int gw = F.vcu * NWAVES + F.wave, NGW = F.G * NWAVES, lane = lane_;
    f32x4 g[4];
#pragma unroll
    for (int j = 0; j < 4; ++j) g[j] = *((const GAS f32x4*)gpost + lane + 64 * j) * coef;
    for (int m = gw; m < MR; m += NGW) {
        const float* hsrc = (m < MP) ? A.in[0] + (size_t)m * D : A.in[1] + (size_t)(m - MP) * D;
        float* hdst = (m < MP) ? A.out + O_YP + (size_t)m * D : A.out + O_YS + (size_t)(m - MP) * D;
        f32x4 y[4], h[4]; float s = 0.f;
        if (m < MP) {
            const GAS unsigned long long* y8 = (const GAS unsigned long long*)(Y + (size_t)m * D) + lane;
#pragma unroll
            for (int j = 0; j < 4; ++j) { const unsigned long long w = y8[64 * j]; const unsigned lo = (unsigned)w, hi = (unsigned)(w >> 32);
                y[j] = (f32x4){bf_lo(lo), bf_hi(lo), bf_lo(hi), bf_hi(hi)}; }
        } else {
#pragma unroll
            for (int j = 0; j < 4; ++j) y[j] = (f32x4){0.f, 0.f, 0.f, 0.f};
#pragma unroll 1
            for (int ks = 0; ks < NSPLIT; ++ks) { const GAS f32x4* sp = (const GAS f32x4*)(SL + ((size_t)ks * 128 + (m - MP)) * D) + lane;
#pragma unroll
                for (int j = 0; j < 4; ++j) y[j] = y[j] + sp[64 * j]; }
            if (MODE == 2) { const float r = RS[m]; const GAS unsigned long long* p8 = (const GAS unsigned long long*)(PP + (size_t)m * D) + lane;
#pragma unroll
                for (int j = 0; j < 4; ++j) { const unsigned long long w = p8[64 * j]; const unsigned lo = (unsigned)w, hi = (unsigned)(w >> 32);
                    const f32x4 pp = (f32x4){bf_lo(lo), bf_hi(lo), bf_lo(hi), bf_hi(hi)};
                    y[j].x = pp.x / (1.0f + __expf(-r * y[j].x)); y[j].y = pp.y / (1.0f + __expf(-r * y[j].y)); y[j].z = pp.z / (1.0f + __expf(-r * y[j].z)); y[j].w = pp.w / (1.0f + __expf(-r * y[j].w)); } }
        }
#pragma unroll
        for (int j = 0; j < 4; ++j) { s += (y[j].x * y[j].x + y[j].y * y[j].y) + (y[j].z * y[j].z + y[j].w * y[j].w);
            if (MODE == 0) h[j] = *((const GAS f32x4*)hsrc + lane + 64 * j);
            else { const unsigned long long w = *((const GAS unsigned long long*)(XB + (size_t)m * D) + lane + 64 * j); const unsigned lo = (unsigned)w, hi = (unsigned)(w >> 32);
                h[j] = (f32x4){bf_lo(lo), bf_hi(lo), bf_lo(hi), bf_hi(hi)}; } }
        const float rstd = 1.0f / sqrtf(wave_sum(s) * (1.0f / D) + EPS);
        float s2 = 0.f;
#pragma unroll
        for (int j = 0; j < 4; ++j) { h[j] = h[j] + g[j] * (y[j] * rstd); s2 += (h[j].x * h[j].x + h[j].y * h[j].y) + (h[j].z * h[j].z + h[j].w * h[j].w);
            if (MODE == 2) *((GAS f32x4*)hdst + lane + 64 * j) = h[j]; }
        if (MODE != 2) {
            s2 = wave_sum(s2);
            GAS unsigned long long* o8 = (GAS unsigned long long*)(XB + (size_t)m * D) + lane;
#pragma unroll
            for (int j = 0; j < 4; ++j) o8[64 * j] = (unsigned long long)pk2(h[j].x, h[j].y) | ((unsigned long long)pk2(h[j].z, h[j].w) << 32);
            if (lane == 0) RS[m] = 1.0f / sqrtf(s2 * (1.0f / D) + EPS);
        }
    }
}

__device__ __forceinline__ int crow(int r, int hi) { return (r & 3) + 8 * (r >> 2) + 4 * hi; }
__device__ __forceinline__ unsigned cvtpk(float lo, float hi) { unsigned r; asm volatile("v_cvt_pk_bf16_f32 %0, %1, %2" : "=v"(r) : "v"(lo), "v"(hi)); return r; }
__device__ __forceinline__ float xhalf_max(float v) { return fmaxf(v, __shfl_xor(v, 32)); }
__device__ __forceinline__ float xhalf_sum(float v) { return v + __shfl_xor(v, 32); }
__device__ __forceinline__ s16x4 vtr(const LAS unsigned char* p) { typedef short v4i16_t __attribute__((ext_vector_type(4))); return __builtin_bit_cast(s16x4, __builtin_amdgcn_ds_read_tr16_b64_v4i16((LAS v4i16_t*)p)); }

template <int MODE> __device__ __forceinline__ void attn_task(const bf16* QKV, int b, int qcol, int kcol, int vcol, int tq0_, int dil, LAS unsigned char* vt, int lane,
                                                              bf16* OP, float* LS, int head, float sinkl, const bf16* OP2, const bf16* OP3, const float* LS2, const float* LS3, bf16* ATT, int acol) {
    int tq0 = tq0_; asm volatile("" : "+s"(tq0));
    const int r32 = lane & 31, hi = lane >> 5;
    const GAS unsigned char* qb = (const GAS unsigned char*)QKV;
    const unsigned rowb = (unsigned)b * SEQ;
    bf16x8 qf[4];
    { const unsigned qo = ((rowb + tq0 + dil * r32) * NIN + qcol + hi * 32) * 2u;
#pragma unroll
      for (int d0 = 0; d0 < 4; ++d0) qf[d0] = *(const GAS bf16x8*)(qb + qo + d0 * 16); }
    float m_run = (MODE == 2) ? sinkl : -INFINITY, l_run = (MODE == 2) ? 1.0f : 0.0f;
    f32x16 o0 = {}, o1 = {};
    const int sq0 = tq0 / dil; int j0 = (128 - sq0) / 32; j0 = j0 < 0 ? 0 : j0;
    const int tk_base = tq0 - 128 * dil;
    const int g = lane >> 4, tq = (lane & 15) >> 2, tp = lane & 3;
    const int trow = 4 * (g >> 1) + tq, tsw = ((trow >> 1) & 1) << 6, tcol = 32 * (g & 1) + 8 * tp;
    const LAS unsigned char* ta0 = vt + trow * 128 + ((0 ^ tsw) + tcol);
    const LAS unsigned char* ta1 = vt + trow * 128 + ((64 ^ tsw) + tcol);
    const int vkey = lane >> 3, vch = lane & 7;
    const unsigned kstep = (unsigned)(32 * dil * NIN * 2), vustep = (unsigned)(8 * dil * NIN * 2);
    unsigned ko = ((rowb + tk_base + 32 * dil * j0 + dil * r32) * NIN + kcol + hi * 32) * 2u;
    unsigned vo = ((rowb + tk_base + 32 * dil * j0 + dil * vkey) * NIN + vcol + vch * 8) * 2u;
    bf16x8 kf[4], vf[4];
#pragma unroll
    for (int d0 = 0; d0 < 4; ++d0) kf[d0] = *(const GAS bf16x8*)(qb + ko + d0 * 16);
#pragma unroll
    for (int u = 0; u < 4; ++u) vf[u] = *(const GAS bf16x8*)(qb + vo + u * vustep);
#pragma unroll 1
    for (int j = j0; j < 5; ++j) {
        f32x16 s = {};
#pragma unroll
        for (int d0 = 0; d0 < 4; ++d0) s = __builtin_amdgcn_mfma_f32_32x32x16_bf16(kf[d0], qf[d0], s, 0, 0, 0);
#pragma unroll
        for (int u = 0; u < 4; ++u) { const int key = 8 * u + vkey; *(LAS bf16x8*)(vt + key * 128 + ((vch * 16) ^ (((key >> 1) & 1) << 6))) = vf[u]; }
        if (j < 4) { ko += kstep; vo += kstep; }
#pragma unroll
        for (int d0 = 0; d0 < 4; ++d0) kf[d0] = *(const GAS bf16x8*)(qb + ko + d0 * 16);
#pragma unroll
        for (int u = 0; u < 4; ++u) vf[u] = *(const GAS bf16x8*)(qb + vo + u * vustep);
        if (j == 0 || j == 4) {
            int qrel = r32 - 4 * hi; asm volatile("" : "+v"(qrel));
            if (j == 0) {
#pragma unroll
                for (int r = 0; r < 16; ++r) s[r] = ((r & 3) + 8 * (r >> 2) < qrel) ? -INFINITY : s[r];
            } else {
#pragma unroll
                for (int r = 0; r < 16; ++r) s[r] = ((r & 3) + 8 * (r >> 2) > qrel) ? -INFINITY : s[r];
            }
        }
        float mx = s[0];
#pragma unroll
        for (int r = 1; r < 16; ++r) mx = fmaxf(mx, s[r]);
        mx = xhalf_max(mx);
        const float m_new = fmaxf(m_run, mx);
        const float alpha = __builtin_amdgcn_exp2f(m_run - m_new);
        float rs = 0.f;
#pragma unroll
        for (int r = 0; r < 16; ++r) { s[r] = __builtin_amdgcn_exp2f(s[r] - m_new); rs += s[r]; }
        rs = xhalf_sum(rs);
        l_run = l_run * alpha + rs; m_run = m_new;
#pragma unroll
        for (int r = 0; r < 16; ++r) { o0[r] *= alpha; o1[r] *= alpha; }
        bf16x8 pk[2];
#pragma unroll
        for (int sl = 0; sl < 2; ++sl) { v4u w; w.x = cvtpk(s[8 * sl + 0], s[8 * sl + 1]); w.y = cvtpk(s[8 * sl + 2], s[8 * sl + 3]); w.z = cvtpk(s[8 * sl + 4], s[8 * sl + 5]); w.w = cvtpk(s[8 * sl + 6], s[8 * sl + 7]);
            pk[sl] = __builtin_bit_cast(bf16x8, w); }
#pragma unroll
        for (int sl = 0; sl < 2; ++sl) {
            const s16x4 a_lo = vtr(ta0 + 2048 * sl), a_hi = vtr(ta0 + 2048 * sl + 1024);
            const s16x4 b_lo = vtr(ta1 + 2048 * sl), b_hi = vtr(ta1 + 2048 * sl + 1024);
            const bf16x8 va = (bf16x8){a_lo[0], a_lo[1], a_lo[2], a_lo[3], a_hi[0], a_hi[1], a_hi[2], a_hi[3]};
            const bf16x8 vb = (bf16x8){b_lo[0], b_lo[1], b_lo[2], b_lo[3], b_hi[0], b_hi[1], b_hi[2], b_hi[3]};
            o0 = __builtin_amdgcn_mfma_f32_32x32x16_bf16(va, pk[sl], o0, 0, 0, 0);
            o1 = __builtin_amdgcn_mfma_f32_32x32x16_bf16(vb, pk[sl], o1, 0, 0, 0);
        }
    }
    const size_t qrow = (size_t)(rowb + tq0 + dil * r32);
    if (MODE == 0) {
        const float inv = 1.0f / l_run;
        bf16* op = OP + qrow * 512 + head * 64 + 4 * hi;
#pragma unroll
        for (int a = 0; a < 4; ++a) {
            u32x2g w0, w1; w0.x = cvtpk(o0[4 * a] * inv, o0[4 * a + 1] * inv); w0.y = cvtpk(o0[4 * a + 2] * inv, o0[4 * a + 3] * inv);
            w1.x = cvtpk(o1[4 * a] * inv, o1[4 * a + 1] * inv); w1.y = cvtpk(o1[4 * a + 2] * inv, o1[4 * a + 3] * inv);
            *(GAS u32x2g*)(op + 8 * a) = w0; *(GAS u32x2g*)(op + 32 + 8 * a) = w1; }
        if (hi == 0) LS[qrow * 8 + head] = m_run + __builtin_amdgcn_logf(l_run);
    } else if (MODE == 1) {
        const float l2 = LS2[qrow * 8 + head], l3 = LS3[qrow * 8 + head];
        const float M = fmaxf(m_run, fmaxf(l2, l3));
        const float w1 = __builtin_amdgcn_exp2f(m_run - M), w2 = __builtin_amdgcn_exp2f(l2 - M), w3 = __builtin_amdgcn_exp2f(l3 - M);
        const float inv = 1.0f / (l_run * w1 + w2 + w3);
        const float c1 = w1 * inv, c2 = w2 * inv, c3 = w3 * inv;
        const bf16* p2 = OP2 + qrow * 512 + head * 64 + 4 * hi; const bf16* p3 = OP3 + qrow * 512 + head * 64 + 4 * hi;
        bf16* op = ATT + qrow * D + acol + 4 * hi;
#pragma unroll
        for (int a = 0; a < 4; ++a) {
            const u32x2g a2 = *(const GAS u32x2g*)(p2 + 8 * a), b2 = *(const GAS u32x2g*)(p2 + 32 + 8 * a), a3 = *(const GAS u32x2g*)(p3 + 8 * a), b3 = *(const GAS u32x2g*)(p3 + 32 + 8 * a);
            float x0[4], x1[4];
            x0[0] = o0[4 * a] * c1 + bf_lo(a2.x) * c2 + bf_lo(a3.x) * c3; x0[1] = o0[4 * a + 1] * c1 + bf_hi(a2.x) * c2 + bf_hi(a3.x) * c3;
            x0[2] = o0[4 * a + 2] * c1 + bf_lo(a2.y) * c2 + bf_lo(a3.y) * c3; x0[3] = o0[4 * a + 3] * c1 + bf_hi(a2.y) * c2 + bf_hi(a3.y) * c3;
            x1[0] = o1[4 * a] * c1 + bf_lo(b2.x) * c2 + bf_lo(b3.x) * c3; x1[1] = o1[4 * a + 1] * c1 + bf_hi(b2.x) * c2 + bf_hi(b3.x) * c3;
            x1[2] = o1[4 * a + 2] * c1 + bf_lo(b2.y) * c2 + bf_lo(b3.y) * c3; x1[3] = o1[4 * a + 3] * c1 + bf_hi(b2.y) * c2 + bf_hi(b3.y) * c3;
            u32x2g w0, w1v; w0.x = cvtpk(x0[0], x0[1]); w0.y = cvtpk(x0[2], x0[3]); w1v.x = cvtpk(x1[0], x1[1]); w1v.y = cvtpk(x1[2], x1[3]);
            *(GAS u32x2g*)(op + 8 * a) = w0; *(GAS u32x2g*)(op + 32 + 8 * a) = w1v; }
    } else {
        const float inv = 1.0f / l_run;
        bf16* op = ATT + qrow * D + acol + 4 * hi;
#pragma unroll
        for (int a = 0; a < 4; ++a) {
            u32x2g w0, w1; w0.x = cvtpk(o0[4 * a] * inv, o0[4 * a + 1] * inv); w0.y = cvtpk(o0[4 * a + 2] * inv, o0[4 * a + 3] * inv);
            w1.x = cvtpk(o1[4 * a] * inv, o1[4 * a + 1] * inv); w1.y = cvtpk(o1[4 * a + 2] * inv, o1[4 * a + 3] * inv);
            *(GAS u32x2g*)(op + 8 * a) = w0; *(GAS u32x2g*)(op + 32 + 8 * a) = w1; }
    }
}

struct SPart { float m, l; f32x4 o; };
__device__ __forceinline__ void sample_scan(const float* kbase, const float* vbase, const float* knew, const float* vnew, int L, int rstride, int dil, const f32x4 q4, int lane, float& m_run, float& l_run, f32x4& o4) {
    const int sub = lane & 15, ks = lane >> 4;
#pragma unroll 4
    for (int st = 0; st < 33; ++st) {
        const int k = 4 * st + ks; const bool valid = k <= 128; const int idx = L - dil * (valid ? k : 128);
        const float* kp = (idx == L) ? knew : kbase + (size_t)idx * rstride; const float* vp = (idx == L) ? vnew : vbase + (size_t)idx * rstride;
        const f32x4 k4 = *((const GAS f32x4*)kp + sub), v4 = *((const GAS f32x4*)vp + sub);
        float s = (k4.x * q4.x + k4.y * q4.y) + (k4.z * q4.z + k4.w * q4.w);
        s += __shfl_xor(s, 1); s += __shfl_xor(s, 2); s += __shfl_xor(s, 4); s += __shfl_xor(s, 8);
        if (!valid) s = -INFINITY;
        const float m_new = fmaxf(m_run, s); const float alpha = __builtin_amdgcn_exp2f(m_run - m_new), p = __builtin_amdgcn_exp2f(s - m_new);
        l_run = l_run * alpha + p; o4 = o4 * alpha + v4 * p; m_run = m_new;
    }
}
__device__ __forceinline__ void sample_merge4(float& m_run, float& l_run, f32x4& o4) {
#pragma unroll
    for (int x = 16; x <= 32; x <<= 1) {
        const float mo = __shfl_xor(m_run, x), lo = __shfl_xor(l_run, x);
        f32x4 oo; oo.x = __shfl_xor(o4.x, x); oo.y = __shfl_xor(o4.y, x); oo.z = __shfl_xor(o4.z, x); oo.w = __shfl_xor(o4.w, x);
        const float M = fmaxf(m_run, mo), a = __builtin_amdgcn_exp2f(m_run - M), c = __builtin_amdgcn_exp2f(mo - M);
        l_run = l_run * a + lo * c; o4 = o4 * a + oo * c; m_run = M;
    }
}

__device__ __forceinline__ void attention_phase(Frame& F, const Args& A) {
    unsigned char* ws = A.ws;
    const bf16* QKV = (const bf16*)(ws + WS_QKV); bf16* ATT = (bf16*)(ws + WS_ATT);
    bf16* OP2 = (bf16*)(ws + WS_OP2); bf16* OP3 = (bf16*)(ws + WS_OP3); float* LS2 = (float*)(ws + WS_LS2); float* LS3 = (float*)(ws + WS_LS3);
    const int lane = F.lane, w = F.wave;
    LAS unsigned char* vt = F.lds + RING_OFF + w * 4096;
    LAS float* spart = (LAS float*)(F.lds + RING_OFF + 32768);
    const float* sinks = A.in[16];
    for (int u = F.vcu; u < 256; u += F.G) {
        const int b = u >> 7, h = (u >> 4) & 7, T0 = (u & 15) * 512;
#pragma unroll 1
        for (int k = 0; k < 2; ++k) attn_task<0>(QKV, b, 64 * h, 512 + 64 * h, 1024 + 64 * h, T0 + 2 * w + k, 16, vt, lane, OP3, LS3, h, 0.f, nullptr, nullptr, nullptr, nullptr, nullptr, 0);
#pragma unroll 1
        for (int k = 0; k < 2; ++k) { const int task = 2 * w + k; attn_task<0>(QKV, b, 64 * h, 512 + 64 * h, 1024 + 64 * h, T0 + 128 * (task >> 2) + (task & 3), 4, vt, lane, OP2, LS2, h, 0.f, nullptr, nullptr, nullptr, nullptr, nullptr, 0); }
#pragma unroll 1
        for (int k = 0; k < 2; ++k) attn_task<2>(QKV, b, 1536 + 64 * h, 2048 + 64 * (h >> 2), 2176 + 64 * (h >> 2), T0 + 32 * (2 * w + k), 1, vt, lane, nullptr, nullptr, h, sinks[h] * 1.4426950408889634f, nullptr, nullptr, nullptr, nullptr, ATT, 512 + 64 * h);
        if (u < 256) {
#pragma unroll 1
            for (int k = 0; k < 2; ++k) { const int task = w + 8 * k;
                const int sub = lane & 15;
                if (task < 12) {
                    const int pair = 4 * u + task / 3, pat = task % 3, sb = pair >> 3, sh = pair & 7, dil = pat == 0 ? 1 : (pat == 1 ? 4 : 16);
                    const bf16* qp = QKV + (size_t)(MP + sb) * NIN + 64 * sh + 4 * sub; const unsigned long long qw = *(const GAS unsigned long long*)qp;
                    const f32x4 q4 = (f32x4){bf_lo((unsigned)qw), bf_hi((unsigned)qw), bf_lo((unsigned)(qw >> 32)), bf_hi((unsigned)(qw >> 32))};
                    float m_run = -INFINITY, l_run = 0.f; f32x4 o4 = {0.f, 0.f, 0.f, 0.f};
                    sample_scan(A.in[2] + ((size_t)sb * LA * 8 + sh) * 64, A.in[3] + ((size_t)sb * LA * 8 + sh) * 64,
                                A.out + O_AKS + ((size_t)(sb * LA + LA - 1) * 8 + sh) * 64, A.out + O_AVS + ((size_t)(sb * LA + LA - 1) * 8 + sh) * 64, LA, 512, dil, q4, lane, m_run, l_run, o4);
                    sample_merge4(m_run, l_run, o4);
                    if (lane < 16) { LAS float* sp = spart + (task * 16 + sub) * 6; sp[0] = m_run; sp[1] = l_run; sp[2] = o4.x; sp[3] = o4.y; sp[4] = o4.z; sp[5] = o4.w; }
                } else {
                    const int pair = 4 * u + (task - 12), sb = pair >> 3, sh = pair & 7, kv = sh >> 2;
                    const bf16* qp = QKV + (size_t)(MP + sb) * NIN + 1536 + 64 * sh + 4 * sub; const unsigned long long qw = *(const GAS unsigned long long*)qp;
                    const f32x4 q4 = (f32x4){bf_lo((unsigned)qw), bf_hi((unsigned)qw), bf_lo((unsigned)(qw >> 32)), bf_hi((unsigned)(qw >> 32))};
                    float m_run = (lane < 16) ? sinks[sh] * 1.4426950408889634f : -INFINITY, l_run = (lane < 16) ? 1.0f : 0.f; f32x4 o4 = {0.f, 0.f, 0.f, 0.f};
                    sample_scan(A.in[4] + ((size_t)sb * LB * 2 + kv) * 64, A.in[5] + ((size_t)sb * LB * 2 + kv) * 64,
                                A.out + O_BKS + ((size_t)(sb * LB + LB - 1) * 2 + kv) * 64, A.out + O_BVS + ((size_t)(sb * LB + LB - 1) * 2 + kv) * 64, LB, 128, 1, q4, lane, m_run, l_run, o4);
                    sample_merge4(m_run, l_run, o4);
                    if (lane < 16) { const float inv = 1.0f / l_run; bf16* op = ATT + (size_t)(MP + sb) * D + 512 + 64 * sh + 4 * sub;
                        *(GAS unsigned long long*)op = (unsigned long long)cvtpk(o4.x * inv, o4.y * inv) | ((unsigned long long)cvtpk(o4.z * inv, o4.w * inv) << 32); }
                }
            }
        }
        __builtin_amdgcn_fence(__ATOMIC_RELEASE, "workgroup"); __syncthreads(); __builtin_amdgcn_fence(__ATOMIC_ACQUIRE, "workgroup");
#pragma unroll 1
        for (int k = 0; k < 2; ++k) attn_task<1>(QKV, b, 64 * h, 512 + 64 * h, 1024 + 64 * h, T0 + 32 * (2 * w + k), 1, vt, lane, nullptr, nullptr, h, 0.f, OP2, OP3, LS2, LS3, ATT, 64 * h);
        if (w < 4 && lane < 16) {
            const int pair = 4 * u + w, sb = pair >> 3, sh = pair & 7, sub = lane;
            float m_run = -INFINITY, l_run = 0.f; f32x4 o4 = {0.f, 0.f, 0.f, 0.f};
#pragma unroll
            for (int p = 0; p < 3; ++p) { const LAS float* sp = spart + ((3 * w + p) * 16 + sub) * 6; const float mo = sp[0], lo = sp[1]; const f32x4 oo = (f32x4){sp[2], sp[3], sp[4], sp[5]};
                const float M = fmaxf(m_run, mo), a = __builtin_amdgcn_exp2f(m_run - M), c = __builtin_amdgcn_exp2f(mo - M);
                l_run = l_run * a + lo * c; o4 = o4 * a + oo * c; m_run = M; }
            const float inv = 1.0f / l_run; bf16* op = ATT + (size_t)(MP + sb) * D + 64 * sh + 4 * sub;
            *(GAS unsigned long long*)op = (unsigned long long)cvtpk(o4.x * inv, o4.y * inv) | ((unsigned long long)cvtpk(o4.z * inv, o4.w * inv) << 32);
        }
        __syncthreads();
    }
}

__global__ void __launch_bounds__(NWAVES * 64, 2) fwd_kernel(Args args) {
    extern __shared__ __attribute__((aligned(16))) unsigned char lds[];
    Frame F;
    F.lds = (LAS unsigned char*)lds;
    F.MISC = (volatile LAS unsigned*)(F.lds + MISC_OFF);
    F.tid = threadIdx.x; F.lane = F.tid & 63; F.wave = __builtin_amdgcn_readfirstlane(F.tid >> 6);
    F.G = gridDim.x; { const int bx = blockIdx.x; F.vcu = (F.G % 8 == 0) ? (bx % 8) * (F.G / 8) + bx / 8 : bx; }
    F.ctl = (gu32*)(args.ws + WS_CTL);
    for (int u = F.tid; u < (LDS_BYTES - LDSCTL_OFF) / 4; u += NWAVES * 64) ((LAS unsigned*)(F.lds + LDSCTL_OFF))[u] = 0u;
    __syncthreads();
    XcdBarrier bar = xcd_barrier_post((unsigned*)(F.ctl + CW_BAR), F.MISC + 8);
#define GRID_BAR() xcd_barrier(bar)

#define XB ((bf16*)(args.ws + WS_XB))
#define RS ((float*)(args.ws + WS_RS))
#define ACT ((bf16*)(args.ws + WS_ACT))
#define Y ((bf16*)(args.ws + WS_Y))
#define QKV ((bf16*)(args.ws + WS_QKV))
#define ATT ((bf16*)(args.ws + WS_ATT))
#define PB ((bf16*)(args.ws + WS_PB))
#define PP ((bf16*)(args.ws + WS_PP))

    const int cpair = (int)blockIdx.x < 256 ? (int)blockIdx.x : 255;
    F.copy_cur = (int)blockIdx.x < 256 ? 0 : 4094;
#define COPY_SRC ((const unsigned char*)(args.in[2 + (cpair >> 7)] + (size_t)(cpair & 127) * LA * 512 + 512))
#define COPY_DST ((unsigned char*)(args.out + ((cpair >> 7) ? O_AVS : O_AKS) + (size_t)(cpair & 127) * LA * 512))
#define GEMM_PHASE(EPI, NG_, A_, B_, N_, K_, NSPLIT_, ...) do { pg8::Gemm g{A_, (const bf16*)(args.ws + B_), MT, N_, K_}; pg8::SampleOrder S; S.init(MP, N_, K_, NSPLIT_, NG_, (int)blockIdx.x); \
      pg8::EPI E{__VA_ARGS__}; pg8::StreamCopy4 C; C.src = COPY_SRC; C.dst = COPY_DST; C.cur = F.copy_cur; C.tw = F.wave & 3; C.last = 4093; C.lane_off = (unsigned)F.lane * 16u; \
      pg8::gemm_phase_rs<pg8::EPI, pg8::SampleOrder>(F.lds + RING_OFF, g, S, E, C); F.copy_cur = C.cur; } while (0)
    const int NG1 = F.G, NG3 = F.G;
#define SIGNAL_DONE(k) do { if (F.tid == 0) __hip_atomic_fetch_add(F.ctl + CW_DONE + 64 * (k), 1u, RLX_AGENT); } while (0)

#ifndef SKIP_P0
    p0_prologue(F, args);
#endif
#ifdef PROBE_P0X2
    GRID_BAR();
    p0_prologue(F, args);
#endif
    GRID_BAR();
#ifndef SKIP_P1
    if ((int)blockIdx.x < NG1) { GEMM_PHASE(EpiSwiGLU, NG1, XB, WS_WGU1, 2 * FF, D, 1, ACT, FF, RS); SIGNAL_DONE(0); }
#endif
    GRID_BAR();
#ifdef PROBE_P1X2
    GEMM_PHASE(EpiSwiGLU, F.G, XB, WS_WGU1, 2 * FF, D, 1, ACT, FF, RS);
    GRID_BAR();
#endif
#ifdef PROBE_P2X2
    GEMM_PHASE(EpiPlain, F.G, ACT, WS_WD1, D, FF, 11, Y, D, (float*)(args.ws + WS_SLAB));
    GRID_BAR();
#endif
#ifndef SKIP_P2
    GEMM_PHASE(EpiPlain, F.G, ACT, WS_WD1, D, FF, 11, Y, D, (float*)(args.ws + WS_SLAB));
#endif
    GRID_BAR();
#ifndef SKIP_NORM
    norm_phase<0, 11>(F, args, args.in[9], 0.5f);
#endif
    GRID_BAR();
#ifndef SKIP_P3
    if ((int)blockIdx.x < NG3) {
        GEMM_PHASE(EpiRope, NG3, XB, WS_WIN, NIN, D, 1, QKV, RS, (const float*)(args.ws + WS_ROPE), args.out);
        GEMM_PHASE(EpiPlain, NG3, PB, WS_WPP, D, DPLE, 1, PP, D, nullptr);
        SIGNAL_DONE(1);
    }
#endif
    GRID_BAR();
#ifndef SKIP_P4
    attention_phase(F, args);
#endif
    GRID_BAR();
#ifndef SKIP_P5
    GEMM_PHASE(EpiPlain, F.G, ATT, WS_WOUT, D, D, 4, Y, D, (float*)(args.ws + WS_SLAB));
#endif
    GRID_BAR();
#ifndef SKIP_NORM
    norm_phase<1, 4>(F, args, args.in[14], 1.0f);
#endif
    GRID_BAR();
#ifndef SKIP_P6
    if ((int)blockIdx.x < NG1) { GEMM_PHASE(EpiSwiGLU, NG1, XB, WS_WGU2, 2 * FF, D, 1, ACT, FF, RS); SIGNAL_DONE(2); }
#endif
    GRID_BAR();
#ifndef SKIP_P7
    GEMM_PHASE(EpiPlain, F.G, ACT, WS_WD2, D, FF, 11, Y, D, (float*)(args.ws + WS_SLAB));
#endif
    GRID_BAR();
#ifndef SKIP_NORM
    norm_phase<1, 11>(F, args, args.in[19], 0.5f);
#endif
    GRID_BAR();
#ifndef SKIP_P8
    GEMM_PHASE(EpiPle, F.G, XB, WS_WPG, D, D, 4, Y, D, RS, PP, (float*)(args.ws + WS_SLAB));
#endif
    for (int pair = (int)blockIdx.x; pair < 256; pair += F.G) {
        const GAS f32x4* s4 = (const GAS f32x4*)(args.in[2 + (pair >> 7)] + (size_t)(pair & 127) * LA * 512 + 512) + F.lane; GAS f32x4* d4 = (GAS f32x4*)(args.out + ((pair >> 7) ? O_AVS : O_AKS) + (size_t)(pair & 127) * LA * 512) + F.lane;
        int c = (pair == (int)blockIdx.x ? F.copy_cur : 0) + F.wave;
        for (; c + 7 * NWAVES < 4094; c += 8 * NWAVES) { f32x4 v[8];
#pragma unroll
            for (int q = 0; q < 8; ++q) v[q] = __builtin_nontemporal_load(s4 + (c + q * NWAVES) * 64);
#pragma unroll
            for (int q = 0; q < 8; ++q) __builtin_nontemporal_store(v[q], d4 + (c + q * NWAVES) * 64); }
        for (; c < 4094; c += NWAVES) { const f32x4 v = __builtin_nontemporal_load(s4 + c * 64); __builtin_nontemporal_store(v, d4 + c * 64); }
    }
    GRID_BAR();
#ifndef SKIP_NORM
    norm_phase<2, 4>(F, args, args.in[24], 1.0f);
#endif
#ifdef PROBE_NORMFX2
    GRID_BAR();
    norm_phase<2, 4>(F, args, args.in[24], 1.0f);
#endif
#undef GEMM_PHASE
#undef COPY_SRC
#undef COPY_DST
#undef SIGNAL_DONE
#undef GRID_BAR
#undef XB
#undef RS
#undef ACT
#undef Y
#undef QKV
#undef ATT
#undef PB
#undef PP
}

extern "C" void kernel_launch(void* const* d_in, const int* in_sizes, int n_in, void* d_out, int out_size, void* d_ws, size_t ws_size, hipStream_t stream) {
    static int grid = 0;
    if (grid == 0) {
        if (n_in != 27 || (size_t)out_size != O_END || ws_size < WS_END) { fprintf(stderr, "kernel_launch: unexpected shapes (n_in %d, out %d, ws %zu); nothing launched\n", n_in, out_size, ws_size); grid = -1; return; }
        int dev = 0, cus = 0, per_cu = 0;
        if (hipGetDevice(&dev) != hipSuccess || hipDeviceGetAttribute(&cus, hipDeviceAttributeMultiprocessorCount, dev) != hipSuccess) { grid = -1; return; }
        if (hipFuncSetAttribute((const void*)fwd_kernel, hipFuncAttributeMaxDynamicSharedMemorySize, LDS_BYTES) != hipSuccess) { fprintf(stderr, "kernel_launch: hipFuncSetAttribute failed\n"); grid = -1; return; }
        if (hipOccupancyMaxActiveBlocksPerMultiprocessor(&per_cu, (const void*)fwd_kernel, NWAVES * 64, LDS_BYTES) != hipSuccess || per_cu < 1) { fprintf(stderr, "kernel_launch: occupancy query says %d blocks per CU\n", per_cu); per_cu = 1; }
        (void)hipGetLastError();
        grid = cus;
    }
    if (grid < 0) return;
    if (hipMemsetAsync((char*)d_ws + WS_CTL, 0, CTL_ZERO_BYTES, stream) != hipSuccess) return;
    Args a{};
    for (int i = 0; i < 27; ++i) a.in[i] = (const float*)d_in[i];
    a.out = (float*)d_out; a.ws = (unsigned char*)d_ws;
    hipLaunchKernelGGL(fwd_kernel, dim3(grid), dim3(NWAVES * 64), LDS_BYTES, stream, a);
}
```

```cpp
#include <hip/hip_runtime.h>
#include <cstdio>
#include <cstdint>
#include <cmath>

#ifndef PG8_SP2
#define PG8_SP2 true
#endif
#ifndef PG8_ALIGN
#define PG8_ALIGN true
#endif
constexpr int NWAVES = 8;
constexpr int D = 1024, FF = 2816, NIN = 2304, DPLE = 256, SEQ = 8192, NB = 2;
constexpr int MP = NB * SEQ;
constexpr int MS = 128;
constexpr int MR = MP + MS;
constexpr int MT = 65 * 256;
constexpr int LA = 2048, LB = 128, PAST = 16384;
constexpr float EPS = 1e-6f;
constexpr float QSCALE = 0.125f * 1.4426950408889634f;

constexpr size_t O_YP = 0, O_YS = O_YP + (size_t)MP * D, O_AKP = O_YS + (size_t)MS * D, O_AVP = O_AKP + (size_t)NB * 2048 * 512,
    O_BKP = O_AVP + (size_t)NB * 2048 * 512, O_BVP = O_BKP + (size_t)NB * 128 * 128, O_AKS = O_BVP + (size_t)NB * 128 * 128,
    O_AVS = O_AKS + (size_t)MS * LA * 512, O_BKS = O_AVS + (size_t)MS * LA * 512, O_BVS = O_BKS + (size_t)MS * LB * 128, O_END = O_BVS + (size_t)MS * LB * 128;
static_assert(O_END == 293797888ull, "output size");

namespace pg8 {
#define PG8_LAS __attribute__((address_space(3)))
typedef unsigned short bf16_t;
typedef short bf16x8 __attribute__((ext_vector_type(8)));
typedef float f32x4 __attribute__((ext_vector_type(4)));
typedef unsigned u32x4 __attribute__((ext_vector_type(4)));
constexpr int BM = 256, BK = 64, HALF = 128, HTB = HALF * BK * 2  , STAGE_BYTES = 8 * HTB, NXCD = 8, WGM = 8;

__host__ __device__ __forceinline__ int lds_byte(int r, int c) { const int st = (r >> 4) * 2 + (c >> 5), rr = r & 15, cc = c & 31, ob = rr * 64 + cc * 2; return st * 1024 + (ob ^ (((ob >> 9) & 1) << 5)); }
__host__ __device__ __forceinline__ void stage_rc(int b, int& R, int& C) { const int st = b / 1024, sb = b % 1024, swz = sb ^ (((sb >> 9) & 1) << 5); R = (st >> 1) * 16 + swz / 64; C = (st & 1) * 32 + (swz % 64) / 2; }
__host__ __device__ __forceinline__ int perm32(int rho) { const int n = rho >> 4, i = rho & 15; return 8 * (i >> 2) + 4 * n + (i & 3); }

struct Unit { int pm, pn, kt0, nkt; };
struct Gemm { const bf16_t* A; const bf16_t* Bt; int M, N, K; };

struct StaticOrder {
    int nM, nN, nwg, G, c;
    __host__ __device__ void init(int M, int N, int G_, int c_) { nM = M / BM; nN = N / BM; nwg = nM * nN; G = G_; c = c_; }
    __host__ __device__ bool next(int i, Unit& u) const {
        const long L = (long)i * G + c; if (L >= nwg) return false;
        int wgid = (int)L; { const int q = nwg / NXCD, r = nwg % NXCD, xcd = wgid % NXCD, off = wgid / NXCD; wgid = (xcd < r ? xcd * (q + 1) : r * (q + 1) + (xcd - r) * q) + off; }
        const int nig = WGM * nN, gid = wgid / nig, fm = gid * WGM, gsz = (nM - fm) < WGM ? (nM - fm) : WGM;
        u.pm = fm + ((wgid % nig) % gsz); u.pn = (wgid % nig) / gsz; return true;
    }
    __device__ __forceinline__ void a_ready(const Unit&) const {}
    __device__ __forceinline__ void done(const Unit&) const {}
};

struct SampleOrder {
    StaticOrder P; int nkt_full, nsplit, ns;
    __host__ __device__ void init(int Mp, int N, int K, int nsplit_, int G_, int c_) { P.init(Mp, N, G_, c_); nkt_full = K / BK; nsplit = nsplit_; ns = (N / BM) * nsplit_; }
    __host__ __device__ bool next(int i, Unit& u) const {
        Unit t; t.pm = 0; t.pn = 0; t.kt0 = 0; t.nkt = 0; int pm, pn, kt0 = 0, nkt = nkt_full;
        if (P.next(i, t)) { pm = t.pm; pn = t.pn; }
        else { const long L = (long)i * P.G + P.c - P.nwg; if (L < 0 || L >= ns) return false;
            const int s = (int)L, ks = s / P.nN; pm = P.nM; pn = s - ks * P.nN; nkt = nkt_full / nsplit; kt0 = ks * nkt; }
        u.pm = pm; u.pn = pn; u.kt0 = kt0; u.nkt = nkt; return true;
    }
    __device__ __forceinline__ void a_ready(const Unit&) const {}
    __device__ __forceinline__ void done(const Unit&) const {}
};
struct NoCopy { static constexpr bool ACTIVE = false; __device__ __forceinline__ void prime() {} template <int KT> __device__ __forceinline__ void step() {} __device__ __forceinline__ void flush() {} };
struct StreamCopy {
    static constexpr bool ACTIVE = true;
    const unsigned char* src; unsigned char* dst; int cur, last; unsigned lane_off; f32x4 buf0, buf1; unsigned off0, off1;
    __device__ __forceinline__ unsigned chunk_off() { const int c = cur < last ? cur : last; cur += 8; return (unsigned)c * 1024u + lane_off; }
    static __device__ __forceinline__ void ld(f32x4& v, unsigned off, const unsigned char* base) { asm volatile("global_load_dwordx4 %0, %1, %2 nt" : "=v"(v) : "v"(off), "s"(base) : "memory"); }
    static __device__ __forceinline__ void st_w(const f32x4& v, unsigned off, unsigned char* base) { asm volatile("s_waitcnt vmcnt(18)\n\tglobal_store_dwordx4 %0, %1, %2 nt" : : "v"(off), "v"(v), "s"(base) : "memory"); }
    static __device__ __forceinline__ void st(const f32x4& v, unsigned off, unsigned char* base) { asm volatile("global_store_dwordx4 %0, %1, %2 nt" : : "v"(off), "v"(v), "s"(base) : "memory"); }
    __device__ __forceinline__ void prime() { off0 = chunk_off(); ld(buf0, off0, src); off1 = chunk_off(); ld(buf1, off1, src); }
    template <int KT> __device__ __forceinline__ void step() {
        if (KT == 0) { st_w(buf0, off0, dst); off0 = chunk_off(); ld(buf0, off0, src); }
        else         { st_w(buf1, off1, dst); off1 = chunk_off(); ld(buf1, off1, src); }
    }
    __device__ __forceinline__ void flush() { st(buf0, off0, dst); st(buf1, off1, dst); }
};

__device__ __forceinline__ unsigned cvt_pk_bf16(float lo, float hi) { unsigned r; asm volatile("v_cvt_pk_bf16_f32 %0, %1, %2" : "=v"(r) : "v"(lo), "v"(hi)); return r; }
typedef float f32x2 __attribute__((ext_vector_type(2)));

typedef unsigned u32x2 __attribute__((ext_vector_type(2)));
__device__ __forceinline__ float fast_sigmoid(float x) { return __builtin_amdgcn_rcpf(1.0f + __builtin_amdgcn_exp2f(-1.4426950408889634f * x)); }

__device__ __forceinline__ void store_slab(float* slab, const f32x4 (&acc)[2][2][4][2], const Unit& u, int wr, int wc, int fr, int fq) {
    const int ks = u.kt0 / u.nkt; float* base = slab + ((size_t)ks * 128 + wr * 64 + fr) * 1024 + u.pn * BM + wc * 32 + 8 * fq;
#pragma unroll
    for (int m = 0; m < 4; ++m)
#pragma unroll
        for (int bj = 0; bj < 2; ++bj) { float* p = base + (size_t)m * 16 * 1024 + bj * HALF; *(f32x4*)p = acc[0][bj][m][0]; *(f32x4*)(p + 4) = acc[0][bj][m][1]; }
}
struct EpiPlain {
    static constexpr bool PERM = true, AFTER_DRAIN = false;
    bf16_t* O; int ldc; float* slab;
    __device__ __forceinline__ void operator()(const f32x4 (&acc)[2][2][4][2], const Unit& u, int wr, int wc, int fr, int fq) const {
        if (slab != nullptr && u.pm == MP / BM) { store_slab(slab, acc, u, wr, wc, fr, fq); return; }
        const int row0 = u.pm * BM + wr * 64 + fr, col0 = u.pn * BM + wc * 32 + 8 * fq;
#pragma unroll
        for (int ai = 0; ai < 2; ++ai)
#pragma unroll
            for (int m = 0; m < 4; ++m) { bf16_t* rowp = O + (size_t)(row0 + ai * HALF + m * 16) * ldc + col0;
#pragma unroll
                for (int bj = 0; bj < 2; ++bj) { const f32x4 v0 = acc[ai][bj][m][0], v1 = acc[ai][bj][m][1];
                    u32x4 w; w.x = cvt_pk_bf16(v0[0], v0[1]); w.y = cvt_pk_bf16(v0[2], v0[3]); w.z = cvt_pk_bf16(v1[0], v1[1]); w.w = cvt_pk_bf16(v1[2], v1[3]);
                    *(u32x4*)(rowp + bj * HALF) = w; } }
    }
};

struct EpiSwiGLU {
    static constexpr bool PERM = true, AFTER_DRAIN = false;
    bf16_t* O; int ldc; const float* rs;
    __device__ __forceinline__ void operator()(const f32x4 (&acc)[2][2][4][2], const Unit& u, int wr, int wc, int fr, int fq) const {
        const int row0 = u.pm * BM + wr * 64 + fr, col0 = u.pn * HALF + wc * 32 + 8 * fq;
        float rv[2][4];
#pragma unroll
        for (int ai = 0; ai < 2; ++ai)
#pragma unroll
            for (int m = 0; m < 4; ++m) rv[ai][m] = rs[row0 + ai * HALF + m * 16];
#pragma unroll
        for (int ai = 0; ai < 2; ++ai)
#pragma unroll
            for (int m = 0; m < 4; ++m) { const int row = row0 + ai * HALF + m * 16; const float r = rv[ai][m];
                unsigned w[4];
#pragma unroll
                for (int bj = 0; bj < 2; ++bj) { const f32x4 g = acc[ai][bj][m][0] * r, up = acc[ai][bj][m][1] * r; float o[4];
#pragma unroll
                    for (int i = 0; i < 4; ++i) o[i] = g[i] * fast_sigmoid(g[i]) * up[i];
                    w[2 * bj] = cvt_pk_bf16(o[0], o[1]); w[2 * bj + 1] = cvt_pk_bf16(o[2], o[3]); }
                u32x4 wv; wv.x = w[0]; wv.y = w[1]; wv.z = w[2]; wv.w = w[3];
                *(u32x4*)(O + (size_t)row * ldc + col0) = wv; }
    }
};

struct EpiRope {
    static constexpr bool PERM = true, AFTER_DRAIN = false;
    bf16_t* O; const float* rs; const float* rope;
    float* out;
    __device__ __forceinline__ void operator()(const f32x4 (&acc)[2][2][4][2], const Unit& u, int wr, int wc, int fr, int fq) const {
        const int pn = u.pn; const int row0 = u.pm * BM + wr * 64 + fr;
        const int d0 = 16 * (wc & 1) + 4 * fq;
        const bool is_s = u.pm >= MP / BM;
#pragma unroll
        for (int ai = 0; ai < 2; ++ai) {
            float rv[4]; f32x4 csa[4], csb[4];
#pragma unroll
            for (int m = 0; m < 4; ++m) { const int row = row0 + ai * HALF + m * 16; rv[m] = rs[row];
                const float* rp = rope + (unsigned)((is_s ? SEQ : (row & (SEQ - 1))) * 64 + 2 * d0); csa[m] = *(const f32x4*)rp; csb[m] = *(const f32x4*)(rp + 4); }
#pragma unroll
            for (int m = 0; m < 4; ++m) { const int row = row0 + ai * HALF + m * 16; const float r = rv[m];
                const int t = is_s ? 0 : (row & (SEQ - 1)); const int b = is_s ? (row - MP) : (row / SEQ);
                const f32x4 cs0 = csa[m], cs1 = csb[m];
#pragma unroll
                for (int bj = 0; bj < 2; ++bj) {
                    const int hl = 2 * bj + (wc >> 1);
                    const bool rot = (pn < 4) || (pn == 6) || (pn == 7) || (pn == 8 && bj == 0);
                    const bool isq = (pn < 2) || (pn == 6) || (pn == 7);
                    f32x4 x1 = acc[ai][bj][m][0] * r, x2 = acc[ai][bj][m][1] * r;
                    if (rot) {
                        const f32x4 c = (f32x4){cs0[0], cs0[2], cs1[0], cs1[2]}, s = (f32x4){cs0[1], cs0[3], cs1[1], cs1[3]};
                        const f32x4 a = x1, bb = x2; x1 = a * c - bb * s; x2 = bb * c + a * s; }
                    long doff = -1;
                    if (pn >= 2 && pn <= 5) {
                        const int head = 4 * (pn & 1) + hl; const size_t base = (pn < 4) ? (is_s ? O_AKS : O_AKP) : (is_s ? O_AVS : O_AVP);
                        if (is_s) { if (row < MP + MS) doff = (long)(base + ((size_t)(b * 2048 + 2047) * 8 + head) * 64); }
                        else if (t >= SEQ - 2048) doff = (long)(base + ((size_t)(b * 2048 + (t - (SEQ - 2048))) * 8 + head) * 64);
                    } else if (pn == 8) {
                        const int kvh = wc >> 1; const size_t base = (bj == 0) ? (is_s ? O_BKS : O_BKP) : (is_s ? O_BVS : O_BVP);
                        if (is_s) { if (row < MP + MS) doff = (long)(base + ((size_t)(b * 128 + 127) * 2 + kvh) * 64); }
                        else if (t >= SEQ - 128) doff = (long)(base + ((size_t)(b * 128 + (t - (SEQ - 128))) * 2 + kvh) * 64);
                    }
                    if (doff >= 0) { float* dst = out + doff; *(f32x4*)(dst + d0) = x1; *(f32x4*)(dst + d0 + 32) = x2; }
                    if (isq) { x1 = x1 * QSCALE; x2 = x2 * QSCALE; }
                    bf16_t* op = O + (size_t)row * 2304 + pn * BM + 64 * hl + d0;
                    u32x2 w1, w2; w1.x = cvt_pk_bf16(x1[0], x1[1]); w1.y = cvt_pk_bf16(x1[2], x1[3]); w2.x = cvt_pk_bf16(x2[0], x2[1]); w2.y = cvt_pk_bf16(x2[2], x2[3]);
                    *(u32x2*)op = w1; *(u32x2*)(op + 32) = w2; } } }
    }
};

struct EpiPle {
    static constexpr bool PERM = true, AFTER_DRAIN = false;
    bf16_t* O; int ldc; const float* rs; const bf16_t* PP; float* slab;
    __device__ __forceinline__ void operator()(const f32x4 (&acc)[2][2][4][2], const Unit& u, int wr, int wc, int fr, int fq) const {
        if (u.pm == MP / BM) { store_slab(slab, acc, u, wr, wc, fr, fq); return; }
        const int row0 = u.pm * BM + wr * 64 + fr, col0 = u.pn * BM + wc * 32 + 8 * fq;
#pragma unroll
        for (int ai = 0; ai < 2; ++ai) {
            float rv[4]; u32x4 ppv[4][2];
#pragma unroll
            for (int m = 0; m < 4; ++m) { const int row = row0 + ai * HALF + m * 16; rv[m] = rs[row];
#pragma unroll
                for (int bj = 0; bj < 2; ++bj) ppv[m][bj] = *(const u32x4*)(PP + (size_t)row * ldc + col0 + bj * HALF); }
#pragma unroll
            for (int m = 0; m < 4; ++m) { const int row = row0 + ai * HALF + m * 16; const float r = rv[m]; const size_t off = (size_t)row * ldc + col0;
#pragma unroll
                for (int bj = 0; bj < 2; ++bj) { const u32x4 pp = ppv[m][bj];
                    const f32x4 v0 = acc[ai][bj][m][0] * r, v1 = acc[ai][bj][m][1] * r; float o[8];
#pragma unroll
                    for (int i = 0; i < 4; ++i) { const unsigned pw0 = pp[i >> 1], pw1 = pp[2 + (i >> 1)];
                        const float p0 = __uint_as_float((i & 1) ? (pw0 & 0xffff0000u) : (pw0 << 16)), p1 = __uint_as_float((i & 1) ? (pw1 & 0xffff0000u) : (pw1 << 16));
                        o[i] = fast_sigmoid(v0[i]) * p0; o[4 + i] = fast_sigmoid(v1[i]) * p1; }
                    u32x4 w; w.x = cvt_pk_bf16(o[0], o[1]); w.y = cvt_pk_bf16(o[2], o[3]); w.z = cvt_pk_bf16(o[4], o[5]); w.w = cvt_pk_bf16(o[6], o[7]);
                    *(u32x4*)(O + off + bj * HALF) = w; } } }
    }
};

template <class Epi, class Sched, class Copy, bool ALIGN_EPI = false, bool SP2 = false>
__device__ __forceinline__ void gemm_phase(PG8_LAS unsigned char* lds, const Gemm g, const Sched& S, const Epi& E, Copy& C) {
    int tid_ = threadIdx.x; asm volatile("" : "+v"(tid_));
    const int tid = tid_, wid = __builtin_amdgcn_readfirstlane(tid >> 6), lane = tid & 63, wr = wid >> 2, wc = wid & 3, fr = lane & 15, fq = lane >> 4;
    const int K = g.K;
    unsigned voffA[2], voffB[2];
#pragma unroll
    for (int i = 0; i < 2; ++i) { int R, C; stage_rc(tid * 16 + i * 8192, R, C); const int Rb = Epi::PERM ? ((R & ~31) + perm32(R & 31)) : R;
        voffA[i] = (unsigned)(R * K + C) * 2u; voffB[i] = (unsigned)(Rb * K + C) * 2u; }
    const size_t kstep = (size_t)(BK * 2);
    const size_t hstep = (size_t)HALF * K * 2;
    const size_t tstep = 2 * hstep;
    const unsigned ldsw = (unsigned)wid * 1024u;
    const int aoff = lds_byte(wr * 64 + fr, fq * 8), boff = lds_byte(wc * 32 + fr, fq * 8);
#define PG8_SA(b, h) (((b) * 2 + (h)) * HTB)
#define PG8_SB(b, h) ((4 + (b) * 2 + (h)) * HTB)
#define PG8_STAGE(bufoff, gbase, voff) do { _Pragma("unroll") for (int _i = 0; _i < 2; ++_i) \
        __builtin_amdgcn_global_load_lds((const unsigned*)((const char*)(gbase) + (voff)[_i]), (PG8_LAS unsigned*)(lds + (bufoff) + ldsw + _i * 8192), 16, 0, 0); } while (0)
#define PG8_LDA(dst, b, h) do { _Pragma("unroll") for (int m = 0; m < 4; ++m) _Pragma("unroll") for (int k = 0; k < 2; ++k) dst[m][k] = *(const PG8_LAS bf16x8*)(lds + PG8_SA(b, h) + aoff + m * 2048 + k * 1024); } while (0)
#define PG8_LDB(dst, b, h) do { _Pragma("unroll") for (int n = 0; n < 2; ++n) _Pragma("unroll") for (int k = 0; k < 2; ++k) dst[n][k] = *(const PG8_LAS bf16x8*)(lds + PG8_SB(b, h) + boff + n * 2048 + k * 1024); } while (0)
#define PG8_MMA(ai, bj, At, Bt) do { __builtin_amdgcn_s_setprio(1); _Pragma("unroll") for (int m = 0; m < 4; ++m) _Pragma("unroll") for (int n = 0; n < 2; ++n) _Pragma("unroll") for (int k = 0; k < 2; ++k) \
        acc[ai][bj][m][n] = __builtin_amdgcn_mfma_f32_16x16x32_bf16(Bt[n][k], At[m][k], acc[ai][bj][m][n], 0, 0, 0); __builtin_amdgcn_s_setprio(0); } while (0)
#define PG8_WAIT_V(n) asm volatile("s_waitcnt vmcnt(" #n ")" ::: "memory")
#define PG8_WAIT_L(n) asm volatile("s_waitcnt lgkmcnt(" #n ")" ::: "memory")
#define PG8_WAIT_VA do { if constexpr (Copy::ACTIVE) { PG8_WAIT_V(12); } else { PG8_WAIT_V(8); } } while (0)
#define PG8_WAIT_VB do { if constexpr (Copy::ACTIVE) { PG8_WAIT_V(10); } else { PG8_WAIT_V(8); } } while (0)
#define PG8_BAR __builtin_amdgcn_s_barrier()
#define PG8_SCHED __builtin_amdgcn_sched_barrier(0)
    Unit cur, nxt; int ui = 0;
    if (!S.next(0, cur)) return;
    f32x4 acc[2][2][4][2];
#pragma unroll
    for (int a = 0; a < 2; ++a)
#pragma unroll
        for (int b = 0; b < 2; ++b)
#pragma unroll
            for (int m = 0; m < 4; ++m)
#pragma unroll
                for (int n = 0; n < 2; ++n) acc[a][b][m][n] = (f32x4){0.f, 0.f, 0.f, 0.f};
    bf16x8 At[4][2], B0[2][2], B1[2][2];
    const char* cA = (const char*)g.A + (size_t)cur.pm * tstep + (size_t)cur.kt0 * kstep; const char* cB = (const char*)g.Bt + (size_t)cur.pn * tstep + (size_t)cur.kt0 * kstep;
    S.a_ready(cur);
    C.prime();
    if constexpr (SP2) {
        PG8_STAGE(PG8_SB(0, 0), cB, voffB); PG8_STAGE(PG8_SB(0, 1), cB + hstep, voffB); PG8_STAGE(PG8_SA(0, 0), cA, voffA); PG8_STAGE(PG8_SA(0, 1), cA + hstep, voffA);
        if (wr == 1) PG8_BAR;
        PG8_WAIT_V(2); PG8_BAR;
        PG8_STAGE(PG8_SB(1, 0), cB + kstep, voffB); PG8_STAGE(PG8_SA(1, 0), cA + kstep, voffA); PG8_STAGE(PG8_SB(1, 1), cB + hstep + kstep, voffB);
        PG8_WAIT_V(6); PG8_BAR;
    } else {
        PG8_STAGE(PG8_SB(0, 0), cB, voffB); PG8_STAGE(PG8_SA(0, 0), cA, voffA); PG8_STAGE(PG8_SB(0, 1), cB + hstep, voffB); PG8_STAGE(PG8_SA(0, 1), cA + hstep, voffA);
        if (wr == 1) PG8_BAR;
        PG8_WAIT_V(4); PG8_BAR;
        PG8_STAGE(PG8_SB(1, 0), cB + kstep, voffB); PG8_STAGE(PG8_SA(1, 0), cA + kstep, voffA); PG8_STAGE(PG8_SB(1, 1), cB + hstep + kstep, voffB);
        PG8_WAIT_V(6); PG8_BAR;
    }
    for (;;) {
        const bool has_next = S.next(ui + 1, nxt);
        const char* nA = has_next ? (const char*)g.A + (size_t)nxt.pm * tstep + (size_t)nxt.kt0 * kstep : cA; const char* nB = has_next ? (const char*)g.Bt + (size_t)nxt.pn * tstep + (size_t)nxt.kt0 * kstep : cB;
        const int nt = cur.nkt;
#pragma nounroll
        for (int t = 0; t < nt; t += 2) {
            const bool last = (t == nt - 2);
            const char* a1 = cA + (size_t)(t + 1) * kstep;
            const char* a2 = last ? nA : cA + (size_t)(t + 2) * kstep; const char* b2 = last ? nB : cB + (size_t)(t + 2) * kstep;
            const char* a3 = a2 + kstep; const char* b3 = b2 + kstep;
            if (last && has_next) S.a_ready(nxt);
            if constexpr (SP2) {
            PG8_LDB(B0, 0, 0); PG8_LDB(B1, 0, 1); PG8_SCHED; PG8_LDA(At, 0, 0); PG8_STAGE(PG8_SA(1, 1), a1 + hstep, voffA);
            C.template step<0>(); PG8_WAIT_VA; PG8_WAIT_L(0); PG8_BAR; PG8_MMA(0, 0, At, B0); PG8_MMA(0, 1, At, B1); PG8_BAR; PG8_SCHED;
            PG8_LDA(At, 0, 1); PG8_STAGE(PG8_SB(0, 0), b2, voffB); PG8_STAGE(PG8_SB(0, 1), b2 + hstep, voffB); PG8_STAGE(PG8_SA(0, 0), a2, voffA);
            PG8_WAIT_VB; PG8_WAIT_L(0); PG8_BAR; PG8_MMA(1, 0, At, B0); PG8_MMA(1, 1, At, B1); PG8_BAR; PG8_SCHED;
            PG8_LDB(B0, 1, 0); PG8_LDB(B1, 1, 1); PG8_SCHED; PG8_LDA(At, 1, 0); PG8_STAGE(PG8_SA(0, 1), a2 + hstep, voffA);
            C.template step<1>(); PG8_WAIT_VA; PG8_WAIT_L(0); PG8_BAR; PG8_MMA(0, 0, At, B0); PG8_MMA(0, 1, At, B1); PG8_BAR; PG8_SCHED;
            PG8_LDA(At, 1, 1); PG8_STAGE(PG8_SB(1, 0), b3, voffB); PG8_STAGE(PG8_SB(1, 1), b3 + hstep, voffB); PG8_STAGE(PG8_SA(1, 0), a3, voffA);
            PG8_WAIT_VB; PG8_WAIT_L(0); PG8_BAR; PG8_MMA(1, 0, At, B0); PG8_MMA(1, 1, At, B1); PG8_BAR; PG8_SCHED;
            } else {
            PG8_LDB(B0, 0, 0); PG8_SCHED; PG8_LDA(At, 0, 0); PG8_STAGE(PG8_SA(1, 1), a1 + hstep, voffA);
            PG8_WAIT_L(8); PG8_BAR; PG8_WAIT_L(0); PG8_MMA(0, 0, At, B0); PG8_BAR; PG8_SCHED;
            PG8_LDB(B1, 0, 1); PG8_STAGE(PG8_SB(0, 0), b2, voffB);
            PG8_BAR; PG8_WAIT_L(0); PG8_MMA(0, 1, At, B1); PG8_BAR;
            PG8_LDA(At, 0, 1); PG8_STAGE(PG8_SA(0, 0), a2, voffA);
            PG8_BAR; PG8_WAIT_L(0); PG8_MMA(1, 0, At, B0); PG8_BAR; PG8_SCHED;
            PG8_STAGE(PG8_SB(0, 1), b2 + hstep, voffB);
            PG8_WAIT_V(6); PG8_BAR; PG8_MMA(1, 1, At, B1); PG8_BAR;
            PG8_LDB(B0, 1, 0); PG8_SCHED; PG8_LDA(At, 1, 0); PG8_STAGE(PG8_SA(0, 1), a2 + hstep, voffA);
            PG8_WAIT_L(8); PG8_BAR; PG8_WAIT_L(0); PG8_MMA(0, 0, At, B0); PG8_BAR; PG8_SCHED;
            PG8_LDB(B1, 1, 1); PG8_STAGE(PG8_SB(1, 0), b3, voffB);
            PG8_BAR; PG8_WAIT_L(0); PG8_MMA(0, 1, At, B1); PG8_BAR;
            PG8_LDA(At, 1, 1); PG8_STAGE(PG8_SA(1, 0), a3, voffA);
            PG8_BAR; PG8_WAIT_L(0); PG8_MMA(1, 0, At, B0); PG8_BAR; PG8_SCHED;
            PG8_STAGE(PG8_SB(1, 1), b3 + hstep, voffB);
            PG8_WAIT_V(6); PG8_BAR; PG8_MMA(1, 1, At, B1); PG8_BAR;
            }
        }
        if constexpr (ALIGN_EPI) { if (wr == 0) PG8_BAR; }
        if constexpr (!Epi::AFTER_DRAIN) { E(acc, cur, wr, wc, fr, fq); S.done(cur); }
        if (!has_next) break;
#pragma unroll
        for (int a = 0; a < 2; ++a)
#pragma unroll
            for (int b = 0; b < 2; ++b)
#pragma unroll
                for (int m = 0; m < 4; ++m)
#pragma unroll
                    for (int n = 0; n < 2; ++n) acc[a][b][m][n] = (f32x4){0.f, 0.f, 0.f, 0.f};
        cur = nxt; cA = nA; cB = nB; ++ui;
        if constexpr (ALIGN_EPI) { if (wr == 1) PG8_BAR; }
    }
    PG8_WAIT_V(0);
    C.flush();
    if constexpr (!ALIGN_EPI) { if (wr == 0) PG8_BAR; }
    PG8_BAR;
    if constexpr (Epi::AFTER_DRAIN) { E.fused(acc, cur, wr, wc, fr, fq, lds, wid, lane); S.done(cur); }
#undef PG8_SA
#undef PG8_SB
#undef PG8_STAGE
#undef PG8_LDA
#undef PG8_LDB
#undef PG8_MMA
#undef PG8_WAIT_V
#undef PG8_WAIT_L
#undef PG8_WAIT_VA
#undef PG8_WAIT_VB
#undef PG8_BAR
#undef PG8_SCHED
}
}
namespace pg8 {
struct StreamCopy4 {
    const unsigned char* src; unsigned char* dst; int cur, tw, last; unsigned lane_off; f32x4 b0, b1, b2, b3, b4, b5, b6, b7;
    __device__ __forceinline__ void skip() { cur += 8; }
    __device__ __forceinline__ unsigned off_of(int c0) const { int c = c0 + tw; c = c < last ? c : last; return (unsigned)c * 1024u + lane_off; }
    static __device__ __forceinline__ void ld(f32x4& v, unsigned off, const unsigned char* base) { asm volatile("global_load_dwordx4 %0, %1, %2 nt" : "=v"(v) : "v"(off), "s"(base) : "memory"); }
    static __device__ __forceinline__ void st_w12(const f32x4& v, unsigned off, unsigned char* base) { asm volatile("s_waitcnt vmcnt(12)\n\tglobal_store_dwordx4 %0, %1, %2 nt\n\ts_nop 0" : : "v"(off), "v"(v), "s"(base) : "memory"); }
    static __device__ __forceinline__ void st(const f32x4& v, unsigned off, unsigned char* base) { asm volatile("global_store_dwordx4 %0, %1, %2 nt\n\ts_nop 0" : : "v"(off), "v"(v), "s"(base) : "memory"); }
    __device__ __forceinline__ void prime() { ld(b0, off_of(cur), src); ld(b1, off_of(cur + 4), src); ld(b2, off_of(cur + 8), src); ld(b3, off_of(cur + 12), src);
        ld(b4, off_of(cur + 16), src); ld(b5, off_of(cur + 20), src); ld(b6, off_of(cur + 24), src); ld(b7, off_of(cur + 28), src); cur += 32;
        asm volatile("s_waitcnt vmcnt(0)" ::: "memory"); }
    template <int P> __device__ __forceinline__ void step() {
        const unsigned so0 = off_of(cur - 32), so1 = off_of(cur - 28), lo0 = off_of(cur), lo1 = off_of(cur + 4); cur += 8;
        if (P == 0) { st_w12(b0, so0, dst); st(b1, so1, dst); ld(b0, lo0, src); ld(b1, lo1, src); }
        if (P == 1) { st_w12(b2, so0, dst); st(b3, so1, dst); ld(b2, lo0, src); ld(b3, lo1, src); }
        if (P == 2) { st_w12(b4, so0, dst); st(b5, so1, dst); ld(b4, lo0, src); ld(b5, lo1, src); }
        if (P == 3) { st_w12(b6, so0, dst); st(b7, so1, dst); ld(b6, lo0, src); ld(b7, lo1, src); }
    }
    __device__ __forceinline__ void flush() { st(b0, off_of(cur - 32), dst); st(b1, off_of(cur - 28), dst); st(b2, off_of(cur - 24), dst); st(b3, off_of(cur - 20), dst);
                                              st(b4, off_of(cur - 16), dst); st(b5, off_of(cur - 12), dst); st(b6, off_of(cur - 8), dst); st(b7, off_of(cur - 4), dst); }
};
#define RS_SA(b, h) (((b) * 2 + (h)) * HTB)
#define RS_SB(b, h) ((4 + (b) * 2 + (h)) * HTB)
#define RS_STAGE(bufoff, gbase, voff) do { _Pragma("unroll") for (int _i = 0; _i < 4; ++_i) \
        __builtin_amdgcn_global_load_lds((const unsigned*)((const char*)(gbase) + (size_t)_i * pstep + (voff)), (PG8_LAS unsigned*)(lds + (bufoff) + ldsw + _i * 4096), 16, 0, 0); } while (0)
#define RS_LDA(dst, b, h) do { _Pragma("unroll") for (int m = 0; m < 4; ++m) _Pragma("unroll") for (int k = 0; k < 2; ++k) dst[m][k] = *(const PG8_LAS bf16x8*)(lds + RS_SA(b, h) + aoff + m * 2048 + k * 1024); } while (0)
#define RS_LDB(dst, b, h) do { _Pragma("unroll") for (int n = 0; n < 2; ++n) _Pragma("unroll") for (int k = 0; k < 2; ++k) dst[n][k] = *(const PG8_LAS bf16x8*)(lds + RS_SB(b, h) + boff + n * 2048 + k * 1024); } while (0)
#define RS_MMA(ai, bj, At, Bt) do { __builtin_amdgcn_s_setprio(1); _Pragma("unroll") for (int m = 0; m < 4; ++m) _Pragma("unroll") for (int n = 0; n < 2; ++n) _Pragma("unroll") for (int k = 0; k < 2; ++k) \
        acc[ai][bj][m][n] = __builtin_amdgcn_mfma_f32_16x16x32_bf16(Bt[n][k], At[m][k], acc[ai][bj][m][n], 0, 0, 0); __builtin_amdgcn_s_setprio(0); } while (0)
#define RS_WAIT_V(n) asm volatile("s_waitcnt vmcnt(" #n ")" ::: "memory")
#define RS_WAIT_L(n) asm volatile("s_waitcnt lgkmcnt(" #n ")" ::: "memory")
#define RS_BAR __builtin_amdgcn_s_barrier()
#define RS_SCHED __builtin_amdgcn_sched_barrier(0)
template <bool STAGER, class Epi, class Sched>
__device__ __forceinline__ void rs_role(PG8_LAS unsigned char* lds, const Gemm g, const Sched& S, const Epi& E, StreamCopy4& C) {
    int tid_ = threadIdx.x; asm volatile("" : "+v"(tid_));
    const int tid = tid_, wid = __builtin_amdgcn_readfirstlane(tid >> 6), lane = tid & 63, wr = STAGER ? 0 : 1, wc = wid & 3, fr = lane & 15, fq = lane >> 4;
    const int K = g.K;
    unsigned voffA = 0, voffB = 0;
    if (STAGER) { int R, Cc; stage_rc((tid & 255) * 16, R, Cc); const int Rb = Epi::PERM ? ((R & ~31) + perm32(R & 31)) : R; voffA = (unsigned)(R * K + Cc) * 2u; voffB = (unsigned)(Rb * K + Cc) * 2u; }
    const size_t kstep = (size_t)(BK * 2), hstep = (size_t)HALF * K * 2, tstep = 2 * hstep, pstep = (size_t)32 * K * 2;
    const unsigned ldsw = (unsigned)(wid & 3) * 1024u;
    const int aoff = lds_byte(wr * 64 + fr, fq * 8), boff = lds_byte(wc * 32 + fr, fq * 8);
    Unit cur, nxt; int ui = 0;
    if (!S.next(0, cur)) return;
    f32x4 acc[2][2][4][2];
#pragma unroll
    for (int a = 0; a < 2; ++a)
#pragma unroll
        for (int b = 0; b < 2; ++b)
#pragma unroll
            for (int m = 0; m < 4; ++m)
#pragma unroll
                for (int n = 0; n < 2; ++n) acc[a][b][m][n] = (f32x4){0.f, 0.f, 0.f, 0.f};
    bf16x8 At[4][2], B0[2][2], B1[2][2];
    const char* cA = (const char*)g.A + (size_t)cur.pm * tstep + (size_t)cur.kt0 * kstep; const char* cB = (const char*)g.Bt + (size_t)cur.pn * tstep + (size_t)cur.kt0 * kstep;
    if (STAGER) {
        RS_STAGE(RS_SB(0, 0), cB, voffB); RS_STAGE(RS_SB(0, 1), cB + hstep, voffB); RS_STAGE(RS_SA(0, 0), cA, voffA); RS_STAGE(RS_SA(0, 1), cA + hstep, voffA);
        RS_WAIT_V(4); RS_BAR;
        RS_STAGE(RS_SB(1, 0), cB + kstep, voffB); RS_STAGE(RS_SA(1, 0), cA + kstep, voffA); RS_STAGE(RS_SB(1, 1), cB + hstep + kstep, voffB);
        RS_WAIT_V(12); RS_BAR;
        C.skip(); C.skip(); C.skip(); C.skip();
    } else {
        C.prime();
        RS_BAR; RS_BAR; RS_BAR;
    }
    for (;;) {
        const bool has_next = S.next(ui + 1, nxt);
        const char* nA = has_next ? (const char*)g.A + (size_t)nxt.pm * tstep + (size_t)nxt.kt0 * kstep : cA; const char* nB = has_next ? (const char*)g.Bt + (size_t)nxt.pn * tstep + (size_t)nxt.kt0 * kstep : cB;
        const int nt = cur.nkt;
#pragma nounroll
        for (int t = 0; t < nt; t += 2) {
            const bool last = (t == nt - 2);
            const char* a1 = cA + (size_t)(t + 1) * kstep;
            const char* a2 = last ? nA : cA + (size_t)(t + 2) * kstep; const char* b2 = last ? nB : cB + (size_t)(t + 2) * kstep;
            const char* a3 = a2 + kstep; const char* b3 = b2 + kstep;
            RS_LDB(B0, 0, 0); RS_LDB(B1, 0, 1); RS_SCHED; RS_LDA(At, 0, 0);
            if (STAGER) { RS_STAGE(RS_SA(1, 1), a1 + hstep, voffA); RS_WAIT_V(16); C.skip(); } else { C.template step<0>(); }
            RS_WAIT_L(0); RS_BAR; RS_MMA(0, 0, At, B0); RS_MMA(0, 1, At, B1); RS_BAR; RS_SCHED;
            RS_LDA(At, 0, 1);
            if (STAGER) { RS_STAGE(RS_SB(0, 0), b2, voffB); RS_STAGE(RS_SB(0, 1), b2 + hstep, voffB); RS_STAGE(RS_SA(0, 0), a2, voffA); RS_WAIT_V(16); C.skip(); } else { C.template step<1>(); }
            RS_WAIT_L(0); RS_BAR; RS_MMA(1, 0, At, B0); RS_MMA(1, 1, At, B1); RS_BAR; RS_SCHED;
            RS_LDB(B0, 1, 0); RS_LDB(B1, 1, 1); RS_SCHED; RS_LDA(At, 1, 0);
            if (STAGER) { RS_STAGE(RS_SA(0, 1), a2 + hstep, voffA); RS_WAIT_V(16); C.skip(); } else { C.template step<2>(); }
            RS_WAIT_L(0); RS_BAR; RS_MMA(0, 0, At, B0); RS_MMA(0, 1, At, B1); RS_BAR; RS_SCHED;
            RS_LDA(At, 1, 1);
            if (STAGER) { RS_STAGE(RS_SB(1, 0), b3, voffB); RS_STAGE(RS_SB(1, 1), b3 + hstep, voffB); RS_STAGE(RS_SA(1, 0), a3, voffA); RS_WAIT_V(16); C.skip(); } else { C.template step<3>(); }
            RS_WAIT_L(0); RS_BAR; RS_MMA(1, 0, At, B0); RS_MMA(1, 1, At, B1); RS_BAR; RS_SCHED;
        }
        if (STAGER) RS_BAR;
        E(acc, cur, wr, wc, fr, fq);
        if (!has_next) break;
#pragma unroll
        for (int a = 0; a < 2; ++a)
#pragma unroll
            for (int b = 0; b < 2; ++b)
#pragma unroll
                for (int m = 0; m < 4; ++m)
#pragma unroll
                    for (int n = 0; n < 2; ++n) acc[a][b][m][n] = (f32x4){0.f, 0.f, 0.f, 0.f};
        cur = nxt; cA = nA; cB = nB; ++ui;
        if (!STAGER) RS_BAR;
    }
    RS_WAIT_V(0);
    if (!STAGER) C.flush();
    RS_BAR;
}
template <class Epi, class Sched>
__device__ __forceinline__ void gemm_phase_rs(PG8_LAS unsigned char* lds, const Gemm g, const Sched& S, const Epi& E, StreamCopy4& C) {
    static_assert(!Epi::AFTER_DRAIN, "gemm_phase_rs: in-loop epilogues only");
    const int wid = __builtin_amdgcn_readfirstlane((int)threadIdx.x >> 6);
    if (wid < 4) rs_role<true>(lds, g, S, E, C); else rs_role<false>(lds, g, S, E, C);
}
#undef RS_SA
#undef RS_SB
#undef RS_STAGE
#undef RS_LDA
#undef RS_LDB
#undef RS_MMA
#undef RS_WAIT_V
#undef RS_WAIT_L
#undef RS_BAR
#undef RS_SCHED
}
constexpr size_t MiB = 1u << 20;
constexpr size_t WS_CTL = 0, CTL_ZERO_BYTES = 1 * MiB;
constexpr size_t WS_WGU1 = 2 * MiB, WS_WD1 = 14 * MiB, WS_WIN = 20 * MiB, WS_WOUT = 25 * MiB, WS_WGU2 = 28 * MiB, WS_WD2 = 40 * MiB, WS_WPG = 46 * MiB, WS_WPP = 49 * MiB, WS_ROPE = 50 * MiB;
constexpr size_t WS_RS = 54 * MiB;
constexpr size_t WS_XB = 56 * MiB;
constexpr size_t WS_H = 92 * MiB;
constexpr size_t WS_ACT = 160 * MiB;
constexpr size_t WS_Y = 252 * MiB;
constexpr size_t WS_QKV = 288 * MiB;
constexpr size_t WS_ATT = 364 * MiB;
constexpr size_t WS_OP2 = 400 * MiB, WS_OP3 = 418 * MiB;
constexpr size_t WS_LS2 = 436 * MiB, WS_LS3 = 437 * MiB;
constexpr size_t WS_PB = 438 * MiB;
constexpr size_t WS_PP = 448 * MiB;
constexpr size_t WS_SLAB = 484 * MiB;
constexpr size_t WS_END = 492 * MiB;
static_assert(WS_WGU1 + (size_t)2 * FF * D * 2 <= WS_WD1 && WS_WD1 + (size_t)D * FF * 2 <= WS_WIN && WS_WIN + (size_t)NIN * D * 2 <= WS_WOUT && WS_WOUT + (size_t)D * D * 2 <= WS_WGU2 &&
              WS_WGU2 + (size_t)2 * FF * D * 2 <= WS_WD2 && WS_WD2 + (size_t)D * FF * 2 <= WS_WPG && WS_WPG + (size_t)D * D * 2 <= WS_WPP && WS_WPP + (size_t)D * DPLE * 2 <= WS_ROPE &&
              WS_ROPE + (size_t)8193 * 64 * 4 <= WS_RS && WS_RS + (size_t)MT * 4 <= WS_XB && WS_XB + (size_t)MT * D * 2 <= WS_H && WS_H + (size_t)MT * D * 4 <= WS_ACT &&
              WS_ACT + (size_t)MT * FF * 2 <= WS_Y && WS_Y + (size_t)MT * D * 2 <= WS_QKV && WS_QKV + (size_t)MT * NIN * 2 <= WS_ATT && WS_ATT + (size_t)MT * D * 2 <= WS_OP2 &&
              WS_OP2 + (size_t)MP * 512 * 2 <= WS_OP3 && WS_OP3 + (size_t)MP * 512 * 2 <= WS_LS2 && WS_LS2 + (size_t)MP * 8 * 4 <= WS_LS3 && WS_LS3 + (size_t)MP * 8 * 4 <= WS_PB &&
              WS_PB + (size_t)MT * DPLE * 2 <= WS_PP && WS_PP + (size_t)MT * D * 2 <= WS_SLAB && WS_SLAB + (size_t)11 * 128 * D * 4 <= WS_END, "d_ws map");
constexpr int CW_BAR = 4096;
constexpr int CW_CUR = 8192;
constexpr int CW_DONE = 8256;
constexpr int RING_OFF = 0, RING_BYTES = 131072;
constexpr int LDSCTL_OFF = RING_BYTES, MISC_OFF = LDSCTL_OFF + 320;
constexpr int LDS_BYTES = 147456;
static_assert(MISC_OFF + 128 <= LDS_BYTES, "LDS map");

#define GAS __attribute__((address_space(1)))
#define LAS __attribute__((address_space(3)))
typedef unsigned short bf16;
typedef unsigned v4u __attribute__((ext_vector_type(4)));
typedef float f32x4 __attribute__((ext_vector_type(4)));
typedef short bf16x8 __attribute__((ext_vector_type(8)));
typedef GAS unsigned gu32;
typedef GAS unsigned long long gu64;
#define RLX_AGENT __ATOMIC_RELAXED, __HIP_MEMORY_SCOPE_AGENT
#define LDS_WAIT() asm volatile("s_waitcnt lgkmcnt(0)" ::: "memory")
#define VM_WAIT() asm volatile("s_waitcnt vmcnt(0)" ::: "memory")
__device__ __forceinline__ unsigned long long rt() { return __builtin_amdgcn_s_memrealtime(); }
__device__ __forceinline__ unsigned f2bf(float f) { unsigned u = __builtin_bit_cast(unsigned, f); return (u + 0x7fffu + ((u >> 16) & 1u)) >> 16; }
__device__ __forceinline__ unsigned pk2(float lo, float hi) { return f2bf(lo) | (f2bf(hi) << 16); }

#define XB_TMO      128
#define XB_XCNT(j)  (256  + 64 * (j))
#define XB_XSUB(j)  (1280 + 64 * (j))
#define XB_XGEN(j)  (2304 + 64 * (j))
#define XB_TOP      3328
#define XB_TOPGEN   3392
#define XCD_BAR_WORDS 3456
#define XB_SPIN_CAP (1u << 18)

__device__ __forceinline__ unsigned xb_ld(unsigned* p)              { return __hip_atomic_load(p, __ATOMIC_RELAXED, __HIP_MEMORY_SCOPE_AGENT); }
__device__ __forceinline__ unsigned xb_add(unsigned* p, unsigned v) { return __hip_atomic_fetch_add(p, v, __ATOMIC_RELAXED, __HIP_MEMORY_SCOPE_AGENT); }
__device__ __forceinline__ unsigned xb_xcc_id() { return (unsigned)__builtin_amdgcn_s_getreg((3 << 11) | 20) & 0xFu; }
#define XB_SPIN(cond, bar) do { unsigned _sp = 0; while (cond) { __builtin_amdgcn_s_sleep(1); \
    if ((++_sp & 255u) == 0u) { if (xb_ld(&(bar)[XB_TMO])) break; if (_sp > XB_SPIN_CAP) { atomicAdd(&(bar)[XB_TMO], 1u); break; } } } } while (0)

struct XcdBarrier {
    unsigned* bar; unsigned x;
    volatile LAS unsigned* st;
};

__device__ __forceinline__ XcdBarrier xcd_barrier_post(unsigned* bar, volatile LAS unsigned* st) {
    XcdBarrier b; b.bar = bar; b.x = xb_xcc_id(); b.st = st;
    if (threadIdx.x == 0) (void)xb_add(&bar[XB_XCNT(b.x)], 1u);
    return b;
}
__device__ __forceinline__ void xcd_barrier_complete(unsigned* bar, unsigned x, unsigned& nloc, unsigned& nx) {
    const unsigned G = gridDim.x * gridDim.y * gridDim.z;
    unsigned sum, cnt, mine, sp = 0u;
    for (;;) {
        sum = 0u; cnt = 0u; mine = 0u;
#pragma unroll
        for (unsigned j = 0; j < 16; ++j) { const unsigned c = xb_ld(&bar[XB_XCNT(j)]); sum += c; cnt += (c > 0u) ? 1u : 0u; mine = (j == x) ? c : mine; }
        if (sum == G) break;
        __builtin_amdgcn_s_sleep(1);
        if ((++sp & 255u) == 0u) { if (xb_ld(&bar[XB_TMO])) break; if (sp > XB_SPIN_CAP) { atomicAdd(&bar[XB_TMO], 1u); break; } }
    }
    nloc = mine > 0u ? mine : 1u; nx = cnt > 0u ? cnt : 1u;
}

__device__ __forceinline__ void xcd_barrier(const XcdBarrier& b) {
    asm volatile("s_waitcnt vmcnt(0)" ::: "memory");
    __syncthreads();
    if (threadIdx.x == 0) {
        unsigned* bar = b.bar;
        __builtin_amdgcn_s_waitcnt(0);
        unsigned nloc = b.st[0], nx = b.st[1];
        if (nloc == 0u) { xcd_barrier_complete(bar, b.x, nloc, nx); b.st[0] = nloc; b.st[1] = nx; }
        const unsigned old = xb_add(&bar[XB_XSUB(b.x)], 1u);
        const unsigned gen = old / nloc;
        if (old + 1u == (gen + 1u) * nloc) {
            __builtin_amdgcn_fence(__ATOMIC_RELEASE, "agent");
            asm volatile("s_waitcnt vmcnt(0)" ::: "memory");
            const unsigned og = xb_add(&bar[XB_TOP], 1u);
            const unsigned tg = og / nx;
            if (og + 1u == (tg + 1u) * nx) xb_add(&bar[XB_TOPGEN], 1u);
            else XB_SPIN(xb_ld(&bar[XB_TOPGEN]) == tg, bar);
            __builtin_amdgcn_fence(__ATOMIC_ACQUIRE, "agent");
            xb_add(&bar[XB_XGEN(b.x)], 1u);
            asm volatile("s_waitcnt vmcnt(0)" ::: "memory");
        } else {
            XB_SPIN(xb_ld(&bar[XB_XGEN(b.x)]) == gen, bar);
            __builtin_amdgcn_fence(__ATOMIC_ACQUIRE, "agent");
            asm volatile("s_waitcnt vmcnt(0)" ::: "memory");
        }
    }
    __syncthreads();
}

typedef unsigned u32x2g __attribute__((ext_vector_type(2)));
typedef float f32x16 __attribute__((ext_vector_type(16)));
typedef short s16x4 __attribute__((ext_vector_type(4)));
struct Args { const float* in[27]; float* out; unsigned char* ws; };
struct Frame {
    LAS unsigned char* lds;
    volatile LAS unsigned* MISC;
    gu32* ctl;
    int tid, lane, wave;
    int vcu, G;
    int copy_cur;
};
__device__ __forceinline__ float wave_sum(float v) {
#pragma unroll
    for (int o = 1; o < 64; o <<= 1) v += __shfl_xor(v, o);
    return v;
}
__device__ __forceinline__ float bf_lo(unsigned w) { return __uint_as_float(w << 16); }
__device__ __forceinline__ float bf_hi(unsigned w) { return __uint_as_float(w & 0xffff0000u); }

enum { MAP_ID = 0, MAP_GATE = 1, MAP_UP = 2, MAP_ROPE = 3 };
__host__ __device__ __forceinline__ int map_row(int kind, int n) {
    if (kind == MAP_ID) return n;
    if (kind == MAP_ROPE) {
        const int pn = n >> 8, c = n & 255, hl = c >> 6, d = c & 63;
        const int bj = hl >> 1, wch = hl & 1, nn = d >> 5, dd = d & 31, wcl = dd >> 4, fq = (dd >> 2) & 3, i = dd & 3;
        const int wc = wch * 2 + wcl;
        return pn * 256 + 128 * bj + 32 * wc + 8 * fq + 4 * nn + i;
    }
    const int pn = n >> 7, o = n & 127, wc = o >> 5, fq = (o >> 3) & 3, bj = (o >> 2) & 1, i = o & 3;
    return pn * 256 + 128 * bj + 32 * wc + 8 * fq + 4 * (kind == MAP_UP ? 1 : 0) + i;
}
__device__ __forceinline__ void p0_transpose_item(const float* W, int K, int N, bf16* WT, int kind, const float* gain, LAS float* scr, int item, int lane) {
    const int nblk = N / 32, kb = item / nblk, nb = item % nblk, k0 = 64 * kb, n0 = 32 * nb;
    float wv[32];
#pragma unroll
    for (int i = 0; i < 32; ++i) { const int kk = 2 * i + (lane >> 5); wv[i] = W[(size_t)(k0 + kk) * N + n0 + (lane & 31)]; }
#pragma unroll
    for (int i = 0; i < 32; ++i) { const int kk = 2 * i + (lane >> 5); const float g = gain ? gain[k0 + kk] : 1.0f; scr[kk * 33 + (lane & 31)] = wv[i] * g; }
    LDS_WAIT(); asm volatile("" ::: "memory");
    const int c = lane & 7;
#pragma unroll
    for (int j = 0; j < 4; ++j) { const int n = (lane >> 3) + 8 * j; const LAS float* s = scr + (8 * c) * 33 + n;
        v4u o; o.x = pk2(s[0 * 33], s[1 * 33]); o.y = pk2(s[2 * 33], s[3 * 33]); o.z = pk2(s[4 * 33], s[5 * 33]); o.w = pk2(s[6 * 33], s[7 * 33]);
        *(GAS v4u*)(WT + (size_t)map_row(kind, n0 + n) * K + k0 + 8 * c) = o; }
    LDS_WAIT(); asm volatile("" ::: "memory");
}
__device__ __forceinline__ void row_to_bf16_rs(int lane, const float* xrow, bf16* orow, float* rs) {
    const GAS f32x4* xr = (const GAS f32x4*)xrow + lane;
    f32x4 v[4]; float s = 0.f;
#pragma unroll
    for (int j = 0; j < 4; ++j) { v[j] = xr[64 * j]; s += (v[j].x * v[j].x + v[j].y * v[j].y) + (v[j].z * v[j].z + v[j].w * v[j].w); }
    s = wave_sum(s);
    GAS unsigned long long* o8 = (GAS unsigned long long*)orow + lane;
#pragma unroll
    for (int j = 0; j < 4; ++j) o8[64 * j] = (unsigned long long)pk2(v[j].x, v[j].y) | ((unsigned long long)pk2(v[j].z, v[j].w) << 32);
    if (lane == 0) *rs = 1.0f / sqrtf(s * (1.0f / D) + EPS);
}

__device__ __forceinline__ void rows2_to_bf16_rs(int lane, const float* xa, const float* xb, bf16* oa, bf16* ob, float* ra, float* rb) {
    const GAS f32x4* pa = (const GAS f32x4*)xa + lane; const GAS f32x4* pb = (const GAS f32x4*)xb + lane;
    f32x4 va[4], vb[4]; float sa = 0.f, sb = 0.f;
#pragma unroll
    for (int j = 0; j < 4; ++j) { va[j] = pa[64 * j]; vb[j] = pb[64 * j]; }
#pragma unroll
    for (int j = 0; j < 4; ++j) { sa += (va[j].x * va[j].x + va[j].y * va[j].y) + (va[j].z * va[j].z + va[j].w * va[j].w); sb += (vb[j].x * vb[j].x + vb[j].y * vb[j].y) + (vb[j].z * vb[j].z + vb[j].w * vb[j].w); }
    sa = wave_sum(sa); sb = wave_sum(sb);
    GAS unsigned long long* qa = (GAS unsigned long long*)oa + lane; GAS unsigned long long* qb = (GAS unsigned long long*)ob + lane;
#pragma unroll
    for (int j = 0; j < 4; ++j) { qa[64 * j] = (unsigned long long)pk2(va[j].x, va[j].y) | ((unsigned long long)pk2(va[j].z, va[j].w) << 32); qb[64 * j] = (unsigned long long)pk2(vb[j].x, vb[j].y) | ((unsigned long long)pk2(vb[j].z, vb[j].w) << 32); }
    if (lane == 0) { *ra = 1.0f / sqrtf(sa * (1.0f / D) + EPS); *rb = 1.0f / sqrtf(sb * (1.0f / D) + EPS); }
}

__device__ __forceinline__ void copy_shift(const float* src, float* dst, int nbatch, int L, int RW, int gtid, int gthreads) {
    const unsigned per_b4 = (unsigned)(L - 1) * RW / 4, blk4 = (unsigned)L * RW / 4, shift4 = (unsigned)RW / 4, total = per_b4 * (unsigned)nbatch;
    const GAS f32x4* s4 = (const GAS f32x4*)src; GAS f32x4* d4 = (GAS f32x4*)dst;
    for (unsigned i0 = gtid; i0 < total; i0 += 4u * gthreads) { f32x4 v[4]; unsigned o[4];
#pragma unroll
        for (int q = 0; q < 4; ++q) { unsigned i = i0 + q * gthreads; i = i < total ? i : total - 1; const unsigned b = i / per_b4, e = i - b * per_b4; o[q] = b * blk4 + e; v[q] = __builtin_nontemporal_load(s4 + o[q] + shift4); }
#pragma unroll
        for (int q = 0; q < 4; ++q) __builtin_nontemporal_store(v[q], d4 + o[q]); }
}

__device__ __forceinline__ void p0_prologue(Frame& F, const Args& A) {
    unsigned char* ws = A.ws;
    LAS float* scr = (LAS float*)(F.lds + RING_OFF + F.wave * 16384);
    const int gw = F.vcu * NWAVES + F.wave, NGW = F.G * NWAVES;
    constexpr int I_GU = (D / 64) * (FF / 32), I_DN = (FF / 64) * (D / 32), I_IN = (D / 64) * (NIN / 32), I_SQ = (D / 64) * (D / 32), I_PP = (DPLE / 64) * (D / 32);
    constexpr int NITEMS = 4 * I_GU + 2 * I_DN + I_IN + 2 * I_SQ + I_PP;
    for (int it = gw; it < NITEMS; it += NGW) {
        int r = it;
        if (r < I_GU) { p0_transpose_item(A.in[10], D, FF, (bf16*)(ws + WS_WGU1), MAP_GATE, A.in[8], scr, r, F.lane); continue; } r -= I_GU;
        if (r < I_GU) { p0_transpose_item(A.in[11], D, FF, (bf16*)(ws + WS_WGU1), MAP_UP, A.in[8], scr, r, F.lane); continue; } r -= I_GU;
        if (r < I_DN) { p0_transpose_item(A.in[12], FF, D, (bf16*)(ws + WS_WD1), MAP_ID, nullptr, scr, r, F.lane); continue; } r -= I_DN;
        if (r < I_IN) { p0_transpose_item(A.in[15], D, NIN, (bf16*)(ws + WS_WIN), MAP_ROPE, A.in[13], scr, r, F.lane); continue; } r -= I_IN;
        if (r < I_SQ) { p0_transpose_item(A.in[17], D, D, (bf16*)(ws + WS_WOUT), MAP_ID, nullptr, scr, r, F.lane); continue; } r -= I_SQ;
        if (r < I_GU) { p0_transpose_item(A.in[20], D, FF, (bf16*)(ws + WS_WGU2), MAP_GATE, A.in[18], scr, r, F.lane); continue; } r -= I_GU;
        if (r < I_GU) { p0_transpose_item(A.in[21], D, FF, (bf16*)(ws + WS_WGU2), MAP_UP, A.in[18], scr, r, F.lane); continue; } r -= I_GU;
        if (r < I_DN) { p0_transpose_item(A.in[22], FF, D, (bf16*)(ws + WS_WD2), MAP_ID, nullptr, scr, r, F.lane); continue; } r -= I_DN;
        if (r < I_SQ) { p0_transpose_item(A.in[25], D, D, (bf16*)(ws + WS_WPG), MAP_ID, A.in[23], scr, r, F.lane); continue; } r -= I_SQ;
        p0_transpose_item(A.in[26], DPLE, D, (bf16*)(ws + WS_WPP), MAP_ID, nullptr, scr, r, F.lane);
    }
    bf16* XB = (bf16*)(ws + WS_XB); float* RS = (float*)(ws + WS_RS);
    for (int m = gw; m < MR; m += 2 * NGW) { const int m2 = (m + NGW < MR) ? m + NGW : m;
        const float* xr = (m < MP) ? A.in[0] + (size_t)m * D : A.in[1] + (size_t)(m - MP) * D; const float* xr2 = (m2 < MP) ? A.in[0] + (size_t)m2 * D : A.in[1] + (size_t)(m2 - MP) * D;
        rows2_to_bf16_rs(F.lane, xr, xr2, XB + (size_t)m * D, XB + (size_t)m2 * D, RS + m, RS + m2); }
    bf16* PB = (bf16*)(ws + WS_PB);
    for (int m0 = gw; m0 < MR; m0 += 4 * NGW) { f32x4 v[4]; int mm[4];
#pragma unroll
        for (int q = 0; q < 4; ++q) { const int m = (m0 + q * NGW < MR) ? m0 + q * NGW : m0; mm[q] = m; const float* pr = (m < MP) ? A.in[6] + (size_t)m * DPLE : A.in[7] + (size_t)(m - MP) * DPLE; v[q] = *((const GAS f32x4*)pr + F.lane); }
#pragma unroll
        for (int q = 0; q < 4; ++q) *((GAS unsigned long long*)(PB + (size_t)mm[q] * DPLE) + F.lane) = (unsigned long long)pk2(v[q].x, v[q].y) | ((unsigned long long)pk2(v[q].z, v[q].w) << 32); }
    { float* rope = (float*)(ws + WS_ROPE); const int gt = gw * 64 + F.lane, NGT = NGW * 64;
      for (int i = gt; i < 8193 * 32; i += NGT) { const int idx = i >> 5, d = i & 31; const float pos = (float)(idx < SEQ ? idx : PAST);
          const float inv = powf(10000.0f, -(float)d * (1.0f / 32.0f)); const float ang = pos * inv;
          rope[2 * i] = cosf(ang); rope[2 * i + 1] = sinf(ang); } }
    { const int gt = gw * 64 + F.lane, NGT = NGW * 64;
      copy_shift(A.in[4], A.out + O_BKS, MS, LB, 128, gt, NGT);
      copy_shift(A.in[5], A.out + O_BVS, MS, LB, 128, gt, NGT); }
}

constexpr int CHUNK_OPS = 32, CHUNKS_PER_BUF = 128, NCHUNKS = 256 * CHUNKS_PER_BUF, OPS_PER_BUF = 4094;
__device__ __forceinline__ void side_copy(const Args& A, gu32* ctl, int lane, int done_word, unsigned done_target) {
    for (;;) {
        unsigned id = 0; if (lane == 0) id = __hip_atomic_fetch_add(ctl + CW_CUR, 1u, RLX_AGENT); id = (unsigned)__builtin_amdgcn_readfirstlane((int)id);
        if (id >= (unsigned)NCHUNKS) break;
        const int buf = (int)(id >> 7), sub = (int)(id & 127), op0 = sub * CHUNK_OPS, nops = (OPS_PER_BUF - op0) < CHUNK_OPS ? (OPS_PER_BUF - op0) : CHUNK_OPS;
        const GAS f32x4* s4 = (const GAS f32x4*)(A.in[2 + (buf >> 7)] + (size_t)(buf & 127) * LA * 512 + 512) + (size_t)op0 * 64 + lane;
        GAS f32x4* d4 = (GAS f32x4*)(A.out + ((buf >> 7) ? O_AVS : O_AKS) + (size_t)(buf & 127) * LA * 512) + (size_t)op0 * 64 + lane;
        f32x4 v[CHUNK_OPS];
#pragma unroll
        for (int q = 0; q < CHUNK_OPS; ++q) { const int qq = q < nops ? q : nops - 1; v[q] = __builtin_nontemporal_load(s4 + qq * 64); }
#pragma unroll
        for (int q = 0; q < CHUNK_OPS; ++q) { const int qq = q < nops ? q : nops - 1; __builtin_nontemporal_store(v[q], d4 + qq * 64); }
        if (done_word >= 0 && (unsigned)__builtin_amdgcn_readfirstlane((int)__hip_atomic_load(ctl + done_word, RLX_AGENT)) >= done_target) break;
    }
}

#ifdef PROBE_COPYX2
__device__ __forceinline__ void side_copy2(const Args& A, gu32* ctl, int lane) {
    for (;;) {
        unsigned id = 0; if (lane == 0) id = __hip_atomic_fetch_add(ctl + CW_CUR + 64 * 20, 1u, RLX_AGENT); id = (unsigned)__builtin_amdgcn_readfirstlane((int)id);
        if (id >= (unsigned)NCHUNKS) break;
        const int buf = (int)(id >> 7), sub = (int)(id & 127), op0 = sub * CHUNK_OPS, nops = (OPS_PER_BUF - op0) < CHUNK_OPS ? (OPS_PER_BUF - op0) : CHUNK_OPS;
        const GAS f32x4* s4 = (const GAS f32x4*)(A.in[2 + (buf >> 7)] + (size_t)(buf & 127) * LA * 512 + 512) + (size_t)op0 * 64 + lane;
        GAS f32x4* d4 = (GAS f32x4*)(A.out + ((buf >> 7) ? O_AVS : O_AKS) + (size_t)(buf & 127) * LA * 512) + (size_t)op0 * 64 + lane;
        f32x4 v[CHUNK_OPS];
#pragma unroll
        for (int q = 0; q < CHUNK_OPS; ++q) { const int qq = q < nops ? q : nops - 1; v[q] = __builtin_nontemporal_load(s4 + qq * 64); }
#pragma unroll
        for (int q = 0; q < CHUNK_OPS; ++q) { const int qq = q < nops ? q : nops - 1; __builtin_nontemporal_store(v[q], d4 + qq * 64); }
    }
}
#endif
template <int MODE, int NSPLIT> __device__ __forceinline__ void norm_phase(Frame& F, const Args& A, const float* gpost, float coef) {
    unsigned char* ws = A.ws;
    const bf16* Y = (const bf16*)(ws + WS_Y); bf16* XB = (bf16*)(ws + WS_XB); float* RS = (float*)(ws + WS_RS);
    const float* SL = (const float*)(ws + WS_SLAB); const bf16* PP = (const bf16*)(ws + WS_PP);
    int lane_ = F.lane; asm volatile("" : "+v"(lane_));
    const int gw = F.vcu * NWAVES + F.wave, NGW = F.G * NWAVES, lane = lane_;
    f32x4 g[4];
#pragma unroll
    for (int j = 0; j < 4; ++j) g[j] = *((const GAS f32x4*)gpost + lane + 64 * j) * coef;
    for (int m = gw; m < MR; m += NGW) {
        const float* hsrc = (m < MP) ? A.in[0] + (size_t)m * D : A.in[1] + (size_t)(m - MP) * D;
        float* hdst = (m < MP) ? A.out + O_YP + (size_t)m * D : A.out + O_YS + (size_t)(m - MP) * D;
        f32x4 y[4], h[4]; float s = 0.f;
        if (m < MP) {
            const GAS unsigned long long* y8 = (const GAS unsigned long long*)(Y + (size_t)m * D) + lane;
#pragma unroll
            for (int j = 0; j < 4; ++j) { const unsigned long long w = y8[64 * j]; const unsigned lo = (unsigned)w, hi = (unsigned)(w >> 32);
                y[j] = (f32x4){bf_lo(lo), bf_hi(lo), bf_lo(hi), bf_hi(hi)}; }
        } else {
#pragma unroll
            for (int j = 0; j < 4; ++j) y[j] = (f32x4){0.f, 0.f, 0.f, 0.f};
#pragma unroll 1
            for (int ks = 0; ks < NSPLIT; ++ks) { const GAS f32x4* sp = (const GAS f32x4*)(SL + ((size_t)ks * 128 + (m - MP)) * D) + lane;
#pragma unroll
                for (int j = 0; j < 4; ++j) y[j] = y[j] + sp[64 * j]; }
            if (MODE == 2) { const float r = RS[m]; const GAS unsigned long long* p8 = (const GAS unsigned long long*)(PP + (size_t)m * D) + lane;
#pragma unroll
                for (int j = 0; j < 4; ++j) { const unsigned long long w = p8[64 * j]; const unsigned lo = (unsigned)w, hi = (unsigned)(w >> 32);
                    const f32x4 pp = (f32x4){bf_lo(lo), bf_hi(lo), bf_lo(hi), bf_hi(hi)};
                    y[j].x = pp.x / (1.0f + __expf(-r * y[j].x)); y[j].y = pp.y / (1.0f + __expf(-r * y[j].y)); y[j].z = pp.z / (1.0f + __expf(-r * y[j].z)); y[j].w = pp.w / (1.0f + __expf(-r * y[j].w)); } }
        }
#pragma unroll
        for (int j = 0; j < 4; ++j) { s += (y[j].x * y[j].x + y[j].y * y[j].y) + (y[j].z * y[j].z + y[j].w * y[j].w);
            if (MODE == 0) h[j] = *((const GAS f32x4*)hsrc + lane + 64 * j);
            else { const unsigned long long w = *((const GAS unsigned long long*)(XB + (size_t)m * D) + lane + 64 * j); const unsigned lo = (unsigned)w, hi = (unsigned)(w >> 32);
                h[j] = (f32x4){bf_lo(lo), bf_hi(lo), bf_lo(hi), bf_hi(hi)}; } }
        const float rstd = 1.0f / sqrtf(wave_sum(s) * (1.0f / D) + EPS);
        float s2 = 0.f;
#pragma unroll
        for (int j = 0; j < 4; ++j) { h[j] = h[j] + g[j] * (y[j] * rstd); s2 += (h[j].x * h[j].x + h[j].y * h[j].y) + (h[j].z * h[j].z + h[j].w * h[j].w);
            if (MODE == 2) *((GAS f32x4*)hdst + lane + 64 * j) = h[j]; }
        if (MODE != 2) {
            s2 = wave_sum(s2);
            GAS unsigned long long* o8 = (GAS unsigned long long*)(XB + (size_t)m * D) + lane;
#pragma unroll
            for (int j = 0; j < 4; ++j) o8[64 * j] = (unsigned long long)pk2(h[j].x, h[j].y) | ((unsigned long long)pk2(h[j].z, h[j].w) << 32);
            if (lane == 0) RS[m] = 1.0f / sqrtf(s2 * (1.0f / D) + EPS);
        }
    }
}

__device__ __forceinline__ int crow(int r, int hi) { return (r & 3) + 8 * (r >> 2) + 4 * hi; }
__device__ __forceinline__ unsigned cvtpk(float lo, float hi) { unsigned r; asm volatile("v_cvt_pk_bf16_f32 %0, %1, %2" : "=v"(r) : "v"(lo), "v"(hi)); return r; }
__device__ __forceinline__ float xhalf_max(float v) { return fmaxf(v, __shfl_xor(v, 32)); }
__device__ __forceinline__ float xhalf_sum(float v) { return v + __shfl_xor(v, 32); }
__device__ __forceinline__ s16x4 vtr(const LAS unsigned char* p) { typedef short v4i16_t __attribute__((ext_vector_type(4))); return __builtin_bit_cast(s16x4, __builtin_amdgcn_ds_read_tr16_b64_v4i16((LAS v4i16_t*)p)); }

template <int MODE> __device__ __forceinline__ void attn_epilogue(const f32x16& o0, const f32x16& o1, float m_run, float l_run, size_t qrow, int hi, int head,
                                                                  bf16* OP, float* LS, const bf16* OP2, const bf16* OP3, const float* LS2, const float* LS3, bf16* ATT, int acol) {
    if (MODE == 0) {
        const float inv = 1.0f / l_run;
        bf16* op = OP + qrow * 512 + head * 64 + 4 * hi;
#pragma unroll
        for (int a = 0; a < 4; ++a) {
            u32x2g w0, w1; w0.x = cvtpk(o0[4 * a] * inv, o0[4 * a + 1] * inv); w0.y = cvtpk(o0[4 * a + 2] * inv, o0[4 * a + 3] * inv);
            w1.x = cvtpk(o1[4 * a] * inv, o1[4 * a + 1] * inv); w1.y = cvtpk(o1[4 * a + 2] * inv, o1[4 * a + 3] * inv);
            *(GAS u32x2g*)(op + 8 * a) = w0; *(GAS u32x2g*)(op + 32 + 8 * a) = w1; }
        if (hi == 0) LS[qrow * 8 + head] = m_run + __builtin_amdgcn_logf(l_run);
    } else if (MODE == 1) {
        const float l2 = LS2[qrow * 8 + head], l3 = LS3[qrow * 8 + head];
        const float M = fmaxf(m_run, fmaxf(l2, l3));
        const float w1 = __builtin_amdgcn_exp2f(m_run - M), w2 = __builtin_amdgcn_exp2f(l2 - M), w3 = __builtin_amdgcn_exp2f(l3 - M);
        const float inv = 1.0f / (l_run * w1 + w2 + w3);
        const float c1 = w1 * inv, c2 = w2 * inv, c3 = w3 * inv;
        const bf16* p2 = OP2 + qrow * 512 + head * 64 + 4 * hi; const bf16* p3 = OP3 + qrow * 512 + head * 64 + 4 * hi;
        bf16* op = ATT + qrow * D + acol + 4 * hi;
#pragma unroll
        for (int a = 0; a < 4; ++a) {
            const u32x2g a2 = *(const GAS u32x2g*)(p2 + 8 * a), b2 = *(const GAS u32x2g*)(p2 + 32 + 8 * a), a3 = *(const GAS u32x2g*)(p3 + 8 * a), b3 = *(const GAS u32x2g*)(p3 + 32 + 8 * a);
            float x0[4], x1[4];
            x0[0] = o0[4 * a] * c1 + bf_lo(a2.x) * c2 + bf_lo(a3.x) * c3; x0[1] = o0[4 * a + 1] * c1 + bf_hi(a2.x) * c2 + bf_hi(a3.x) * c3;
            x0[2] = o0[4 * a + 2] * c1 + bf_lo(a2.y) * c2 + bf_lo(a3.y) * c3; x0[3] = o0[4 * a + 3] * c1 + bf_hi(a2.y) * c2 + bf_hi(a3.y) * c3;
            x1[0] = o1[4 * a] * c1 + bf_lo(b2.x) * c2 + bf_lo(b3.x) * c3; x1[1] = o1[4 * a + 1] * c1 + bf_hi(b2.x) * c2 + bf_hi(b3.x) * c3;
            x1[2] = o1[4 * a + 2] * c1 + bf_lo(b2.y) * c2 + bf_lo(b3.y) * c3; x1[3] = o1[4 * a + 3] * c1 + bf_hi(b2.y) * c2 + bf_hi(b3.y) * c3;
            u32x2g w0, w1v; w0.x = cvtpk(x0[0], x0[1]); w0.y = cvtpk(x0[2], x0[3]); w1v.x = cvtpk(x1[0], x1[1]); w1v.y = cvtpk(x1[2], x1[3]);
            *(GAS u32x2g*)(op + 8 * a) = w0; *(GAS u32x2g*)(op + 32 + 8 * a) = w1v; }
    } else {
        const float inv = 1.0f / l_run;
        bf16* op = ATT + qrow * D + acol + 4 * hi;
#pragma unroll
        for (int a = 0; a < 4; ++a) {
            u32x2g w0, w1; w0.x = cvtpk(o0[4 * a] * inv, o0[4 * a + 1] * inv); w0.y = cvtpk(o0[4 * a + 2] * inv, o0[4 * a + 3] * inv);
            w1.x = cvtpk(o1[4 * a] * inv, o1[4 * a + 1] * inv); w1.y = cvtpk(o1[4 * a + 2] * inv, o1[4 * a + 3] * inv);
            *(GAS u32x2g*)(op + 8 * a) = w0; *(GAS u32x2g*)(op + 32 + 8 * a) = w1; }
    }
}

__device__ __forceinline__ int kv_swz(int r) { return (((r >> 1) & 1) << 2) | ((r >> 2) & 3); }
struct AU { int b, qcol, kcol, vcol, dil, rho, blk, head, acol, mode; };
__device__ __forceinline__ void attn_prefetch(const bf16* QKV, const AU& u, int tid, int lane, int w, bf16x8 (&kk)[6], bf16x8 (&vv)[6], bf16x8 (&qf)[4]) {
    const GAS unsigned char* qb = (const GAS unsigned char*)QKV; const unsigned rowb = (unsigned)u.b * SEQ;
    const int s_lo = 256 * u.blk - 128, ch = tid & 7, r0 = tid >> 3, r32 = lane & 31, hi = lane >> 5, sq0 = 256 * u.blk + 32 * w;
    { const unsigned qo = ((rowb + u.rho + u.dil * (sq0 + r32)) * NIN + u.qcol + hi * 32) * 2u;
#pragma unroll
      for (int d0 = 0; d0 < 4; ++d0) qf[d0] = *(const GAS bf16x8*)(qb + qo + d0 * 16); }
#pragma unroll
    for (int q = 0; q < 6; ++q) { int s = s_lo + 64 * q + r0; s = s < 0 ? 0 : s; const unsigned ro = ((rowb + u.rho + u.dil * s) * NIN) * 2u + ch * 16;
        kk[q] = *(const GAS bf16x8*)(qb + ro + u.kcol * 2); vv[q] = *(const GAS bf16x8*)(qb + ro + u.vcol * 2); }
}
__device__ __forceinline__ void attn_stage(LAS unsigned char* lds, int tid, const bf16x8 (&kk)[6], const bf16x8 (&vv)[6]) {
    const int ch = tid & 7, r0 = tid >> 3;
#pragma unroll
    for (int q = 0; q < 6; ++q) { const int r = 64 * q + r0; const int o = r * 128 + ((ch ^ kv_swz(r)) << 4); *(LAS bf16x8*)(lds + o) = kk[q]; *(LAS bf16x8*)(lds + 49152 + o) = vv[q]; }
}
template <int MODE> __device__ __forceinline__ void attn_compute(const AU& u, const bf16x8 (&qf)[4], LAS unsigned char* lds, int lane, int w,
                                                                 bf16* OP, float* LS, float sinkl, const bf16* OP2, const bf16* OP3, const float* LS2, const float* LS3, bf16* ATT) {
    const unsigned rowb = (unsigned)u.b * SEQ; const int dil = u.dil, rho = u.rho, head = u.head, acol = u.acol;
    LAS unsigned char* Kl = lds; LAS unsigned char* Vl = lds + 49152;
    const int r32 = lane & 31, hi = lane >> 5, sq0 = 256 * u.blk + 32 * w;
    float m_run = (MODE == 2) ? sinkl : -INFINITY, l_run = (MODE == 2) ? 1.0f : 0.0f;
    f32x16 o0 = {}, o1 = {};
    int j0 = (128 - sq0) / 32; j0 = j0 < 0 ? 0 : j0;
    const int ksw = kv_swz(r32);
    const LAS unsigned char* kr = Kl + (32 * w + r32) * 128;
    int koff[4];
#pragma unroll
    for (int d0 = 0; d0 < 4; ++d0) koff[d0] = (((hi * 4 + d0) ^ ksw) << 4);
    const int g = lane >> 4, tq = (lane & 15) >> 2, tp = lane & 3, trow = 4 * (g >> 1) + tq;
    const int sw0 = (((trow >> 1) & 1) << 2) | (trow >> 2);
    const LAS unsigned char* vr = Vl + (32 * w + trow) * 128 + 8 * (tp & 1);
    const int vc = 2 * (g & 1) + (tp >> 1);
    const int vo00 = ((vc ^ sw0) << 4), vo01 = (((vc ^ sw0) ^ 2) << 4), vo10 = (((4 + vc) ^ sw0) << 4), vo11 = ((((4 + vc) ^ sw0) ^ 2) << 4);
#pragma unroll 1
    for (int j = j0; j < 5; ++j) {
        const LAS unsigned char* kt = kr + j * 4096; const LAS unsigned char* vtl = vr + j * 4096;
        f32x16 s = {};
#pragma unroll
        for (int d0 = 0; d0 < 4; ++d0) { const bf16x8 kf = *(const LAS bf16x8*)(kt + koff[d0]); s = __builtin_amdgcn_mfma_f32_32x32x16_bf16(kf, qf[d0], s, 0, 0, 0); }
        if (j == 0 || j == 4) {
            int qrel = r32 - 4 * hi; asm volatile("" : "+v"(qrel));
            if (j == 0) {
#pragma unroll
                for (int r = 0; r < 16; ++r) s[r] = ((r & 3) + 8 * (r >> 2) < qrel) ? -INFINITY : s[r];
            } else {
#pragma unroll
                for (int r = 0; r < 16; ++r) s[r] = ((r & 3) + 8 * (r >> 2) > qrel) ? -INFINITY : s[r];
            }
        }
        float mx = s[0];
#pragma unroll
        for (int r = 1; r < 16; ++r) mx = fmaxf(mx, s[r]);
        mx = xhalf_max(mx);
        const float m_new = fmaxf(m_run, mx);
        const float alpha = __builtin_amdgcn_exp2f(m_run - m_new);
        float rs = 0.f;
#pragma unroll
        for (int r = 0; r < 16; ++r) { s[r] = __builtin_amdgcn_exp2f(s[r] - m_new); rs += s[r]; }
        rs = xhalf_sum(rs);
        l_run = l_run * alpha + rs; m_run = m_new;
#pragma unroll
        for (int r = 0; r < 16; ++r) { o0[r] *= alpha; o1[r] *= alpha; }
        bf16x8 pk[2];
#pragma unroll
        for (int sl = 0; sl < 2; ++sl) { v4u wv; wv.x = cvtpk(s[8 * sl + 0], s[8 * sl + 1]); wv.y = cvtpk(s[8 * sl + 2], s[8 * sl + 3]); wv.z = cvtpk(s[8 * sl + 4], s[8 * sl + 5]); wv.w = cvtpk(s[8 * sl + 6], s[8 * sl + 7]);
            pk[sl] = __builtin_bit_cast(bf16x8, wv); }
#pragma unroll
        for (int sl = 0; sl < 2; ++sl) {
            const s16x4 a_lo = vtr(vtl + 2048 * sl + vo00), a_hi = vtr(vtl + 2048 * sl + 1024 + vo01);
            const s16x4 b_lo = vtr(vtl + 2048 * sl + vo10), b_hi = vtr(vtl + 2048 * sl + 1024 + vo11);
            const bf16x8 va = (bf16x8){a_lo[0], a_lo[1], a_lo[2], a_lo[3], a_hi[0], a_hi[1], a_hi[2], a_hi[3]};
            const bf16x8 vb = (bf16x8){b_lo[0], b_lo[1], b_lo[2], b_lo[3], b_hi[0], b_hi[1], b_hi[2], b_hi[3]};
            o0 = __builtin_amdgcn_mfma_f32_32x32x16_bf16(va, pk[sl], o0, 0, 0, 0);
            o1 = __builtin_amdgcn_mfma_f32_32x32x16_bf16(vb, pk[sl], o1, 0, 0, 0);
        }
    }
    attn_epilogue<MODE>(o0, o1, m_run, l_run, (size_t)(rowb + rho + dil * (sq0 + r32)), hi, head, OP, LS, OP2, OP3, LS2, LS3, ATT, acol);
}

struct SPart { float m, l; f32x4 o; };
__device__ __forceinline__ void sample_scan(const float* kbase, const float* vbase, const float* knew, const float* vnew, int L, int rstride, int dil, const f32x4 q4, int lane, float& m_run, float& l_run, f32x4& o4) {
    const int sub = lane & 15, ks = lane >> 4;
#pragma unroll 11
    for (int st = 0; st < 33; ++st) {
        const int k = 4 * st + ks; const bool valid = k <= 128; const int idx = L - dil * (valid ? k : 128);
        const float* kp = (idx == L) ? knew : kbase + (size_t)idx * rstride; const float* vp = (idx == L) ? vnew : vbase + (size_t)idx * rstride;
        const f32x4 k4 = *((const GAS f32x4*)kp + sub), v4 = *((const GAS f32x4*)vp + sub);
        float s = (k4.x * q4.x + k4.y * q4.y) + (k4.z * q4.z + k4.w * q4.w);
        s += __shfl_xor(s, 1); s += __shfl_xor(s, 2); s += __shfl_xor(s, 4); s += __shfl_xor(s, 8);
        if (!valid) s = -INFINITY;
        const float m_new = fmaxf(m_run, s); const float alpha = __builtin_amdgcn_exp2f(m_run - m_new), p = __builtin_amdgcn_exp2f(s - m_new);
        l_run = l_run * alpha + p; o4 = o4 * alpha + v4 * p; m_run = m_new;
    }
}
__device__ __forceinline__ void sample_merge4(float& m_run, float& l_run, f32x4& o4) {
#pragma unroll
    for (int x = 16; x <= 32; x <<= 1) {
        const float mo = __shfl_xor(m_run, x), lo = __shfl_xor(l_run, x);
        f32x4 oo; oo.x = __shfl_xor(o4.x, x); oo.y = __shfl_xor(o4.y, x); oo.z = __shfl_xor(o4.z, x); oo.w = __shfl_xor(o4.w, x);
        const float M = fmaxf(m_run, mo), a = __builtin_amdgcn_exp2f(m_run - M), c = __builtin_amdgcn_exp2f(mo - M);
        l_run = l_run * a + lo * c; o4 = o4 * a + oo * c; m_run = M;
    }
}

__device__ __forceinline__ bool decode_a(int U, AU& u) {
    if (U >= 1536) return false;
    if (U < 1024) { const int pd = U >> 9, rem = U & 511, h = (rem >> 5) & 7, x = rem & 31; u.b = rem >> 8; u.dil = pd ? 16 : 4; u.rho = pd ? (x >> 1) : (x >> 3); u.blk = pd ? (x & 1) : (x & 7);
        u.qcol = 64 * h; u.kcol = 512 + 64 * h; u.vcol = 1024 + 64 * h; u.head = h; u.acol = 0; u.mode = pd; }
    else { const int rem = U - 1024, hb = (rem >> 5) & 7; u.b = rem >> 8; u.dil = 1; u.rho = 0; u.blk = rem & 31;
        u.qcol = 1536 + 64 * hb; u.kcol = 2048 + 64 * (hb >> 2); u.vcol = 2176 + 64 * (hb >> 2); u.head = hb; u.acol = 512 + 64 * hb; u.mode = 2; }
    return true;
}
__device__ __forceinline__ bool decode_b(int U, AU& u) {
    if (U >= 512) return false;
    const int h = (U >> 5) & 7; u.b = U >> 8; u.dil = 1; u.rho = 0; u.blk = U & 31; u.qcol = 64 * h; u.kcol = 512 + 64 * h; u.vcol = 1024 + 64 * h; u.head = h; u.acol = 64 * h; u.mode = 3; return true;
}
__device__ __forceinline__ void attention_phase_a(Frame& F, const Args& A) {
    unsigned char* ws = A.ws;
    const bf16* QKV = (const bf16*)(ws + WS_QKV); bf16* ATT = (bf16*)(ws + WS_ATT);
    bf16* OP2 = (bf16*)(ws + WS_OP2); bf16* OP3 = (bf16*)(ws + WS_OP3); float* LS2 = (float*)(ws + WS_LS2); float* LS3 = (float*)(ws + WS_LS3);
    const int lane = F.lane, w = F.wave, tid = F.tid;
    LAS unsigned char* lds = F.lds + RING_OFF;
    LAS float* spart = (LAS float*)(F.lds + RING_OFF + 98304);
    const float* sinks = A.in[16];
    { AU cur, nxt; bf16x8 kk[6], vv[6], qn[4]; int k = 0;
      bool have = decode_a(F.vcu, cur);
      if (have) attn_prefetch(QKV, cur, tid, lane, w, kk, vv, qn);
      while (have) {
          bf16x8 qf[4];
#pragma unroll
          for (int d0 = 0; d0 < 4; ++d0) qf[d0] = qn[d0];
          __syncthreads(); attn_stage(lds, tid, kk, vv); __syncthreads();
          ++k; const bool hn = decode_a(F.vcu + k * F.G, nxt);
          if (hn) attn_prefetch(QKV, nxt, tid, lane, w, kk, vv, qn);
          if (cur.mode == 2) attn_compute<2>(cur, qf, lds, lane, w, nullptr, nullptr, sinks[cur.head] * 1.4426950408889634f, nullptr, nullptr, nullptr, nullptr, ATT);
          else attn_compute<0>(cur, qf, lds, lane, w, cur.mode ? OP3 : OP2, cur.mode ? LS3 : LS2, 0.f, nullptr, nullptr, nullptr, nullptr, nullptr);
          cur = nxt; have = hn; }
    }
#ifdef PROBE_SAMPLEX2
    for (int rep = 0; rep < 2; ++rep)
#endif
    for (int u = F.vcu; u < 256; u += F.G) {
#pragma unroll 1
        for (int k = 0; k < 2; ++k) { const int task = w + 8 * k;
            int lane_s = lane; asm volatile("" : "+v"(lane_s)); const int sub = lane_s & 15;
            if (task < 12) {
                const int pair = 4 * u + task / 3, pat = task % 3, sb = pair >> 3, sh = pair & 7, dil = pat == 0 ? 1 : (pat == 1 ? 4 : 16);
                const bf16* qp = QKV + (size_t)(MP + sb) * NIN + 64 * sh + 4 * sub; const unsigned long long qw = *(const GAS unsigned long long*)qp;
                const f32x4 q4 = (f32x4){bf_lo((unsigned)qw), bf_hi((unsigned)qw), bf_lo((unsigned)(qw >> 32)), bf_hi((unsigned)(qw >> 32))};
                float m_run = -INFINITY, l_run = 0.f; f32x4 o4 = {0.f, 0.f, 0.f, 0.f};
                sample_scan(A.in[2] + ((size_t)sb * LA * 8 + sh) * 64, A.in[3] + ((size_t)sb * LA * 8 + sh) * 64,
                            A.out + O_AKS + ((size_t)(sb * LA + LA - 1) * 8 + sh) * 64, A.out + O_AVS + ((size_t)(sb * LA + LA - 1) * 8 + sh) * 64, LA, 512, dil, q4, lane_s, m_run, l_run, o4);
                sample_merge4(m_run, l_run, o4);
                if (lane_s < 16) { LAS float* sp = spart + (task * 16 + sub) * 6; sp[0] = m_run; sp[1] = l_run; sp[2] = o4.x; sp[3] = o4.y; sp[4] = o4.z; sp[5] = o4.w; }
            } else {
                const int pair = 4 * u + (task - 12), sb = pair >> 3, sh = pair & 7, kv = sh >> 2;
                const bf16* qp = QKV + (size_t)(MP + sb) * NIN + 1536 + 64 * sh + 4 * sub; const unsigned long long qw = *(const GAS unsigned long long*)qp;
                const f32x4 q4 = (f32x4){bf_lo((unsigned)qw), bf_hi((unsigned)qw), bf_lo((unsigned)(qw >> 32)), bf_hi((unsigned)(qw >> 32))};
                float m_run = (lane_s < 16) ? sinks[sh] * 1.4426950408889634f : -INFINITY, l_run = (lane_s < 16) ? 1.0f : 0.f; f32x4 o4 = {0.f, 0.f, 0.f, 0.f};
                sample_scan(A.in[4] + ((size_t)sb * LB * 2 + kv) * 64, A.in[5] + ((size_t)sb * LB * 2 + kv) * 64,
                            A.out + O_BKS + ((size_t)(sb * LB + LB - 1) * 2 + kv) * 64, A.out + O_BVS + ((size_t)(sb * LB + LB - 1) * 2 + kv) * 64, LB, 128, 1, q4, lane_s, m_run, l_run, o4);
                sample_merge4(m_run, l_run, o4);
                if (lane_s < 16) { const float inv = 1.0f / l_run; bf16* op = ATT + (size_t)(MP + sb) * D + 512 + 64 * sh + 4 * sub;
                    *(GAS unsigned long long*)op = (unsigned long long)cvtpk(o4.x * inv, o4.y * inv) | ((unsigned long long)cvtpk(o4.z * inv, o4.w * inv) << 32); }
            }
        }
        __syncthreads();
        int lane_m = lane; asm volatile("" : "+v"(lane_m));
        if (w < 4 && lane_m < 16) {
            const int pair = 4 * u + w, sb = pair >> 3, sh = pair & 7, sub = lane_m;
            float m_run = -INFINITY, l_run = 0.f; f32x4 o4 = {0.f, 0.f, 0.f, 0.f};
#pragma unroll
            for (int p = 0; p < 3; ++p) { const LAS float* sp = spart + ((3 * w + p) * 16 + sub) * 6; const float mo = sp[0], lo = sp[1]; const f32x4 oo = (f32x4){sp[2], sp[3], sp[4], sp[5]};
                const float M = fmaxf(m_run, mo), a = __builtin_amdgcn_exp2f(m_run - M), c = __builtin_amdgcn_exp2f(mo - M);
                l_run = l_run * a + lo * c; o4 = o4 * a + oo * c; m_run = M; }
            const float inv = 1.0f / l_run; bf16* op = ATT + (size_t)(MP + sb) * D + 64 * sh + 4 * sub;
            *(GAS unsigned long long*)op = (unsigned long long)cvtpk(o4.x * inv, o4.y * inv) | ((unsigned long long)cvtpk(o4.z * inv, o4.w * inv) << 32);
        }
        __syncthreads();
    }
}
__device__ __forceinline__ void attention_phase_b(Frame& F, const Args& A) {
    unsigned char* ws = A.ws;
    const bf16* QKV = (const bf16*)(ws + WS_QKV); bf16* ATT = (bf16*)(ws + WS_ATT);
    const bf16* OP2 = (const bf16*)(ws + WS_OP2); const bf16* OP3 = (const bf16*)(ws + WS_OP3); const float* LS2 = (const float*)(ws + WS_LS2); const float* LS3 = (const float*)(ws + WS_LS3);
    LAS unsigned char* lds = F.lds + RING_OFF; const int lane = F.lane, w = F.wave, tid = F.tid;
    AU cur, nxt; bf16x8 kk[6], vv[6], qn[4]; int k = 0;
    bool have = decode_b(F.vcu, cur);
    if (have) attn_prefetch(QKV, cur, tid, lane, w, kk, vv, qn);
    while (have) {
        bf16x8 qf[4];
#pragma unroll
        for (int d0 = 0; d0 < 4; ++d0) qf[d0] = qn[d0];
        __syncthreads(); attn_stage(lds, tid, kk, vv); __syncthreads();
        ++k; const bool hn = decode_b(F.vcu + k * F.G, nxt);
        if (hn) attn_prefetch(QKV, nxt, tid, lane, w, kk, vv, qn);
        attn_compute<1>(cur, qf, lds, lane, w, nullptr, nullptr, 0.f, OP2, OP3, LS2, LS3, ATT);
        cur = nxt; have = hn; }
}

__global__ void __launch_bounds__(NWAVES * 64, 2) fwd_kernel(Args args) {
    extern __shared__ __attribute__((aligned(16))) unsigned char lds[];
    Frame F;
    F.lds = (LAS unsigned char*)lds;
    F.MISC = (volatile LAS unsigned*)(F.lds + MISC_OFF);
    F.tid = threadIdx.x; F.lane = F.tid & 63; F.wave = __builtin_amdgcn_readfirstlane(F.tid >> 6);
    F.G = gridDim.x; { const int bx = blockIdx.x; F.vcu = (F.G % 8 == 0) ? (bx % 8) * (F.G / 8) + bx / 8 : bx; }
    F.ctl = (gu32*)(args.ws + WS_CTL);
    for (int u = F.tid; u < (LDS_BYTES - LDSCTL_OFF) / 4; u += NWAVES * 64) ((LAS unsigned*)(F.lds + LDSCTL_OFF))[u] = 0u;
    __syncthreads();
    XcdBarrier bar = xcd_barrier_post((unsigned*)(F.ctl + CW_BAR), F.MISC + 8);
#define GRID_BAR() xcd_barrier(bar)

#define XB ((bf16*)(args.ws + WS_XB))
#define RS ((float*)(args.ws + WS_RS))
#define ACT ((bf16*)(args.ws + WS_ACT))
#define Y ((bf16*)(args.ws + WS_Y))
#define QKV ((bf16*)(args.ws + WS_QKV))
#define ATT ((bf16*)(args.ws + WS_ATT))
#define PB ((bf16*)(args.ws + WS_PB))
#define PP ((bf16*)(args.ws + WS_PP))

    const int cpair = (int)blockIdx.x < 256 ? (int)blockIdx.x : 255;
    F.copy_cur = (int)blockIdx.x < 256 ? 0 : 4094;
#define COPY_SRC ((const unsigned char*)(args.in[2 + (cpair >> 7)] + (size_t)(cpair & 127) * LA * 512 + 512))
#define COPY_DST ((unsigned char*)(args.out + ((cpair >> 7) ? O_AVS : O_AKS) + (size_t)(cpair & 127) * LA * 512))
#define GEMM_PHASE(EPI, NG_, A_, B_, N_, K_, NSPLIT_, ...) do { pg8::Gemm g{A_, (const bf16*)(args.ws + B_), MT, N_, K_}; pg8::SampleOrder S; S.init(MP, N_, K_, NSPLIT_, NG_, (int)blockIdx.x); \
      pg8::EPI E{__VA_ARGS__}; pg8::StreamCopy4 C; C.src = COPY_SRC; C.dst = COPY_DST; C.cur = F.copy_cur; C.tw = F.wave & 3; C.last = 4093; C.lane_off = (unsigned)F.lane * 16u; \
      pg8::gemm_phase_rs<pg8::EPI, pg8::SampleOrder>(F.lds + RING_OFF, g, S, E, C); F.copy_cur = C.cur; } while (0)
    const int NG1 = F.G, NG3 = F.G;
#define SIGNAL_DONE(k) do { if (F.tid == 0) __hip_atomic_fetch_add(F.ctl + CW_DONE + 64 * (k), 1u, RLX_AGENT); } while (0)

#ifndef SKIP_P0
    p0_prologue(F, args);
#endif
#ifdef PROBE_P0X2
    GRID_BAR();
    p0_prologue(F, args);
#endif
    GRID_BAR();
#ifndef SKIP_P1
    if ((int)blockIdx.x < NG1) { GEMM_PHASE(EpiSwiGLU, NG1, XB, WS_WGU1, 2 * FF, D, 1, ACT, FF, RS); SIGNAL_DONE(0); }
#endif
    GRID_BAR();
#ifdef PROBE_P1X2
    GEMM_PHASE(EpiSwiGLU, F.G, XB, WS_WGU1, 2 * FF, D, 1, ACT, FF, RS);
    GRID_BAR();
#endif
#ifdef PROBE_P2X2
    GEMM_PHASE(EpiPlain, F.G, ACT, WS_WD1, D, FF, 11, Y, D, (float*)(args.ws + WS_SLAB));
    GRID_BAR();
#endif
#ifndef SKIP_P2
    GEMM_PHASE(EpiPlain, F.G, ACT, WS_WD1, D, FF, 11, Y, D, (float*)(args.ws + WS_SLAB));
#endif
    GRID_BAR();
#ifndef SKIP_NORM
    norm_phase<0, 11>(F, args, args.in[9], 0.5f);
#endif
    GRID_BAR();
#ifndef SKIP_P3
    if ((int)blockIdx.x < NG3) {
        GEMM_PHASE(EpiRope, NG3, XB, WS_WIN, NIN, D, 1, QKV, RS, (const float*)(args.ws + WS_ROPE), args.out);
        GEMM_PHASE(EpiPlain, NG3, PB, WS_WPP, D, DPLE, 1, PP, D, nullptr);
#ifdef PROBE_P358
        GRID_BAR();
        GEMM_PHASE(EpiRope, NG3, XB, WS_WIN, NIN, D, 1, QKV, RS, (const float*)(args.ws + WS_ROPE), args.out);
        GEMM_PHASE(EpiPlain, NG3, PB, WS_WPP, D, DPLE, 1, PP, D, nullptr);
#endif
        SIGNAL_DONE(1);
    }
#endif
    GRID_BAR();
#ifndef SKIP_P4
    attention_phase_a(F, args);
    GRID_BAR();
    attention_phase_b(F, args);
#ifdef PROBE_ATTN2
    GRID_BAR();
    attention_phase_a(F, args);
    GRID_BAR();
    attention_phase_b(F, args);
#endif
#endif
    GRID_BAR();
#ifdef PROBE_BAR8
    GRID_BAR(); GRID_BAR(); GRID_BAR(); GRID_BAR(); GRID_BAR(); GRID_BAR(); GRID_BAR(); GRID_BAR();
#endif
#ifndef SKIP_P5
    GEMM_PHASE(EpiPlain, F.G, ATT, WS_WOUT, D, D, 4, Y, D, (float*)(args.ws + WS_SLAB));
#ifdef PROBE_P358
    GRID_BAR();
    GEMM_PHASE(EpiPlain, F.G, ATT, WS_WOUT, D, D, 4, Y, D, (float*)(args.ws + WS_SLAB));
#endif
#endif
    GRID_BAR();
#ifndef SKIP_NORM
    norm_phase<1, 4>(F, args, args.in[14], 1.0f);
#endif
    GRID_BAR();
#ifndef SKIP_P6
    if ((int)blockIdx.x < NG1) { GEMM_PHASE(EpiSwiGLU, NG1, XB, WS_WGU2, 2 * FF, D, 1, ACT, FF, RS); SIGNAL_DONE(2); }
#endif
    GRID_BAR();
#ifndef SKIP_P7
    GEMM_PHASE(EpiPlain, F.G, ACT, WS_WD2, D, FF, 11, Y, D, (float*)(args.ws + WS_SLAB));
#endif
    GRID_BAR();
#ifndef SKIP_NORM
    norm_phase<1, 11>(F, args, args.in[19], 0.5f);
#endif
    GRID_BAR();
#ifndef SKIP_P8
    GEMM_PHASE(EpiPle, F.G, XB, WS_WPG, D, D, 4, Y, D, RS, PP, (float*)(args.ws + WS_SLAB));
#ifdef PROBE_P358
    GRID_BAR();
    GEMM_PHASE(EpiPle, F.G, XB, WS_WPG, D, D, 4, Y, D, RS, PP, (float*)(args.ws + WS_SLAB));
#endif
#endif
    for (int pair = (int)blockIdx.x; pair < 256; pair += F.G) {
        const GAS f32x4* s4 = (const GAS f32x4*)(args.in[2 + (pair >> 7)] + (size_t)(pair & 127) * LA * 512 + 512) + F.lane; GAS f32x4* d4 = (GAS f32x4*)(args.out + ((pair >> 7) ? O_AVS : O_AKS) + (size_t)(pair & 127) * LA * 512) + F.lane;
        int c = (pair == (int)blockIdx.x ? F.copy_cur : 0) + F.wave;
        for (; c + 7 * NWAVES < 4094; c += 8 * NWAVES) { f32x4 v[8];
#pragma unroll
            for (int q = 0; q < 8; ++q) v[q] = __builtin_nontemporal_load(s4 + (c + q * NWAVES) * 64);
#pragma unroll
            for (int q = 0; q < 8; ++q) __builtin_nontemporal_store(v[q], d4 + (c + q * NWAVES) * 64); }
        for (; c < 4094; c += NWAVES) { const f32x4 v = __builtin_nontemporal_load(s4 + c * 64); __builtin_nontemporal_store(v, d4 + c * 64); }
    }
    GRID_BAR();
#ifndef SKIP_NORM
    norm_phase<2, 4>(F, args, args.in[24], 1.0f);
#endif
#ifdef PROBE_NORMFX2
    GRID_BAR();
    norm_phase<2, 4>(F, args, args.in[24], 1.0f);
#endif
#undef GEMM_PHASE
#undef COPY_SRC
#undef COPY_DST
#undef SIGNAL_DONE
#undef GRID_BAR
#undef XB
#undef RS
#undef ACT
#undef Y
#undef QKV
#undef ATT
#undef PB
#undef PP
}

extern "C" void kernel_launch(void* const* d_in, const int* in_sizes, int n_in, void* d_out, int out_size, void* d_ws, size_t ws_size, hipStream_t stream) {
    static int grid = 0;
    if (grid == 0) {
        if (n_in != 27 || (size_t)out_size != O_END || ws_size < WS_END) { fprintf(stderr, "kernel_launch: unexpected shapes (n_in %d, out %d, ws %zu); nothing launched\n", n_in, out_size, ws_size); grid = -1; return; }
        int dev = 0, cus = 0, per_cu = 0;
        if (hipGetDevice(&dev) != hipSuccess || hipDeviceGetAttribute(&cus, hipDeviceAttributeMultiprocessorCount, dev) != hipSuccess) { grid = -1; return; }
        if (hipFuncSetAttribute((const void*)fwd_kernel, hipFuncAttributeMaxDynamicSharedMemorySize, LDS_BYTES) != hipSuccess) { fprintf(stderr, "kernel_launch: hipFuncSetAttribute failed\n"); grid = -1; return; }
        if (hipOccupancyMaxActiveBlocksPerMultiprocessor(&per_cu, (const void*)fwd_kernel, NWAVES * 64, LDS_BYTES) != hipSuccess || per_cu < 1) { fprintf(stderr, "kernel_launch: occupancy query says %d blocks per CU\n", per_cu); per_cu = 1; }
        (void)hipGetLastError();
        grid = cus;
    }
    if (grid < 0) return;
    if (hipMemsetAsync((char*)d_ws + WS_CTL, 0, CTL_ZERO_BYTES, stream) != hipSuccess) return;
    Args a{};
    for (int i = 0; i < 27; ++i) a.in[i] = (const float*)d_in[i];
    a.out = (float*)d_out; a.ws = (unsigned char*)d_ws;
    hipLaunchKernelGGL(fwd_kernel, dim3(grid), dim3(NWAVES * 64), LDS_BYTES, stream, a);
}
```
